# Optimizing an MI355X kernel written in HIP

```python
import math
import jax, jax.numpy as jnp
from jax import lax
import numpy as np

D_MODEL = 1024
BATCH = 8
SEQ = 2048
DEPTH = 1

GDN_HEADS = 8
GDN_DK = 128
GDN_DV = 128
GDN_CONV = 4
GDN_CHUNK = 64
DIL_PATTERN = ((128, 1), (512, 4), (2048, 16))
DIL_HEADS_PER_GROUP = 4
DIL_HD = 128
DIL_BLOCK = 128
N_EXPERTS = 64
TOP_K = 8
N_GROUPS = 8
TOPK_GROUPS = 4
D_EXPERT = 256
D_SHARED = 256
ROUTE_SCALE = 2.5
MOE_TOKEN_BLOCK = 512
EPS = 1e-6

GDN_QK_W = GDN_HEADS * GDN_DK
GDN_V_W = GDN_HEADS * GDN_DV
N_DIL_GROUPS = len(DIL_PATTERN)
DIL_HEADS = N_DIL_GROUPS * DIL_HEADS_PER_GROUP
DIL_W = DIL_HEADS * DIL_HD
DIL_OUT_W = DIL_HEADS_PER_GROUP * DIL_HD
SPLIT_WIDTHS = (GDN_QK_W, GDN_QK_W, GDN_V_W, GDN_V_W, GDN_HEADS, GDN_HEADS,
                DIL_W, DIL_W, DIL_W, D_MODEL, D_MODEL)
IN_W = sum(SPLIT_WIDTHS)
SPLIT_OFFSETS = tuple(sum(SPLIT_WIDTHS[:i + 1]) for i in range(len(SPLIT_WIDTHS) - 1))

kernel_name = "hybrid_gdn_dilated_moe_adaln"


def _rms(t, g):
    t32 = t.astype(jnp.float32)
    return t32 * lax.rsqrt(jnp.mean(t32 * t32, axis=-1, keepdims=True) + EPS) * g.astype(jnp.float32)


def _l2norm(t):
    return t * lax.rsqrt(jnp.sum(t * t, axis=-1, keepdims=True) + EPS)


def causal_depthwise_conv(x, w):
    K, C = w.shape
    return lax.conv_general_dilated(x, w[:, None, :], window_strides=(1,), padding=((K - 1, 0),),
                                    dimension_numbers=('NWC', 'WIO', 'NWC'), feature_group_count=C)


def chunk_gated_delta_rule(q, k, v, g, beta):
    B, H, S, dk = q.shape
    dv = v.shape[-1]
    C = GDN_CHUNK
    N = S // C
    q = q.reshape(B, H, N, C, dk)
    k = k.reshape(B, H, N, C, dk)
    v = v.reshape(B, H, N, C, dv)
    g = g.reshape(B, H, N, C)
    beta = beta.reshape(B, H, N, C)
    gc = jnp.cumsum(g, axis=-1)
    incl = jnp.tril(jnp.ones((C, C), bool))
    strict = jnp.tril(jnp.ones((C, C), bool), -1)
    decay = jnp.exp(jnp.where(incl, gc[..., :, None] - gc[..., None, :], -jnp.inf))
    k_beta = k * beta[..., None]
    a_mat = jnp.where(strict, jnp.einsum('bhnid,bhnjd->bhnij', k_beta, k) * decay, 0.0)
    lmat = a_mat + jnp.eye(C, dtype=a_mat.dtype)
    rhs = jnp.concatenate([v * beta[..., None], k_beta * jnp.exp(gc)[..., None]], axis=-1)
    sol = lax.linalg.triangular_solve(lmat, rhs, left_side=True, lower=True, unit_diagonal=True)
    u, w = sol[..., :dv], sol[..., dv:]
    qk = jnp.einsum('bhnid,bhnjd->bhnij', q, k) * decay
    q_dec = q * jnp.exp(gc)[..., None]
    k_dec = k * jnp.exp(gc[..., -1:] - gc)[..., None]
    g_tot = jnp.exp(gc[..., -1])

    def step(state, xs):
        u_n, w_n, qk_n, qd_n, kd_n, gt_n = xs
        v_new = u_n - jnp.einsum('bhck,bhkv->bhcv', w_n, state)
        o_n = jnp.einsum('bhck,bhkv->bhcv', qd_n, state) + jnp.einsum('bhij,bhjv->bhiv', qk_n, v_new)
        state = state * gt_n[..., None, None] + jnp.einsum('bhck,bhcv->bhkv', kd_n, v_new)
        return state, o_n

    xs = tuple(jnp.moveaxis(t, 2, 0) for t in (u, w, qk, q_dec, k_dec, g_tot))
    state0 = jnp.zeros((B, H, dk, dv), q.dtype)
    _, o = lax.scan(step, state0, xs)
    return jnp.moveaxis(o, 0, 2).reshape(B, H, S, dv)


def gated_deltanet(q, k, v, z, b, a, conv_w, a_log, dt_bias, norm_g):
    B, S, _ = q.shape
    f32 = jnp.float32
    qkv = jnp.concatenate([q, k, v], axis=-1).astype(f32)
    qkv = jax.nn.silu(causal_depthwise_conv(qkv, conv_w.astype(f32)))
    q, k, v = jnp.split(qkv, [GDN_QK_W, 2 * GDN_QK_W], axis=-1)

    def heads(t, d):
        return t.reshape(B, S, GDN_HEADS, d).transpose(0, 2, 1, 3)

    q = _l2norm(heads(q, GDN_DK)) * (GDN_DK ** -0.5)
    k = _l2norm(heads(k, GDN_DK))
    v = heads(v, GDN_DV)
    beta = jax.nn.sigmoid(b.astype(f32)).transpose(0, 2, 1)
    g = (-jnp.exp(a_log.astype(f32)) * jax.nn.softplus(a.astype(f32) + dt_bias.astype(f32))).transpose(0, 2, 1)
    o = chunk_gated_delta_rule(q, k, v, g, beta).transpose(0, 2, 1, 3)
    zg = jax.nn.silu(z.astype(f32).reshape(B, S, GDN_HEADS, GDN_DV))
    o = _rms(o, norm_g) * zg
    return o.reshape(B, S, GDN_V_W)


def dilated_window_attention(q, k, v, window, dilation):
    B, S, h, e = q.shape
    L = S // dilation
    W = window // dilation
    blk = math.gcd(L, DIL_BLOCK)
    nb = L // blk

    def sub(t):
        return t.reshape(B, L, dilation, h, e).transpose(0, 2, 3, 1, 4)

    qs = sub(q).reshape(B, dilation, h, nb, blk, e)
    key_idx = np.arange(nb)[:, None] * blk + np.arange(blk + W)[None, :]
    pad = ((0, 0), (0, 0), (0, 0), (W, 0), (0, 0))
    ks = jnp.pad(sub(k), pad)[:, :, :, key_idx]
    vs = jnp.pad(sub(v), pad)[:, :, :, key_idx]
    dist = np.arange(blk)[:, None] + W - np.arange(blk + W)[None, :]
    valid = (dist >= 0) & (dist <= W) & ((key_idx[:, None, :] - W) >= 0)
    s = jnp.einsum('bdhnqe,bdhnke->bdhnqk', qs, ks) * (e ** -0.5)
    s = jnp.where(valid, s, -jnp.inf)
    m = jnp.max(s, axis=-1, keepdims=True)
    p = jnp.exp(s - m)
    den = jnp.sum(p, axis=-1, keepdims=True)
    o = jnp.einsum('bdhnqk,bdhnke->bdhnqe', p, vs) / den
    lse = (m + jnp.log(den))[..., 0]
    o = o.reshape(B, dilation, h, L, e).transpose(0, 3, 1, 2, 4).reshape(B, S, h, e)
    lse = lse.reshape(B, dilation, h, L).transpose(0, 3, 1, 2).reshape(B, S, h)
    return o, lse


def dilated_mixture(q, k, v, q_norm_g, k_norm_g):
    B, S, _ = q.shape
    q = _rms(q.reshape(B, S, DIL_HEADS, DIL_HD), q_norm_g)
    k = _rms(k.reshape(B, S, DIL_HEADS, DIL_HD), k_norm_g)
    v = v.reshape(B, S, DIL_HEADS, DIL_HD).astype(jnp.float32)
    outs, lses = [], []
    for gi, (win, dil) in enumerate(DIL_PATTERN):
        hs = slice(gi * DIL_HEADS_PER_GROUP, (gi + 1) * DIL_HEADS_PER_GROUP)
        o, lse = dilated_window_attention(q[:, :, hs], k[:, :, hs], v[:, :, hs], win, dil)
        outs.append(o)
        lses.append(lse)
    wts = jax.nn.softmax(jnp.stack(lses), axis=0)
    y = jnp.einsum('gbsh,gbshe->bshe', wts, jnp.stack(outs))
    return y.reshape(B, S, DIL_OUT_W)


def moe_ffn(h, w_router, router_bias, w_gate, w_up, w_down, ws_gate, ws_up, ws_down):
    B, S, D = h.shape
    T = B * S
    f32 = jnp.float32
    ht = h.reshape(T, D)
    scores = jax.nn.sigmoid(ht.astype(f32) @ w_router.astype(f32))
    sel = scores + router_bias.astype(f32)
    grp = sel.reshape(T, N_GROUPS, N_EXPERTS // N_GROUPS)
    grp_score = jnp.sum(lax.top_k(grp, 2)[0], axis=-1)
    _, gidx = lax.top_k(grp_score, TOPK_GROUPS)
    gmask = jnp.sum(jax.nn.one_hot(gidx, N_GROUPS, dtype=f32), axis=1)
    emask = jnp.repeat(gmask, N_EXPERTS // N_GROUPS, axis=1) > 0
    _, eidx = lax.top_k(jnp.where(emask, sel, -jnp.inf), TOP_K)
    wk = jnp.take_along_axis(scores, eidx, axis=-1)
    wk = wk / jnp.sum(wk, axis=-1, keepdims=True) * ROUTE_SCALE
    combine = jnp.einsum('tk,tke->te', wk, jax.nn.one_hot(eidx, N_EXPERTS, dtype=f32)).astype(h.dtype)
    tb = math.gcd(T, MOE_TOKEN_BLOCK)

    def block(args):
        hb, cb = args
        a = jnp.einsum('td,edf->tef', hb, w_gate)
        u = jnp.einsum('td,edf->tef', hb, w_up)
        return jnp.einsum('tef,efd->td', jax.nn.silu(a) * u * cb[..., None], w_down)

    routed = lax.map(block, (ht.reshape(T // tb, tb, D), combine.reshape(T // tb, tb, N_EXPERTS))).reshape(T, D)
    shared = (jax.nn.silu(ht @ ws_gate) * (ht @ ws_up)) @ ws_down
    return (routed + shared).reshape(B, S, D)


def setup_inputs(seed: int = 0) -> dict:
    key = jax.random.key(seed)
    ks = jax.random.split(key, 24)
    L, D, E = DEPTH, D_MODEL, N_EXPERTS
    nrm = lambda k, shape, scale: jax.random.normal(k, shape, jnp.float32) * scale
    dt = jnp.exp(jax.random.uniform(ks[7], (L, GDN_HEADS), jnp.float32, math.log(1e-3), math.log(1e-1)))
    return {
        "x": nrm(ks[0], (BATCH, SEQ, D), 1.0),
        "c": nrm(ks[1], (BATCH, D), 1.0),
        "w_ada": nrm(ks[2], (L, D, 6 * D), 0.5 * D ** -0.5),
        "b_ada": nrm(ks[3], (L, 6 * D), 0.02),
        "g_mix": 1.0 + nrm(ks[4], (L, D), 0.05),
        "w_in": nrm(ks[5], (L, D, IN_W), D ** -0.5),
        "gdn_conv_w": nrm(ks[6], (L, GDN_CONV, 2 * GDN_QK_W + GDN_V_W), 0.5),
        "gdn_a_log": jnp.log(jax.random.uniform(ks[8], (L, GDN_HEADS), jnp.float32, 1.0, 16.0)),
        "gdn_dt_bias": dt + jnp.log(-jnp.expm1(-dt)),
        "gdn_norm_g": 1.0 + nrm(ks[9], (L, GDN_DV), 0.05),
        "dil_q_norm_g": 1.0 + nrm(ks[10], (L, DIL_HD), 0.05),
        "dil_k_norm_g": 1.0 + nrm(ks[11], (L, DIL_HD), 0.05),
        "w_up_gdn": nrm(ks[12], (L, GDN_V_W, D), GDN_V_W ** -0.5),
        "w_up_dil": nrm(ks[13], (L, DIL_OUT_W, D), DIL_OUT_W ** -0.5),
        "w_out": nrm(ks[14], (L, D, D), D ** -0.5),
        "g_ffn": 1.0 + nrm(ks[15], (L, D), 0.05),
        "w_router": nrm(ks[16], (L, D, E), D ** -0.5),
        "router_bias": nrm(ks[17], (L, E), 0.01),
        "w_exp_gate": nrm(ks[18], (L, E, D, D_EXPERT), D ** -0.5),
        "w_exp_up": nrm(ks[19], (L, E, D, D_EXPERT), D ** -0.5),
        "w_exp_down": nrm(ks[20], (L, E, D_EXPERT, D), D_EXPERT ** -0.5),
        "w_sh_gate": nrm(ks[21], (L, D, D_SHARED), D ** -0.5),
        "w_sh_up": nrm(ks[22], (L, D, D_SHARED), D ** -0.5),
        "w_sh_down": nrm(ks[23], (L, D_SHARED, D), D_SHARED ** -0.5),
    }


def reference(x, c, w_ada, b_ada, g_mix, w_in, gdn_conv_w, gdn_a_log, gdn_dt_bias, gdn_norm_g,
              dil_q_norm_g, dil_k_norm_g, w_up_gdn, w_up_dil, w_out, g_ffn, w_router, router_bias,
              w_exp_gate, w_exp_up, w_exp_down, w_sh_gate, w_sh_up, w_sh_down):
    cs = jax.nn.silu(c)
    for l in range(DEPTH):
        mod = (cs @ w_ada[l] + b_ada[l])[:, None, :]
        sh1, sc1, gt1, sh2, sc2, gt2 = jnp.split(mod, 6, axis=-1)
        h = _rms(x, g_mix[l]).astype(x.dtype) * (1.0 + sc1) + sh1
        proj = h @ w_in[l]
        (gq, gk, gv, gz, gb, ga, dil_q, dil_k, dil_v, gate_a, gate_b) = jnp.split(proj, SPLIT_OFFSETS, axis=-1)
        y_a = gated_deltanet(gq, gk, gv, gz, gb, ga, gdn_conv_w[l], gdn_a_log[l], gdn_dt_bias[l],
                             gdn_norm_g[l]).astype(x.dtype)
        y_b = dilated_mixture(dil_q, dil_k, dil_v, dil_q_norm_g[l], dil_k_norm_g[l]).astype(x.dtype)
        merged = jax.nn.sigmoid(gate_a) * (y_a @ w_up_gdn[l]) + jax.nn.sigmoid(gate_b) * (y_b @ w_up_dil[l])
        x = x + gt1 * (merged @ w_out[l])
        h2 = _rms(x, g_ffn[l]).astype(x.dtype) * (1.0 + sc2) + sh2
        x = x + gt2 * moe_ffn(h2, w_router[l], router_bias[l], w_exp_gate[l], w_exp_up[l], w_exp_down[l],
                              w_sh_gate[l], w_sh_up[l], w_sh_down[l])
    return x
```

```cpp
#include <hip/hip_runtime.h>
#include <cstdio>
#include <cstdint>

#define LAS __attribute__((address_space(3)))
#define GAS __attribute__((address_space(1)))
typedef unsigned short bf16_t;
typedef short bf16x8 __attribute__((ext_vector_type(8)));
typedef float f32x2 __attribute__((ext_vector_type(2)));
typedef float f32x4 __attribute__((ext_vector_type(4)));
typedef unsigned u32x2 __attribute__((ext_vector_type(2)));
typedef unsigned u32x4 __attribute__((ext_vector_type(4)));

constexpr int BATCH = 8, SEQ = 2048, DM = 1024, T = BATCH * SEQ;
constexpr int IN_W = 10768;
constexpr int NPROJ = 8704;
constexpr int NEXP = 64, DEXP = 256;
constexpr float EPS = 1e-6f;

__device__ __forceinline__ unsigned f2bf(float f) { unsigned u = __builtin_bit_cast(unsigned, f); return (u + 0x7fffu + ((u >> 16) & 1u)) >> 16; }
typedef __bf16 bf16x2_t __attribute__((ext_vector_type(2)));
__device__ __forceinline__ unsigned pk2(float lo, float hi) { const f32x2 v = {lo, hi}; const bf16x2_t b = __builtin_convertvector(v, bf16x2_t); return __builtin_bit_cast(unsigned, b); }
__device__ __forceinline__ float bf2f(unsigned h) { return __builtin_bit_cast(float, h << 16); }
__device__ __forceinline__ float bflo(unsigned w) { return __builtin_bit_cast(float, w << 16); }
__device__ __forceinline__ float bfhi(unsigned w) { return __builtin_bit_cast(float, w & 0xffff0000u); }
__device__ __forceinline__ float sigmoidf_(float x) { return __builtin_amdgcn_rcpf(1.0f + __builtin_amdgcn_exp2f(-1.4426950408889634f * x)); }
__device__ __forceinline__ float siluf_(float x) { return x * __builtin_amdgcn_rcpf(1.0f + __builtin_amdgcn_exp2f(-1.4426950408889634f * x)); }
__device__ __forceinline__ int opaque_tid() { int t = threadIdx.x; asm volatile("" : "+v"(t)); return t; }
template <int CTRL> __device__ __forceinline__ float dppf(float v) { return __builtin_bit_cast(float, __builtin_amdgcn_update_dpp(0, __builtin_bit_cast(int, v), CTRL, 0xF, 0xF, true)); }
__device__ __forceinline__ float red4(float v) { v += dppf<0xB1>(v); v += dppf<0x4E>(v); return v; }
__device__ __forceinline__ float red8(float v) { v = red4(v); v += dppf<0x141>(v); return v; }
__device__ __forceinline__ float red16(float v) { v = red8(v); v += dppf<0x140>(v); return v; }
__device__ __forceinline__ float wave_sum(float v) { v = red16(v); v += __shfl_xor(v, 16); v += __shfl_xor(v, 32); return v; }

namespace pg8 {
#define PG8_LAS __attribute__((address_space(3)))
constexpr int BM = 256, BK = 64, HALF = 128, HTB = HALF * BK * 2, STAGE_BYTES = 8 * HTB, NXCD = 8, WGM = 8;

__host__ __device__ __forceinline__ int lds_byte(int r, int c) { const int st = (r >> 4) * 2 + (c >> 5), rr = r & 15, cc = c & 31, ob = rr * 64 + cc * 2; return st * 1024 + (ob ^ (((ob >> 9) & 1) << 5)); }
__host__ __device__ __forceinline__ void stage_rc(int b, int& R, int& C) { const int st = b / 1024, sb = b % 1024, swz = sb ^ (((sb >> 9) & 1) << 5); R = (st >> 1) * 16 + swz / 64; C = (st & 1) * 32 + (swz % 64) / 2; }
__host__ __device__ __forceinline__ int perm32(int rho) { const int n = rho >> 4, i = rho & 15; return 8 * (i >> 2) + 4 * n + (i & 3); }

struct Unit { int pm, pn; const char* Ap; const char* Bp; int e, mt; };

struct DenseOrder {
    int nM, nN, nwg, G, c; const char* A; const char* Bt; size_t tstep;
    __device__ __forceinline__ void init(int M, int N, int K, int G_, int c_, const void* A_, const void* Bt_) { nM = M / BM; nN = N / BM; nwg = nM * nN; G = G_; c = c_; A = (const char*)A_; Bt = (const char*)Bt_; tstep = (size_t)BM * K * 2; }
    __device__ __forceinline__ bool next(int i, Unit& u) const {
        const long L = (long)i * G + c; if (L >= nwg) return false;
        int wgid = (int)L; { const int q = nwg / NXCD, r = nwg % NXCD, xcd = wgid % NXCD, off = wgid / NXCD; wgid = (xcd < r ? xcd * (q + 1) : r * (q + 1) + (xcd - r) * q) + off; }
        const int nig = WGM * nN, gid = wgid / nig, fm = gid * WGM, gsz = (nM - fm) < WGM ? (nM - fm) : WGM;
        u.pm = fm + ((wgid % nig) % gsz); u.pn = (wgid % nig) / gsz; u.Ap = A + (size_t)u.pm * tstep; u.Bp = Bt + (size_t)u.pn * tstep; u.e = 0; u.mt = 0; return true;
    }
    __device__ __forceinline__ unsigned a_off(const Unit&, int r, int K) const { return (unsigned)(r * K) * 2u; }
};

__device__ __forceinline__ unsigned cvt_pk_bf16(float lo, float hi) { unsigned r; asm volatile("v_cvt_pk_bf16_f32 %0, %1, %2" : "=v"(r) : "v"(lo), "v"(hi)); return r; }

template <class Epi, class Sched, bool ALIGN_EPI, bool GATHER>
__device__ __forceinline__ void gemm_phase(PG8_LAS unsigned char* lds, const int K, const Sched& S, const Epi& E, PG8_LAS int* tokb = nullptr) {
    const int tid = opaque_tid(), wid = __builtin_amdgcn_readfirstlane(tid >> 6), lane = tid & 63, wr = wid >> 2, wc = wid & 3, fr = lane & 15, fq = lane >> 4;
    const int nt = K / BK;
    unsigned voffB[2];
#pragma unroll
    for (int i = 0; i < 2; ++i) { int R, C; stage_rc(tid * 16 + i * 8192, R, C); const int Rb = Epi::PERM ? ((R & ~31) + perm32(R & 31)) : R;
        voffB[i] = (unsigned)(Rb * K + C) * 2u; }
    const size_t kstep = (size_t)(BK * 2);
    const size_t hstep = (size_t)HALF * K * 2;
    const unsigned ldsw = (unsigned)wid * 1024u;
    const int aoff = lds_byte(wr * 64 + fr, fq * 8), boff = lds_byte(wc * 32 + fr, fq * 8);
#define PG8_SA(b, h) (((b) * 2 + (h)) * HTB)
#define PG8_SB(b, h) ((4 + (b) * 2 + (h)) * HTB)
#define PG8_GLDS(gptr, bufoff, i_) __builtin_amdgcn_global_load_lds((const unsigned*)(gptr), (PG8_LAS unsigned*)(lds + (bufoff) + ldsw + (i_) * 8192), 16, 0, 0)
#define PG8_STAGE_B(bufoff, gbase) do { _Pragma("unroll") for (int _i = 0; _i < 2; ++_i) PG8_GLDS((const char*)(gbase) + voffB[_i], bufoff, _i); } while (0)
#define PG8_STAGE_A(bufoff, gbase, h) do { _Pragma("unroll") for (int _i = 0; _i < 2; ++_i) PG8_GLDS((const char*)(gbase) + vAc[h][_i], bufoff, _i); } while (0)
#define PG8_STAGE_A2(bufoff, gbase, h) PG8_STAGE_A(bufoff, gbase, h)
#define PG8_NEXT_A() do { const int _t = opaque_tid(); const PG8_LAS int* _tb = tokb + (ui + 1) * 256; _Pragma("unroll") for (int _i = 0; _i < 2; ++_i) { int _R, _C; stage_rc(_t * 16 + _i * 8192, _R, _C); \
        _Pragma("unroll") for (int _h = 0; _h < 2; ++_h) vAc[_h][_i] = (unsigned)(_tb[_h * 128 + _R] * K + _C) * 2u; } } while (0)
#define PG8_CALC_A(u, v) do { const int _t = opaque_tid(); _Pragma("unroll") for (int _i = 0; _i < 2; ++_i) { int _R, _C; stage_rc(_t * 16 + _i * 8192, _R, _C); _Pragma("unroll") for (int _h = 0; _h < 2; ++_h) v[_h][_i] = (GATHER ? (unsigned)(tokb[_h * 128 + _R] * K) * 2u : S.a_off(u, _h * 128 + _R, K)) + (unsigned)_C * 2u; } } while (0)
#define PG8_LDA(dst, b, h) do { _Pragma("unroll") for (int m = 0; m < 4; ++m) _Pragma("unroll") for (int k = 0; k < 2; ++k) dst[m][k] = *(const PG8_LAS bf16x8*)(lds + PG8_SA(b, h) + aoff + m * 2048 + k * 1024); } while (0)
#define PG8_LDB(dst, b, h) do { _Pragma("unroll") for (int n = 0; n < 2; ++n) _Pragma("unroll") for (int k = 0; k < 2; ++k) dst[n][k] = *(const PG8_LAS bf16x8*)(lds + PG8_SB(b, h) + boff + n * 2048 + k * 1024); } while (0)
#define PG8_MMA(ai, bj, At, Bt) do { __builtin_amdgcn_s_setprio(1); _Pragma("unroll") for (int m = 0; m < 4; ++m) _Pragma("unroll") for (int n = 0; n < 2; ++n) _Pragma("unroll") for (int k = 0; k < 2; ++k) \
        acc[ai][bj][m][n] = __builtin_amdgcn_mfma_f32_16x16x32_bf16(Bt[n][k], At[m][k], acc[ai][bj][m][n], 0, 0, 0); __builtin_amdgcn_s_setprio(0); } while (0)
#define PG8_WAIT_V(n) asm volatile("s_waitcnt vmcnt(" #n ")" ::: "memory")
#define PG8_WAIT_L(n) asm volatile("s_waitcnt lgkmcnt(" #n ")" ::: "memory")
#define PG8_BAR __builtin_amdgcn_s_barrier()
#define PG8_SCHED __builtin_amdgcn_sched_barrier(0)
    Unit cur, nxt; int ui = 0;
    if (!S.next(0, cur)) return;
    f32x4 acc[2][2][4][2];
#pragma unroll
    for (int a = 0; a < 2; ++a)
#pragma unroll
        for (int b = 0; b < 2; ++b)
#pragma unroll
            for (int m = 0; m < 4; ++m)
#pragma unroll
                for (int n = 0; n < 2; ++n) acc[a][b][m][n] = (f32x4){0.f, 0.f, 0.f, 0.f};
    bf16x8 At[4][2], B0[2][2], B1[2][2];
    unsigned vAc[2][2];
    PG8_CALC_A(cur, vAc);
    const char* cA = cur.Ap; const char* cB = cur.Bp;
    PG8_STAGE_B(PG8_SB(0, 0), cB); PG8_STAGE_B(PG8_SB(0, 1), cB + hstep); PG8_STAGE_A(PG8_SA(0, 0), cA, 0); PG8_STAGE_A(PG8_SA(0, 1), cA, 1);
    if (wr == 1) PG8_BAR;
    PG8_WAIT_V(2); PG8_BAR;
    PG8_STAGE_B(PG8_SB(1, 0), cB + kstep); PG8_STAGE_A(PG8_SA(1, 0), cA + kstep, 0); PG8_STAGE_B(PG8_SB(1, 1), cB + hstep + kstep);
    PG8_WAIT_V(6); PG8_BAR;
    for (;;) {
        const bool has_next = S.next(ui + 1, nxt);
        const char* nA = has_next ? nxt.Ap : cA; const char* nB = has_next ? nxt.Bp : cB;
#pragma unroll 1
        for (int t = 0; t < nt; t += 2) {
            const bool last = (t == nt - 2);
            const char* a1 = cA + (size_t)(t + 1) * kstep;
            const char* a2 = last ? nA : cA + (size_t)(t + 2) * kstep; const char* b2 = last ? nB : cB + (size_t)(t + 2) * kstep;
            const char* a3 = a2 + kstep; const char* b3 = b2 + kstep;
            PG8_LDB(B0, 0, 0); PG8_LDB(B1, 0, 1); PG8_SCHED; PG8_LDA(At, 0, 0); PG8_STAGE_A(PG8_SA(1, 1), a1, 1);
            if constexpr (GATHER) { if (last && has_next) { PG8_NEXT_A(); } }
            PG8_WAIT_V(8); PG8_WAIT_L(0); PG8_BAR; PG8_MMA(0, 0, At, B0); PG8_MMA(0, 1, At, B1); PG8_BAR; PG8_SCHED;
            PG8_LDA(At, 0, 1); PG8_STAGE_B(PG8_SB(0, 0), b2); PG8_STAGE_B(PG8_SB(0, 1), b2 + hstep); PG8_STAGE_A2(PG8_SA(0, 0), a2, 0);
            PG8_WAIT_V(8); PG8_WAIT_L(0); PG8_BAR; PG8_MMA(1, 0, At, B0); PG8_MMA(1, 1, At, B1); PG8_BAR; PG8_SCHED;
            PG8_LDB(B0, 1, 0); PG8_LDB(B1, 1, 1); PG8_SCHED; PG8_LDA(At, 1, 0); PG8_STAGE_A2(PG8_SA(0, 1), a2, 1);
            PG8_WAIT_V(8); PG8_WAIT_L(0); PG8_BAR; PG8_MMA(0, 0, At, B0); PG8_MMA(0, 1, At, B1); PG8_BAR; PG8_SCHED;
            PG8_LDA(At, 1, 1); PG8_STAGE_B(PG8_SB(1, 0), b3); PG8_STAGE_B(PG8_SB(1, 1), b3 + hstep); PG8_STAGE_A2(PG8_SA(1, 0), a3, 0);
            PG8_WAIT_V(8); PG8_WAIT_L(0); PG8_BAR; PG8_MMA(1, 0, At, B0); PG8_MMA(1, 1, At, B1); PG8_BAR; PG8_SCHED;
        }
        if constexpr (ALIGN_EPI) { if (wr == 0) PG8_BAR; }
        E(acc, cur, ui);
        if (!has_next) break;
#pragma unroll
        for (int a = 0; a < 2; ++a)
#pragma unroll
            for (int b = 0; b < 2; ++b)
#pragma unroll
                for (int m = 0; m < 4; ++m)
#pragma unroll
                    for (int n = 0; n < 2; ++n) acc[a][b][m][n] = (f32x4){0.f, 0.f, 0.f, 0.f};
        cur = nxt; cA = nA; cB = nB; ++ui;
        if constexpr (ALIGN_EPI) { if (wr == 1) PG8_BAR; }
    }
    PG8_WAIT_V(0);
    if constexpr (!ALIGN_EPI) { if (wr == 0) PG8_BAR; }
    PG8_BAR;
#undef PG8_SA
#undef PG8_SB
#undef PG8_GLDS
#undef PG8_STAGE_A
#undef PG8_STAGE_A2
#undef PG8_NEXT_A
#undef PG8_STAGE_B
#undef PG8_CALC_A
#undef PG8_LDA
#undef PG8_LDB
#undef PG8_MMA
#undef PG8_WAIT_V
#undef PG8_WAIT_L
#undef PG8_BAR
#undef PG8_SCHED
}
}

constexpr size_t MiB = 1u << 20;
constexpr size_t WS_CTL = 0, CTL_ZERO_BYTES = 128 * 1024;
constexpr size_t WS_MOD = 1 * MiB;
constexpr size_t WS_BA = 2 * MiB;
constexpr size_t WS_PW = 3 * MiB;
constexpr size_t WS_WIN = 4 * MiB;
constexpr size_t WS_LIST = 4 * MiB;
constexpr size_t WS_LISTW = 8 * MiB;
constexpr size_t WS_WSGU = 12 * MiB;
constexpr size_t WS_WSD = 13 * MiB;
constexpr size_t WS_WG = 21 * MiB;
constexpr size_t WS_WUPG = 25 * MiB, WS_WUPD = 27 * MiB, WS_WOUT = 28 * MiB;
constexpr size_t WS_H = 30 * MiB;
constexpr size_t WS_GQ = 62 * MiB, WS_GK = 94 * MiB, WS_GV = 126 * MiB;
constexpr size_t WS_YA = 62 * MiB;
constexpr size_t WS_WGU = 94 * MiB;
constexpr size_t WS_DQ = 158 * MiB, WS_DK = 206 * MiB, WS_DV = 254 * MiB;
constexpr size_t WS_UA = 158 * MiB, WS_UB = 190 * MiB, WS_MG = 222 * MiB;
constexpr size_t WS_ACT = 158 * MiB;
constexpr size_t WS_ACTS = 231 * MiB;
constexpr size_t WS_WD = 302 * MiB;
constexpr size_t WS_SLOT = 30 * MiB;
constexpr size_t WS_SH = 240 * MiB;
constexpr size_t WS_END = 334 * MiB;
constexpr size_t OUT_GZ = 0, OUT_YB = 32 * MiB;

constexpr int CW_BAR = 4096;
constexpr int CW_CNT = 16384;

constexpr int RING_BYTES = 131072;
constexpr int MISC_OFF = 143360;
constexpr int INFO_OFF = 131072;
constexpr int LDS_BYTES = 147456;

typedef GAS unsigned gu32;
#define RLX_AGENT __ATOMIC_RELAXED, __HIP_MEMORY_SCOPE_AGENT

#define XB_TMO      128
#define XB_XCNT(j)  (256  + 64 * (j))
#define XB_XSUB(j)  (1280 + 64 * (j))
#define XB_XGEN(j)  (2304 + 64 * (j))
#define XB_TOP      3328
#define XB_TOPGEN   3392
#define XCD_BAR_WORDS 3456
#define XB_SPIN_CAP (1u << 22)
__device__ __forceinline__ unsigned xb_ld(unsigned* p)              { return __hip_atomic_load(p, __ATOMIC_RELAXED, __HIP_MEMORY_SCOPE_AGENT); }
__device__ __forceinline__ unsigned xb_add(unsigned* p, unsigned v) { return __hip_atomic_fetch_add(p, v, __ATOMIC_RELAXED, __HIP_MEMORY_SCOPE_AGENT); }
__device__ __forceinline__ unsigned xb_xcc_id() { return (unsigned)__builtin_amdgcn_s_getreg((3 << 11) | 20) & 0xFu; }
#define XB_SPIN(cond, bar) do { unsigned _sp = 0; while (cond) { __builtin_amdgcn_s_sleep(1); \
    if ((++_sp & 255u) == 0u) { if (xb_ld(&(bar)[XB_TMO])) break; if (_sp > XB_SPIN_CAP) { atomicAdd(&(bar)[XB_TMO], 1u); break; } } } } while (0)
struct XcdBarrier { unsigned* bar; unsigned x; volatile LAS unsigned* st; };
__device__ __forceinline__ XcdBarrier xcd_barrier_post(unsigned* bar, volatile LAS unsigned* st) {
    XcdBarrier b; b.bar = bar; b.x = xb_xcc_id(); b.st = st;
    if (threadIdx.x == 0) (void)xb_add(&bar[XB_XCNT(b.x)], 1u);
    return b;
}
__device__ __forceinline__ void xcd_barrier_complete(unsigned* bar, unsigned x, unsigned& nloc, unsigned& nx) {
    const unsigned G = gridDim.x * gridDim.y * gridDim.z;
    unsigned sum, cnt, mine, sp = 0u;
    for (;;) {
        sum = 0u; cnt = 0u; mine = 0u;
#pragma unroll
        for (unsigned j = 0; j < 16; ++j) { const unsigned c = xb_ld(&bar[XB_XCNT(j)]); sum += c; cnt += (c > 0u) ? 1u : 0u; mine = (j == x) ? c : mine; }
        if (sum == G) break;
        __builtin_amdgcn_s_sleep(1);
        if ((++sp & 255u) == 0u) { if (xb_ld(&bar[XB_TMO])) break; if (sp > XB_SPIN_CAP) { atomicAdd(&bar[XB_TMO], 1u); break; } }
    }
    nloc = mine > 0u ? mine : 1u; nx = cnt > 0u ? cnt : 1u;
}
__device__ __forceinline__ void xcd_barrier(const XcdBarrier& b) {
    asm volatile("s_waitcnt vmcnt(0)" ::: "memory");
    __syncthreads();
    if (threadIdx.x == 0) {
        unsigned* bar = b.bar;
        __builtin_amdgcn_s_waitcnt(0);
        unsigned nloc = b.st[0], nx = b.st[1];
        if (nloc == 0u) { xcd_barrier_complete(bar, b.x, nloc, nx); b.st[0] = nloc; b.st[1] = nx; }
        const unsigned old = xb_add(&bar[XB_XSUB(b.x)], 1u);
        const unsigned gen = old / nloc;
        if (old + 1u == (gen + 1u) * nloc) {
            __builtin_amdgcn_fence(__ATOMIC_RELEASE, "agent");
            asm volatile("s_waitcnt vmcnt(0)" ::: "memory");
            const unsigned og = xb_add(&bar[XB_TOP], 1u);
            const unsigned tg = og / nx;
            if (og + 1u == (tg + 1u) * nx) xb_add(&bar[XB_TOPGEN], 1u);
            else XB_SPIN(xb_ld(&bar[XB_TOPGEN]) == tg, bar);
            __builtin_amdgcn_fence(__ATOMIC_ACQUIRE, "agent");
            xb_add(&bar[XB_XGEN(b.x)], 1u);
            asm volatile("s_waitcnt vmcnt(0)" ::: "memory");
        } else {
            XB_SPIN(xb_ld(&bar[XB_XGEN(b.x)]) == gen, bar);
            __builtin_amdgcn_fence(__ATOMIC_ACQUIRE, "agent");
            asm volatile("s_waitcnt vmcnt(0)" ::: "memory");
        }
    }
    __syncthreads();
}

struct Frame {
    LAS unsigned char* lds;
    int G, blk;
    float* out; unsigned char* ws; unsigned char* ob;
};
enum { I_X = 0, I_C, I_WADA, I_BADA, I_GMIX, I_WIN, I_CONVW, I_ALOG, I_DTB, I_GNG, I_QNG, I_KNG, I_WUPG, I_WUPD, I_WOUT, I_GFFN, I_WR, I_RB, I_WEG, I_WEU, I_WED, I_WSG, I_WSU, I_WSD };
__device__ __forceinline__ const float* inp(int i) { return ((const float* const __attribute__((address_space(4)))*)__builtin_amdgcn_kernarg_segment_ptr())[i]; }

__device__ __forceinline__ void transpose_item(const float* W, int ldn, int n0s, int k0, bf16_t* WT, int dK, int drow0, LAS float* scr, int lane) {
#pragma unroll 8
    for (int i = 0; i < 32; ++i) { const int kk = 2 * i + (lane >> 5); scr[kk * 33 + (lane & 31)] = W[(size_t)(k0 + kk) * ldn + n0s + (lane & 31)]; }
    asm volatile("s_waitcnt lgkmcnt(0)" ::: "memory");
    const int c = lane & 7;
#pragma unroll
    for (int j = 0; j < 4; ++j) { const int n = (lane >> 3) + 8 * j; const LAS float* s = scr + (8 * c) * 33 + n;
        u32x4 o; o.x = pk2(s[0 * 33], s[1 * 33]); o.y = pk2(s[2 * 33], s[3 * 33]); o.z = pk2(s[4 * 33], s[5 * 33]); o.w = pk2(s[6 * 33], s[7 * 33]);
        *(GAS u32x4*)(WT + (size_t)(drow0 + n) * dK + k0 + 8 * c) = o; }
    asm volatile("s_waitcnt lgkmcnt(0)" ::: "memory");
}

__device__ __forceinline__ void p0_mod(Frame& F) {
    const int ftid = opaque_tid(), flane = ftid & 63, fwave = __builtin_amdgcn_readfirstlane(ftid >> 6);
    LAS float* cs = (LAS float*)(F.lds);
    LAS float* red = (LAS float*)(F.lds + 32768);
    for (int i = ftid; i < 8 * 1024; i += 512) cs[i] = siluf_(inp(I_C)[i]);
    __syncthreads();
    float* MOD = (float*)(F.ws + WS_MOD);
    for (int cb = F.blk; cb < 6144 / 24; cb += F.G) {
        const int col = ftid & 31, kg = ftid >> 5;
        float acc[8];
#pragma unroll
        for (int b = 0; b < 8; ++b) acc[b] = 0.f;
        if (col < 24) {
            for (int i = 0; i < 64; ++i) { const int k = kg + 16 * i; const float w = inp(I_WADA)[(size_t)k * 6144 + cb * 24 + col];
#pragma unroll
                for (int b = 0; b < 8; ++b) acc[b] += cs[b * 1024 + k] * w; }
        }
#pragma unroll
        for (int b = 0; b < 8; ++b) red[(kg * 8 + b) * 32 + col] = acc[b];
        __syncthreads();
        if (ftid < 256) { const int b = ftid >> 5, cc = ftid & 31;
            if (cc < 24) { float s = inp(I_BADA)[cb * 24 + cc];
                for (int g = 0; g < 16; ++g) s += red[(g * 8 + b) * 32 + cc];
                MOD[b * 6144 + cb * 24 + cc] = s; } }
        __syncthreads();
    }
}
__device__ __forceinline__ void p0_weights(Frame& F) {
    const int ftid = opaque_tid(), flane = ftid & 63, fwave = __builtin_amdgcn_readfirstlane(ftid >> 6);
    LAS float* scr = (LAS float*)(F.lds + 49152 + fwave * 8448);
    const int gw = F.blk * 8 + fwave, NGW = F.G * 8;
    bf16_t* WIN = (bf16_t*)(F.ws + WS_WIN); bf16_t* WG = (bf16_t*)(F.ws + WS_WG);
    bf16_t* WUPG = (bf16_t*)(F.ws + WS_WUPG); bf16_t* WUPD = (bf16_t*)(F.ws + WS_WUPD); bf16_t* WOUT = (bf16_t*)(F.ws + WS_WOUT);
    constexpr int I_IN = 16 * (NPROJ / 32), I_G = 16 * 64, I_UG = 16 * 32, I_UD = 8 * 32, I_O = 16 * 32;
    constexpr int NIT = I_IN + I_G + I_UG + I_UD + I_O;
    for (int it = gw; it < NIT; it += NGW) {
        int r = it;
        if (r < I_IN) { const int kb = r / (NPROJ / 32), nb = r % (NPROJ / 32), n0 = nb * 32; transpose_item(inp(I_WIN), IN_W, n0 + (n0 >= 4096 ? 16 : 0), kb * 64, WIN, 1024, n0, scr, flane); continue; } r -= I_IN;
        if (r < I_G) { const int kb = r / 64, nb = r % 64, p = nb >> 3, hf = (nb >> 2) & 1, i0 = (nb & 3) * 32;
            transpose_item(inp(I_WIN), IN_W, 8720 + hf * 1024 + p * 128 + i0, kb * 64, WG, 1024, p * 256 + hf * 128 + i0, scr, flane); continue; } r -= I_G;
        if (r < I_UG) { const int kb = r / 32, nb = r % 32; transpose_item(inp(I_WUPG), 1024, nb * 32, kb * 64, WUPG, 1024, nb * 32, scr, flane); continue; } r -= I_UG;
        if (r < I_UD) { const int kb = r / 32, nb = r % 32; transpose_item(inp(I_WUPD), 1024, nb * 32, kb * 64, WUPD, 512, nb * 32, scr, flane); continue; } r -= I_UD;
        { const int kb = r / 32, nb = r % 32; transpose_item(inp(I_WOUT), 1024, nb * 32, kb * 64, WOUT, 1024, nb * 32, scr, flane); }
    }
}
__device__ __forceinline__ void tr16_item(const float* src, int ldn, int n0, int k0, bf16_t* d0, bf16_t* d1, bf16_t* d2, bf16_t* d3, int lane) {
    f32x4 v[16];
#pragma unroll
    for (int i = 0; i < 16; ++i) v[i] = *(const f32x4*)(src + (size_t)(k0 + i) * ldn + n0 + 4 * lane);
    u32x4 a0, a1, b0, b1, c0, c1, e0, e1;
#pragma unroll
    for (int i = 0; i < 4; ++i) { a0[i] = pk2(v[2 * i].x, v[2 * i + 1].x); a1[i] = pk2(v[8 + 2 * i].x, v[9 + 2 * i].x); b0[i] = pk2(v[2 * i].y, v[2 * i + 1].y); b1[i] = pk2(v[8 + 2 * i].y, v[9 + 2 * i].y);
        c0[i] = pk2(v[2 * i].z, v[2 * i + 1].z); c1[i] = pk2(v[8 + 2 * i].z, v[9 + 2 * i].z); e0[i] = pk2(v[2 * i].w, v[2 * i + 1].w); e1[i] = pk2(v[8 + 2 * i].w, v[9 + 2 * i].w); }
    *(u32x4*)(d0 + k0) = a0; *(u32x4*)(d0 + k0 + 8) = a1; *(u32x4*)(d1 + k0) = b0; *(u32x4*)(d1 + k0 + 8) = b1;
    *(u32x4*)(d2 + k0) = c0; *(u32x4*)(d2 + k0 + 8) = c1; *(u32x4*)(d3 + k0) = e0; *(u32x4*)(d3 + k0 + 8) = e1;
}
__device__ __forceinline__ void convert_experts(Frame& F, int b0, int nb) {
    const int ftid = opaque_tid(), flane = ftid & 63, fwave = __builtin_amdgcn_readfirstlane(ftid >> 6);
    if (F.blk < b0 || F.blk >= b0 + nb) return;
    const int gw = (F.blk - b0) * 8 + fwave, NGW = nb * 8;
    bf16_t* WGU = (bf16_t*)(F.ws + WS_WGU); bf16_t* WD = (bf16_t*)(F.ws + WS_WD); bf16_t* WSGU = (bf16_t*)(F.ws + WS_WSGU); bf16_t* WSD = (bf16_t*)(F.ws + WS_WSD);
    constexpr int PER_E = 192, NIT = 65 * PER_E;
    for (int it = gw; it < NIT; it += NGW) {
        const int e = it / PER_E; const int r = it % PER_E;
        bf16_t* dgu = e < 64 ? WGU + (size_t)e * 512 * 1024 : WSGU; bf16_t* dd = e < 64 ? WD + (size_t)e * 1024 * 256 : WSD;
        if (r < 128) { const int hf = r >> 6, k0 = (r & 63) * 16;
            const float* src = hf ? (e < 64 ? inp(I_WEU) + (size_t)e * 1024 * 256 : inp(I_WSU)) : (e < 64 ? inp(I_WEG) + (size_t)e * 1024 * 256 : inp(I_WSG));
            const int n = 4 * flane; bf16_t* d = dgu + (size_t)((n >> 7) * 256 + hf * 128 + (n & 127)) * 1024;
            tr16_item(src, 256, 0, k0, d, d + 1024, d + 2048, d + 3072, flane); }
        else { const int q = r - 128, k0 = (q >> 2) * 16, n0 = (q & 3) * 256;
            const float* src = e < 64 ? inp(I_WED) + (size_t)e * 256 * 1024 : inp(I_WSD);
            bf16_t* d = dd + (size_t)(n0 + 4 * flane) * 256;
            tr16_item(src, 1024, n0, k0, d, d + 256, d + 512, d + 768, flane); }
    }
}

__device__ __forceinline__ void p1_norm(Frame& F) {
    const int ftid = opaque_tid(), flane = ftid & 63, fwave = __builtin_amdgcn_readfirstlane(ftid >> 6);
    LAS float* WbT = (LAS float*)(F.lds);
    for (int it = 0; it < 8; ++it) { const int k = (ftid >> 2) + 128 * it, j4 = (ftid & 3) * 4;
        const f32x4 v = *(const f32x4*)(inp(I_WIN) + (size_t)k * IN_W + 4096 + j4);
        WbT[(j4 + 0) * 1024 + k] = v.x; WbT[(j4 + 1) * 1024 + k] = v.y; WbT[(j4 + 2) * 1024 + k] = v.z; WbT[(j4 + 3) * 1024 + k] = v.w; }
    __syncthreads();
    const float* MOD = (const float*)(F.ws + WS_MOD); bf16_t* H = (bf16_t*)(F.ws + WS_H); float* BA = (float*)(F.ws + WS_BA);
    const int gw = F.blk * 8 + fwave, NGW = F.G * 8;
    for (int rg = gw; rg < T / 8; rg += NGW) {
        const int row0 = rg * 8, b = row0 / SEQ;
        const float* sh = MOD + b * 6144; const float* sc = sh + 1024;
        f32x4 gm[4], s1[4], h1[4];
#pragma unroll
        for (int j = 0; j < 4; ++j) { const int k = 4 * flane + 256 * j; gm[j] = *(const f32x4*)(inp(I_GMIX) + k); s1[j] = *(const f32x4*)(sc + k) + 1.0f; h1[j] = *(const f32x4*)(sh + k); gm[j] = gm[j] * s1[j]; }
        f32x4 cur[4], nxt[4];
        { const f32x4* xr = (const f32x4*)(inp(I_X) + (size_t)row0 * DM) + flane;
#pragma unroll
          for (int j = 0; j < 4; ++j) cur[j] = xr[64 * j]; }
#pragma unroll 1
        for (int r = 0; r < 8; ++r) {
            const int row = row0 + r;
            if (r < 7) { const f32x4* xr = (const f32x4*)(inp(I_X) + (size_t)(row + 1) * DM) + flane;
#pragma unroll
                for (int j = 0; j < 4; ++j) nxt[j] = xr[64 * j]; }
            f32x4 v[4]; float ss = 0.f;
#pragma unroll
            for (int j = 0; j < 4; ++j) { v[j] = cur[j]; ss += (v[j].x * v[j].x + v[j].y * v[j].y) + (v[j].z * v[j].z + v[j].w * v[j].w); }
            const float rstd = rsqrtf(wave_sum(ss) * (1.f / DM) + EPS);
#pragma unroll
            for (int j = 0; j < 4; ++j) { const int k = 4 * flane + 256 * j;
                v[j] = (v[j] * rstd) * gm[j] + h1[j];
                u32x2 o; o.x = pk2(v[j].x, v[j].y); o.y = pk2(v[j].z, v[j].w);
                *(u32x2*)(H + (size_t)row * DM + k) = o; }
            float a[16];
#pragma unroll
            for (int jj = 0; jj < 16; ++jj) { float s = 0.f;
#pragma unroll
                for (int j = 0; j < 4; ++j) { const f32x4 w = *(const LAS f32x4*)(WbT + jj * 1024 + 4 * flane + 256 * j); s += (v[j].x * w.x + v[j].y * w.y) + (v[j].z * w.z + v[j].w * w.w); }
                a[jj] = s; if ((jj & 3) == 3) asm volatile("" ::: "memory"); }
            float v8[8], v4[4], v2[2], v1;
            { const bool hi = (flane & 32) != 0;
#pragma unroll
              for (int i = 0; i < 8; ++i) { const float x = hi ? a[i] : a[8 + i]; const float rr = __shfl_xor(x, 32); v8[i] = (hi ? a[8 + i] : a[i]) + rr; } }
            { const bool hi = (flane & 16) != 0;
#pragma unroll
              for (int i = 0; i < 4; ++i) { const float x = hi ? v8[i] : v8[4 + i]; const float rr = __shfl_xor(x, 16); v4[i] = (hi ? v8[4 + i] : v8[i]) + rr; } }
            { const bool hi = (flane & 8) != 0;
#pragma unroll
              for (int i = 0; i < 2; ++i) { const float x = hi ? v4[i] : v4[2 + i]; const float rr = __shfl_xor(x, 8); v2[i] = (hi ? v4[2 + i] : v4[i]) + rr; } }
            { const bool hi = (flane & 4) != 0; const float x = hi ? v2[0] : v2[1]; const float rr = __shfl_xor(x, 4); v1 = (hi ? v2[1] : v2[0]) + rr; }
            v1 = red4(v1);
            if ((flane & 3) == 0) BA[(size_t)row * 16 + (flane >> 2)] = v1;
#pragma unroll
            for (int j = 0; j < 4; ++j) cur[j] = nxt[j];
        }
    }
}

using pg8::Unit; using pg8::cvt_pk_bf16;
struct EpiProj {
    static constexpr bool PERM = true;
    unsigned char* ws; bf16_t* gz;
    __device__ __forceinline__ void operator()(const f32x4 (&acc)[2][2][4][2], const Unit& u, const int ui) const {
        const int tid_ = opaque_tid(), lane_ = tid_ & 63, wid_ = tid_ >> 6, wr = wid_ >> 2, wc = wid_ & 3, fr = lane_ & 15, fq = lane_ >> 4;
        bf16_t* base; int ldc, colt;
        if (u.pn < 16) { const int t = u.pn >> 2; base = (bf16_t*)(ws + WS_GQ + (size_t)t * (32 * MiB)); if (t == 3) base = gz; ldc = 1024; colt = (u.pn & 3) * 256; }
        else { const int d = u.pn - 16, t = d / 6; base = (bf16_t*)(ws + WS_DQ + (size_t)t * (48 * MiB)); ldc = 1536; colt = (d % 6) * 256; }
        const int row0 = u.pm * 256 + wr * 64 + fr, col0 = colt + wc * 32 + 8 * fq;
#pragma unroll
        for (int ai = 0; ai < 2; ++ai)
#pragma unroll
            for (int m = 0; m < 4; ++m) { bf16_t* rowp = base + (size_t)(row0 + ai * 128 + m * 16) * ldc + col0;
#pragma unroll
                for (int bj = 0; bj < 2; ++bj) { const f32x4 v0 = acc[ai][bj][m][0], v1 = acc[ai][bj][m][1];
                    u32x4 w; w.x = pk2(v0[0], v0[1]); w.y = pk2(v0[2], v0[3]); w.z = pk2(v1[0], v1[1]); w.w = pk2(v1[2], v1[3]);
                    *(u32x4*)(rowp + bj * 128) = w; } }
    }
};
struct EpiStore {
    static constexpr bool PERM = true;
    bf16_t* O; int ldc;
    __device__ __forceinline__ void operator()(const f32x4 (&acc)[2][2][4][2], const Unit& u, const int ui) const {
        const int tid_ = opaque_tid(), lane_ = tid_ & 63, wid_ = tid_ >> 6, wr = wid_ >> 2, wc = wid_ & 3, fr = lane_ & 15, fq = lane_ >> 4;
        const int row0 = u.pm * 256 + wr * 64 + fr, col0 = u.pn * 256 + wc * 32 + 8 * fq;
#pragma unroll
        for (int ai = 0; ai < 2; ++ai)
#pragma unroll
            for (int m = 0; m < 4; ++m) { bf16_t* rowp = O + (size_t)(row0 + ai * 128 + m * 16) * ldc + col0;
#pragma unroll
                for (int bj = 0; bj < 2; ++bj) { const f32x4 v0 = acc[ai][bj][m][0], v1 = acc[ai][bj][m][1];
                    u32x4 w; w.x = pk2(v0[0], v0[1]); w.y = pk2(v0[2], v0[3]); w.z = pk2(v1[0], v1[1]); w.w = pk2(v1[2], v1[3]);
                    *(u32x4*)(rowp + bj * 128) = w; } }
    }
};
struct EpiGate {
    static constexpr bool PERM = true;
    const bf16_t* UA; const bf16_t* UB; bf16_t* MG;
    __device__ __forceinline__ void operator()(const f32x4 (&acc)[2][2][4][2], const Unit& u, const int ui) const {
        const int tid_ = opaque_tid(), lane_ = tid_ & 63, wid_ = tid_ >> 6, wr = wid_ >> 2, wc = wid_ & 3, fr = lane_ & 15, fq = lane_ >> 4;
        const int row0 = u.pm * 256 + wr * 64 + fr, col0 = u.pn * 128 + wc * 32 + 8 * fq;
#pragma unroll
        for (int ai = 0; ai < 2; ++ai) {
            u32x4 ua[4], ub[4];
#pragma unroll
            for (int m = 0; m < 4; ++m) { const size_t off = (size_t)(row0 + ai * 128 + m * 16) * 1024 + col0; ua[m] = *(const u32x4*)(UA + off); ub[m] = *(const u32x4*)(UB + off); }
#pragma unroll
            for (int m = 0; m < 4; ++m) { const size_t off = (size_t)(row0 + ai * 128 + m * 16) * 1024 + col0;
                float o[8];
#pragma unroll
                for (int n = 0; n < 2; ++n)
#pragma unroll
                    for (int j = 0; j < 4; ++j) { const int q = n * 4 + j; const unsigned wa = ua[m][q >> 1], wb = ub[m][q >> 1];
                        const float fa = (q & 1) ? bfhi(wa) : bflo(wa), fb = (q & 1) ? bfhi(wb) : bflo(wb);
                        o[q] = sigmoidf_(acc[ai][0][m][n][j]) * fa + sigmoidf_(acc[ai][1][m][n][j]) * fb; }
                u32x4 w; w.x = pk2(o[0], o[1]); w.y = pk2(o[2], o[3]); w.z = pk2(o[4], o[5]); w.w = pk2(o[6], o[7]);
                *(u32x4*)(MG + off) = w; }
            asm volatile("" ::: "memory");
        }
    }
};
struct EpiX1 {
    static constexpr bool PERM = false;
    const float* x; const float* mod; float* out;
    __device__ __forceinline__ void operator()(const f32x4 (&acc)[2][2][4][2], const Unit& u, const int ui) const {
        const int tid_ = opaque_tid(), lane_ = tid_ & 63, wid_ = tid_ >> 6, wr = wid_ >> 2, wc = wid_ & 3, fr = lane_ & 15, fq = lane_ >> 4;
        const int row0 = u.pm * 256 + wr * 64 + fr, col0 = u.pn * 256 + wc * 32 + 4 * fq; const int b = u.pm >> 3;
        f32x4 gt[2][2];
#pragma unroll
        for (int bj = 0; bj < 2; ++bj)
#pragma unroll
            for (int n = 0; n < 2; ++n) gt[bj][n] = *(const f32x4*)(mod + b * 6144 + 2048 + col0 + bj * 128 + n * 16);
#pragma unroll
        for (int ai = 0; ai < 2; ++ai) {
            f32x4 xv[4][2][2];
#pragma unroll
            for (int m = 0; m < 4; ++m) { const size_t off = (size_t)(row0 + ai * 128 + m * 16) * 1024 + col0;
#pragma unroll
                for (int bj = 0; bj < 2; ++bj)
#pragma unroll
                    for (int n = 0; n < 2; ++n) xv[m][bj][n] = *(const f32x4*)(x + off + bj * 128 + n * 16); }
#pragma unroll
            for (int m = 0; m < 4; ++m) { const size_t off = (size_t)(row0 + ai * 128 + m * 16) * 1024 + col0;
#pragma unroll
                for (int bj = 0; bj < 2; ++bj)
#pragma unroll
                    for (int n = 0; n < 2; ++n) *(f32x4*)(out + off + bj * 128 + n * 16) = xv[m][bj][n] + gt[bj][n] * acc[ai][bj][m][n]; }
            asm volatile("" ::: "memory");
        }
    }
};
struct MoeTab { const LAS int* tp; const LAS int* cnt; const LAS unsigned short* te; };
struct EpiAct {
    static constexpr bool PERM = true;
    MoeTab tb; const LAS float* wkb; bf16_t* ACT; bf16_t* ACTS;
    __device__ __forceinline__ void operator()(const f32x4 (&acc)[2][2][4][2], const Unit& u, const int ui) const {
        const int tid_ = opaque_tid(), lane_ = tid_ & 63, wid_ = tid_ >> 6, wr = wid_ >> 2, wc = wid_ & 3, fr = lane_ & 15, fq = lane_ >> 4;
        const int e = u.e;
        bf16_t* base = e < 64 ? ACT + (size_t)u.pm * 256 * 256 : ACTS + (size_t)u.mt * 256 * 256;
        const int col0 = u.pn * 128 + wc * 32 + 8 * fq;
        float wk[2][4];
#pragma unroll
        for (int ai = 0; ai < 2; ++ai)
#pragma unroll
            for (int m = 0; m < 4; ++m) wk[ai][m] = wkb[ui * 256 + ai * 128 + wr * 64 + m * 16 + fr];
#pragma unroll
        for (int ai = 0; ai < 2; ++ai)
#pragma unroll
            for (int m = 0; m < 4; ++m) { const int r = ai * 128 + wr * 64 + m * 16 + fr;
                float o[8];
#pragma unroll
                for (int n = 0; n < 2; ++n)
#pragma unroll
                    for (int j = 0; j < 4; ++j) o[n * 4 + j] = siluf_(acc[ai][0][m][n][j]) * acc[ai][1][m][n][j] * wk[ai][m];
                u32x4 w; w.x = pk2(o[0], o[1]); w.y = pk2(o[2], o[3]); w.z = pk2(o[4], o[5]); w.w = pk2(o[6], o[7]);
                *(u32x4*)(base + (size_t)r * 256 + col0) = w; }
    }
};
struct EpiSlot {
    static constexpr bool PERM = true;
    MoeTab tb; const LAS int* pairb; unsigned char* SLOT; bf16_t* SH;
    __device__ __forceinline__ void operator()(const f32x4 (&acc)[2][2][4][2], const Unit& u, const int ui) const {
        const int tid_ = opaque_tid(), lane_ = tid_ & 63, wid_ = tid_ >> 6, wr = wid_ >> 2, wc = wid_ & 3, fr = lane_ & 15, fq = lane_ >> 4;
        const int e = u.e; const int col0 = u.pn * 256 + wc * 32 + 8 * fq;
        if (e == 64) {
#pragma unroll
            for (int ai = 0; ai < 2; ++ai)
#pragma unroll
                for (int m = 0; m < 4; ++m) { bf16_t* rowp = SH + (size_t)(u.mt * 256 + ai * 128 + wr * 64 + m * 16 + fr) * 1024 + col0;
#pragma unroll
                    for (int bj = 0; bj < 2; ++bj) { const f32x4 v0 = acc[ai][bj][m][0], v1 = acc[ai][bj][m][1];
                        u32x4 w; w.x = pk2(v0[0], v0[1]); w.y = pk2(v0[2], v0[3]); w.z = pk2(v1[0], v1[1]); w.w = pk2(v1[2], v1[3]);
                        *(u32x4*)(rowp + bj * 128) = w; } }
            return;
        }
        int pair[2][4];
#pragma unroll
        for (int ai = 0; ai < 2; ++ai)
#pragma unroll
            for (int m = 0; m < 4; ++m) pair[ai][m] = pairb[ui * 256 + ai * 128 + wr * 64 + m * 16 + fr];
#pragma unroll
        for (int ai = 0; ai < 2; ++ai)
#pragma unroll
            for (int m = 0; m < 4; ++m) {
                if (pair[ai][m] >= 0) { unsigned char* rowp = SLOT + (size_t)pair[ai][m] * 1024 + col0;
#pragma unroll
                    for (int bj = 0; bj < 2; ++bj) { const f32x4 v0 = acc[ai][bj][m][0], v1 = acc[ai][bj][m][1];
                        int p0 = 0, p1 = 0;
                        p0 = __builtin_amdgcn_cvt_pk_fp8_f32(v0[0], v0[1], p0, false); p0 = __builtin_amdgcn_cvt_pk_fp8_f32(v0[2], v0[3], p0, true);
                        p1 = __builtin_amdgcn_cvt_pk_fp8_f32(v1[0], v1[1], p1, false); p1 = __builtin_amdgcn_cvt_pk_fp8_f32(v1[2], v1[3], p1, true);
                        u32x2 w; w.x = (unsigned)p0; w.y = (unsigned)p1; *(u32x2*)(rowp + bj * 128) = w; } } }
    }
};
struct G1Order {
    MoeTab tb; int G, c; const int* list; const char* H2; const char* WGU; const char* WSGU;
    __device__ __forceinline__ bool next(int i, Unit& u) const {
        const int NR = tb.tp[64]; const long L = (long)i * G + c; if (L >= (long)(NR + 64) * 2) return false;
        const int tile = (int)(L >> 1), j = (int)(L & 1);
        u.pn = j; u.Ap = H2;
        if (tile < NR) { const int e = tb.te[tile]; u.e = e; u.mt = tile - tb.tp[e]; u.pm = tile; u.Bp = WGU + ((size_t)e * 512 + j * 256) * 1024 * 2; }
        else { u.e = 64; u.mt = tile - NR; u.pm = 0; u.Bp = WSGU + (size_t)(j * 256) * 1024 * 2; }
        return true;
    }
    __device__ __forceinline__ int a_row(const Unit& u, int r) const {
        int tok;
        if (u.e == 64) tok = u.mt * 256 + r;
        else { const int pos = u.mt * 256 + r; tok = 0; if (pos < tb.cnt[u.e]) tok = list[(size_t)u.e * T + pos] >> 3; }
        return tok;
    }
    __device__ __forceinline__ unsigned a_off(const Unit& u, int r, int K) const { return (unsigned)(a_row(u, r) * K) * 2u; }
    __device__ __forceinline__ void preload(LAS int* tokb, LAS float* wkb, const float* listw) const {
        const int t = opaque_tid(); Unit u;
        for (int i = 0; i < 6 && next(i, u); ++i) if (t < 256) {
            int tok; float w = 1.0f;
            if (u.e == 64) tok = u.mt * 256 + t;
            else { const int pos = u.mt * 256 + t; tok = 0; w = 0.f; if (pos < tb.cnt[u.e]) { tok = list[(size_t)u.e * T + pos] >> 3; w = listw[(size_t)u.e * T + pos]; } }
            tokb[i * 256 + t] = tok; wkb[i * 256 + t] = w; }
        __syncthreads();
    }
};
struct G2Order {
    MoeTab tb; int G, c; const char* ACT; const char* WD; const char* ACTS; const char* WSD;
    __device__ __forceinline__ bool next(int i, Unit& u) const {
        const int NR = tb.tp[64]; const long L = (long)i * G + c; if (L >= (long)(NR + 64) * 4) return false;
        const int tile = (int)(L >> 2), pn = (int)(L & 3);
        u.pn = pn;
        if (tile < NR) { const int e = tb.te[tile];
            u.e = e; u.mt = tile - tb.tp[e]; u.pm = tile; u.Ap = ACT + (size_t)tile * 256 * 256 * 2; u.Bp = WD + ((size_t)e * 1024 + pn * 256) * 256 * 2; }
        else { u.e = 64; u.mt = tile - NR; u.pm = 0; u.Ap = ACTS + (size_t)u.mt * 256 * 256 * 2; u.Bp = WSD + (size_t)(pn * 256) * 256 * 2; }
        return true;
    }
    __device__ __forceinline__ unsigned a_off(const Unit&, int r, int K) const { return (unsigned)(r * K) * 2u; }
    __device__ __forceinline__ void preload(LAS int* pairb, const int* list) const {
        const int t = opaque_tid(); Unit u;
        for (int i = 0; i < 12 && next(i, u); ++i) if (t < 256) {
            int p = -1;
            if (u.e < 64) { const int pos = u.mt * 256 + t; if (pos < tb.cnt[u.e]) p = list[(size_t)u.e * T + pos]; }
            pairb[i * 256 + t] = p; }
        __syncthreads();
    }
};
__device__ __forceinline__ MoeTab build_moetab(Frame& F) {
    const int ftid = opaque_tid();
    LAS int* tp = (LAS int*)(F.lds + MISC_OFF + 1024); LAS int* cnt = (LAS int*)(F.lds + MISC_OFF + 2048); LAS unsigned short* te = (LAS unsigned short*)(F.lds + MISC_OFF + 2304);
    const gu32* gc = (const gu32*)(F.ws + WS_CTL) + CW_CNT;
    __syncthreads();
    if (ftid < 64) { int v = (int)__hip_atomic_load(gc + ftid, RLX_AGENT); if (v > T) v = T; if (v < 0) v = 0; cnt[ftid] = v; }
    __syncthreads();
    if (ftid == 0) { int s = 0; for (int e = 0; e < 64; ++e) { tp[e] = s; s += (cnt[e] + 255) >> 8; } tp[64] = s; }
    __syncthreads();
    if (ftid < 64) { const int t0 = tp[ftid], t1 = tp[ftid + 1]; for (int t = t0; t < t1 && t < 640; ++t) te[t] = (unsigned short)ftid; }
    __syncthreads();
    MoeTab t; t.tp = tp; t.cnt = cnt; t.te = te; return t;
}


typedef short v4i16_t __attribute__((ext_vector_type(4)));
constexpr size_t WS_OG01 = 302 * MiB;
constexpr size_t OUT_OG2 = 48 * MiB;
constexpr size_t WS_LSE = 3 * MiB + 512 * 1024;
__device__ __forceinline__ void p3_attn(Frame& F) {
    const int tid = opaque_tid(), lane = tid & 63, wave = __builtin_amdgcn_readfirstlane(tid >> 6), n = lane & 15, g = lane >> 4;
    const bf16_t* DQ = (const bf16_t*)(F.ws + WS_DQ); const bf16_t* DK = (const bf16_t*)(F.ws + WS_DK); const bf16_t* DV = (const bf16_t*)(F.ws + WS_DV);
    LAS unsigned char* Ks = F.lds; LAS unsigned char* Vs = F.lds + 65536; LAS float* rkS = (LAS float*)(F.lds + 131072);
    const float* gqp = inp(I_QNG); const float* gkp = inp(I_KNG);
    u32x4 kreg[8], vreg[8];
#define ATT_DECODE(u_, b_, h_, dsh_, r_, qb_) const int b_ = (u_) / 192, rem_##b_ = (u_) % 192, h_ = rem_##b_ >> 4, rq_##b_ = rem_##b_ & 15, dsh_ = 2 * (h_ >> 2), r_ = rq_##b_ / (16 >> dsh_), qb_ = rq_##b_ % (16 >> dsh_)
#define ATT_LOADKV(u_) do { ATT_DECODE(u_, lb, lh, ldsh, lr, lqb); \
        _Pragma("unroll") for (int pass = 0; pass < 8; ++pass) { if (lqb == 0 && pass < 4) continue; \
            const int wi = pass * 32 + (tid >> 4), c = tid & 15, m = lqb * 128 - 128 + wi; \
            const size_t t = (size_t)lb * SEQ + (size_t)((m << ldsh) + lr); \
            kreg[pass] = *(const u32x4*)(DK + t * 1536 + lh * 128 + c * 8); vreg[pass] = *(const u32x4*)(DV + t * 1536 + lh * 128 + c * 8); } } while (0)
    if (F.blk < BATCH * 12 * 16) { ATT_LOADKV(F.blk); }
#pragma unroll 1
    for (int u = F.blk; u < BATCH * 12 * 16; u += F.G) {
        ATT_DECODE(u, b, h, dsh, r, qb); const int grp = h >> 2, s = h & 3, dil = 1 << dsh, m0 = qb * 128;
        const size_t rowb = (size_t)b * SEQ;
        __syncthreads();
#pragma unroll
        for (int pass = 0; pass < 8; ++pass) {
            if (qb == 0 && pass < 4) continue;
            const int wi = pass * 32 + (tid >> 4), c = tid & 15;
            const u32x4 kv = kreg[pass], vv = vreg[pass];
            float ss = 0.f;
#pragma unroll
            for (int i = 0; i < 4; ++i) { const float a0 = bflo(kv[i]), a1 = bfhi(kv[i]); ss += a0 * a0 + a1 * a1; }
            ss = red16(ss);
            if (c == 0) rkS[wi] = rsqrtf(ss * (1.f / 128.f) + EPS);
            *(LAS u32x4*)(Ks + wi * 256 + ((c ^ (wi & 15)) << 4)) = kv;
            *(LAS u32x4*)(Vs + wi * 256 + ((c ^ ((wi & 7) << 1)) << 4)) = vv;
        }
        const size_t tq = rowb + (size_t)((m0 + 16 * wave + n) * dil + r);
        bf16x8 qf[4];
        {
            u32x4 qraw[4]; float ss = 0.f;
#pragma unroll
            for (int ks = 0; ks < 4; ++ks) { qraw[ks] = *(const u32x4*)(DQ + tq * 1536 + h * 128 + 32 * ks + 8 * g);
#pragma unroll
                for (int i = 0; i < 4; ++i) { const float a0 = bflo(qraw[ks][i]), a1 = bfhi(qraw[ks][i]); ss += a0 * a0 + a1 * a1; } }
            ss += __shfl_xor(ss, 16); ss += __shfl_xor(ss, 32);
            const float rqs = rsqrtf(ss * (1.f / 128.f) + EPS) * (0.08838834764831845f * 1.4426950408889634f);
#pragma unroll
            for (int ks = 0; ks < 4; ++ks) { u32x4 o;
#pragma unroll
                for (int i = 0; i < 4; ++i) { const int d = 32 * ks + 8 * g + 2 * i;
                    o[i] = pk2(bflo(qraw[ks][i]) * rqs * gqp[d] * gkp[d], bfhi(qraw[ks][i]) * rqs * gqp[d + 1] * gkp[d + 1]); }
                qf[ks] = __builtin_bit_cast(bf16x8, o); }
        }
        __syncthreads();
        if (u + F.G < BATCH * 12 * 16) { ATT_LOADKV(u + F.G); }
        f32x4 st[16];
        float mx = -INFINITY;
#pragma unroll
        for (int tau = 0; tau < 16; ++tau) {
            const bool act = tau < 8 ? (qb > 0 && tau >= wave) : (tau - 8 <= wave);
            st[tau] = (f32x4){-INFINITY, -INFINITY, -INFINITY, -INFINITY};
            if (act) {
                f32x4 a = {0.f, 0.f, 0.f, 0.f};
                const int wi = 16 * tau + n;
#pragma unroll
                for (int ks = 0; ks < 4; ++ks) { const bf16x8 kf = *(const LAS bf16x8*)(Ks + wi * 256 + (((4 * ks + g) ^ n) << 4));
                    a = __builtin_amdgcn_mfma_f32_16x16x32_bf16(kf, qf[ks], a, 0, 0, 0); }
                const f32x4 rk = *(const LAS f32x4*)(rkS + 16 * tau + 4 * g);
                a = a * rk;
                const int jt = tau & 7;
                if (jt == wave) {
#pragma unroll
                    for (int reg = 0; reg < 4; ++reg) { const int kk = 4 * g + reg; const bool ok = tau < 8 ? (kk >= n) : (kk <= n); if (!ok) a[reg] = -INFINITY; }
                }
                st[tau] = a;
                mx = fmaxf(mx, fmaxf(fmaxf(a[0], a[1]), fmaxf(a[2], a[3])));
            }
        }
        mx = fmaxf(mx, __shfl_xor(mx, 16)); mx = fmaxf(mx, __shfl_xor(mx, 32));
        float lsum = 0.f;
#pragma unroll
        for (int tau = 0; tau < 16; ++tau)
#pragma unroll
            for (int reg = 0; reg < 4; ++reg) { const float p = __builtin_amdgcn_exp2f(st[tau][reg] - mx); st[tau][reg] = p; lsum += p; }
        lsum += __shfl_xor(lsum, 16); lsum += __shfl_xor(lsum, 32);
        f32x4 o[8];
#pragma unroll
        for (int dt = 0; dt < 8; ++dt) o[dt] = (f32x4){0.f, 0.f, 0.f, 0.f};
        const int q4 = (lane & 15) >> 2, p4 = lane & 3;
#pragma unroll
        for (int a = 0; a < 8; ++a) {
            const bool act = a < 4 ? (qb > 0 && 2 * a + 1 >= wave) : (2 * (a - 4) <= wave);
            if (act) {
                u32x4 pw; pw[0] = pk2(st[2 * a][0], st[2 * a][1]); pw[1] = pk2(st[2 * a][2], st[2 * a][3]); pw[2] = pk2(st[2 * a + 1][0], st[2 * a + 1][1]); pw[3] = pk2(st[2 * a + 1][2], st[2 * a + 1][3]);
                const bf16x8 pf = __builtin_bit_cast(bf16x8, pw);
                const int row0 = 32 * a + 4 * g + q4, row1 = row0 + 16;
#pragma unroll
                for (int dt = 0; dt < 8; ++dt) {
                    const int c = 2 * dt + (p4 >> 1);
                    const v4i16_t v0 = __builtin_amdgcn_ds_read_tr16_b64_v4i16((LAS v4i16_t*)(Vs + row0 * 256 + ((c ^ ((row0 & 7) << 1)) << 4) + 8 * (p4 & 1)));
                    const v4i16_t v1 = __builtin_amdgcn_ds_read_tr16_b64_v4i16((LAS v4i16_t*)(Vs + row1 * 256 + ((c ^ ((row1 & 7) << 1)) << 4) + 8 * (p4 & 1)));
                    const bf16x8 vf = (bf16x8){v0[0], v0[1], v0[2], v0[3], v1[0], v1[1], v1[2], v1[3]};
                    o[dt] = __builtin_amdgcn_mfma_f32_16x16x32_bf16(vf, pf, o[dt], 0, 0, 0);
                }
            }
        }
        const float il = 1.f / lsum;
        bf16_t* OG = grp < 2 ? (bf16_t*)(F.ws + WS_OG01) + (size_t)grp * T * 512 : (bf16_t*)(F.ob + OUT_OG2);
#pragma unroll
        for (int dt = 0; dt < 8; ++dt) { u32x2 w; w.x = pk2(o[dt][0] * il, o[dt][1] * il); w.y = pk2(o[dt][2] * il, o[dt][3] * il);
            *(u32x2*)(OG + tq * 512 + s * 128 + 16 * dt + 4 * g) = w; }
        if (g == 0) ((float*)(F.ws + WS_LSE))[((size_t)grp * T + tq) * 4 + s] = (mx + __builtin_amdgcn_logf(lsum)) * 0.6931471805599453f;
    }
}
#undef ATT_DECODE
#undef ATT_LOADKV
__device__ __forceinline__ void p3_merge(Frame& F) {
    const int tid = opaque_tid();
    const bf16_t* OG0 = (const bf16_t*)(F.ws + WS_OG01); const bf16_t* OG1 = OG0 + (size_t)T * 512; const bf16_t* OG2 = (const bf16_t*)(F.ob + OUT_OG2);
    const float* LSE = (const float*)(F.ws + WS_LSE); bf16_t* YB = (bf16_t*)(F.ob + OUT_YB);
    for (size_t it = (size_t)F.blk * 512 + tid; it < (size_t)T * 64; it += (size_t)F.G * 512) {
        const size_t t = it >> 6; const int ch = (int)(it & 63), s = ch >> 4;
        const float l0 = LSE[t * 4 + s], l1 = LSE[((size_t)T + t) * 4 + s], l2 = LSE[((size_t)2 * T + t) * 4 + s];
        const float m = fmaxf(l0, fmaxf(l1, l2)); const float e0 = __expf(l0 - m), e1 = __expf(l1 - m), e2 = __expf(l2 - m); const float inv = 1.f / (e0 + e1 + e2);
        const float w0 = e0 * inv, w1 = e1 * inv, w2 = e2 * inv;
        const u32x4 a = *(const u32x4*)(OG0 + t * 512 + ch * 8), bq = *(const u32x4*)(OG1 + t * 512 + ch * 8), cq = *(const u32x4*)(OG2 + t * 512 + ch * 8);
        u32x4 o;
#pragma unroll
        for (int i = 0; i < 4; ++i) o[i] = pk2(w0 * bflo(a[i]) + w1 * bflo(bq[i]) + w2 * bflo(cq[i]), w0 * bfhi(a[i]) + w1 * bfhi(bq[i]) + w2 * bfhi(cq[i]));
        *(u32x4*)(YB + t * 512 + ch * 8) = o;
    }
}

constexpr size_t WS_UT = 158 * MiB, WS_WM = 190 * MiB, WS_QD = 222 * MiB, WS_KDT = 254 * MiB, WS_QK = 286 * MiB;
constexpr size_t WS_GT = 1 * MiB + 512 * 1024;
__device__ __forceinline__ unsigned off_b(unsigned row, unsigned ch) { return 256u * row + 16u * (ch ^ (((row & 3) << 2) | ((row >> 2) & 3))); }
__device__ __forceinline__ unsigned rowfrag_b(unsigned lane, unsigned rb, unsigned s) { return off_b((lane & 15) + 16 * rb, 4 * s + (lane >> 4)); }
__device__ __forceinline__ unsigned trfrag_b(unsigned lane, unsigned c, unsigned ks, unsigned t) { const unsigned g = lane >> 4, q = (lane & 15) >> 2, p = lane & 3; return off_b(32 * ks + 8 * g + 4 * t + q, 2 * c + (p >> 1)) + 8 * (p & 1); }
__device__ __forceinline__ bf16x8 tr_pair(LAS unsigned char* a0, LAS unsigned char* a1) {
    const v4i16_t v0 = __builtin_amdgcn_ds_read_tr16_b64_v4i16((LAS v4i16_t*)a0), v1 = __builtin_amdgcn_ds_read_tr16_b64_v4i16((LAS v4i16_t*)a1);
    return (bf16x8){v0[0], v0[1], v0[2], v0[3], v1[0], v1[1], v1[2], v1[3]};
}
constexpr int MST = 144;
__device__ __forceinline__ f32x4 mm64_tile(LAS unsigned char* X, LAS unsigned char* Y, int ti, int tj, int lane) {
    const int n = lane & 15, g = lane >> 4, q = n >> 2, p = lane & 3;
    f32x4 acc = {0.f, 0.f, 0.f, 0.f};
#pragma unroll
    for (int ks = 0; ks < 2; ++ks) {
        const bf16x8 a = *(const LAS bf16x8*)(X + (16 * ti + n) * MST + 16 * (4 * ks + g));
        LAS unsigned char* yb = Y + (32 * ks + 8 * g + q) * MST + 32 * tj + 8 * p;
        const bf16x8 b = tr_pair(yb, yb + 4 * MST);
        acc = __builtin_amdgcn_mfma_f32_16x16x32_bf16(a, b, acc, 0, 0, 0);
    }
    return acc;
}
__device__ __forceinline__ void st_b16(LAS unsigned char* M, int row, int col, float v) { *(LAS unsigned short*)(M + row * MST + col * 2) = (unsigned short)pk2(v, 0.f); }

__device__ __forceinline__ void p3b_gdn_prep(Frame& F) {
    LAS unsigned char* Kn = F.lds; LAS unsigned char* Qn = F.lds + 16384; LAS unsigned char* Vn = F.lds + 32768;
    LAS unsigned char* R0 = F.lds + 49152; LAS unsigned char* R1 = R0 + 9216; LAS unsigned char* R2 = R1 + 9216; LAS unsigned char* R3 = R2 + 9216; LAS unsigned char* R4 = R3 + 9216;
    LAS float* Af = (LAS float*)(F.lds + 95232);
    LAS float* CW = (LAS float*)(F.lds + 111872);
    LAS float* betaS = (LAS float*)(F.lds + 118016); LAS float* gS = betaS + 64; LAS float* gcS = gS + 64;
    const bf16_t* GQ = (const bf16_t*)(F.ws + WS_GQ); const float* BA = (const float*)(F.ws + WS_BA);
    bf16_t* UT = (bf16_t*)(F.ws + WS_UT); bf16_t* WM = (bf16_t*)(F.ws + WS_WM); bf16_t* QD = (bf16_t*)(F.ws + WS_QD); bf16_t* KDT = (bf16_t*)(F.ws + WS_KDT); bf16_t* QK = (bf16_t*)(F.ws + WS_QK);
    float* GT = (float*)(F.ws + WS_GT);
    const float* convw = inp(I_CONVW);
    LAS unsigned char* RAW = F.lds + 49152;
    u32x4 own[3][2], halo; float cwr[3], bar0 = 0.f, bar1 = 0.f;
#define PREP_LOAD(u_) do { const int t_ = opaque_tid(), tr_ = t_ >> 3, cg_ = t_ & 7, h_ = ((u_) >> 5) & 7, nch_ = (u_) & 31; const size_t t0_ = (size_t)((u_) >> 8) * SEQ + 64 * nch_; \
        _Pragma("unroll") for (int tens = 0; tens < 3; ++tens) { const bf16_t* src = GQ + (size_t)tens * T * 1024 + (t0_ + tr_) * 1024 + h_ * 128 + 16 * cg_; own[tens][0] = *(const u32x4*)src; own[tens][1] = *(const u32x4*)(src + 8); } \
        halo = (u32x4){0u, 0u, 0u, 0u}; \
        if (t_ < 144 && nch_ > 0) { const int tens = t_ / 48, rem = t_ % 48; halo = *(const u32x4*)(GQ + (size_t)tens * T * 1024 + (t0_ - 3 + (rem >> 4)) * 1024 + h_ * 128 + (rem & 15) * 8); } \
        _Pragma("unroll") for (int i = 0; i < 3; ++i) { const int ii = t_ + 512 * i; cwr[i] = convw[((ii >> 7) & 3) * 3072 + (ii >> 9) * 1024 + h_ * 128 + (ii & 127)]; } \
        if (cg_ == 0) { bar0 = BA[(t0_ + tr_) * 16 + h_]; bar1 = BA[(t0_ + tr_) * 16 + 8 + h_]; } } while (0)
    if (F.blk < 2048) { PREP_LOAD(F.blk); }
#pragma unroll 1
    for (int u = F.blk; u < 2048; u += F.G) {
        const int tid = opaque_tid(), lane = tid & 63, wave = __builtin_amdgcn_readfirstlane(tid >> 6), n = lane & 15, g = lane >> 4;
        const int h = (u >> 5) & 7, nch = u & 31;
        const int tr = tid >> 3, cg = tid & 7;
        __syncthreads();
#pragma unroll
        for (int i = 0; i < 3; ++i) CW[tid + 512 * i] = cwr[i];
#pragma unroll
        for (int tens = 0; tens < 3; ++tens) { LAS unsigned char* rp = RAW + (tens * 67 + 3 + tr) * 272 + 32 * cg; *(LAS u32x4*)rp = own[tens][0]; *(LAS u32x4*)(rp + 16) = own[tens][1]; }
        if (tid < 144) { const int tens = tid / 48, rem = tid % 48; *(LAS u32x4*)(RAW + (tens * 67 + (rem >> 4)) * 272 + (rem & 15) * 16) = halo; }
        __syncthreads();
        float qv[16], kv[16];
        {
            float vv[16];
#pragma unroll
            for (int tens = 0; tens < 3; ++tens) {
                float acc[16];
#pragma unroll
                for (int c = 0; c < 16; ++c) acc[c] = 0.f;
#pragma unroll
                for (int j = 0; j < 4; ++j) { const LAS unsigned char* rp = RAW + (tens * 67 + tr + j) * 272 + 32 * cg; const u32x4 x0 = *(const LAS u32x4*)rp, x1 = *(const LAS u32x4*)(rp + 16);
                        const LAS float* w = CW + (tens * 4 + j) * 128 + 16 * cg;
#pragma unroll
                        for (int i = 0; i < 4; ++i) { acc[2 * i] += w[2 * i] * bflo(x0[i]); acc[2 * i + 1] += w[2 * i + 1] * bfhi(x0[i]); acc[8 + 2 * i] += w[8 + 2 * i] * bflo(x1[i]); acc[9 + 2 * i] += w[9 + 2 * i] * bfhi(x1[i]); } }
#pragma unroll
                for (int c = 0; c < 16; ++c) { const float y = siluf_(acc[c]); if (tens == 0) qv[c] = y; else if (tens == 1) kv[c] = y; else vv[c] = y; }
            }
            float sq = 0.f, sk = 0.f;
#pragma unroll
            for (int c = 0; c < 16; ++c) { sq += qv[c] * qv[c]; sk += kv[c] * kv[c]; }
            sq = red8(sq); sk = red8(sk);
            const float rq = rsqrtf(sq + EPS) * 0.08838834764831845f, rk = rsqrtf(sk + EPS);
#pragma unroll
            for (int c = 0; c < 16; ++c) { qv[c] *= rq; kv[c] *= rk; }
#pragma unroll
            for (int hf = 0; hf < 2; ++hf) { u32x4 a, bq, cq;
#pragma unroll
                for (int i = 0; i < 4; ++i) { a[i] = pk2(kv[8 * hf + 2 * i], kv[8 * hf + 2 * i + 1]); bq[i] = pk2(qv[8 * hf + 2 * i], qv[8 * hf + 2 * i + 1]); cq[i] = pk2(vv[8 * hf + 2 * i], vv[8 * hf + 2 * i + 1]); }
                const unsigned o = off_b(tr, 2 * cg + hf);
                *(LAS u32x4*)(Kn + o) = a; *(LAS u32x4*)(Qn + o) = bq; *(LAS u32x4*)(Vn + o) = cq; }
        }
        if (cg == 0) { const float bb = bar0, aa = bar1; const float sp = aa + inp(I_DTB)[h]; const float spl = sp > 20.f ? sp : log1pf(__expf(sp));
            betaS[tr] = sigmoidf_(bb); gS[tr] = -__expf(inp(I_ALOG)[h]) * spl; }
        __syncthreads();
        if (wave == 0) { float v = gS[lane];
#pragma unroll
            for (int d = 1; d < 64; d <<= 1) { const float t = __shfl_up(v, d); if (lane >= d) v += t; }
            gcS[lane] = v; }
        __syncthreads();
        {
            const float eg = __expf(gcS[tr]);
            u32x4 a, bq;
#pragma unroll
            for (int i = 0; i < 4; ++i) { a[i] = pk2(qv[2 * i] * eg, qv[2 * i + 1] * eg); bq[i] = pk2(qv[8 + 2 * i] * eg, qv[9 + 2 * i] * eg); }
            bf16_t* d = QD + (size_t)u * 8192 + (size_t)(((tr >> 4) * 4 + (cg >> 1)) * 64 + (tr & 15)) * 8;
            *(u32x4*)(d + (((2 * cg) & 3) * 16) * 8) = a; *(u32x4*)(d + (((2 * cg + 1) & 3) * 16) * 8) = bq;
        }
        if (u + F.G < 2048) { PREP_LOAD(u + F.G); }
        const float gcl = gcS[63];
        if (tid == 0) GT[u] = __expf(gcl);
#pragma unroll
        for (int rep = 0; rep < 2; ++rep) {
            const int idx = wave + 8 * rep, ti = idx >> 2, tj = idx & 3;
            f32x4 kk = {0.f, 0.f, 0.f, 0.f}, qk = {0.f, 0.f, 0.f, 0.f};
            if (ti >= tj) {
#pragma unroll
                for (int ks = 0; ks < 4; ++ks) { const bf16x8 a = *(const LAS bf16x8*)(Kn + rowfrag_b(lane, ti, ks)), bb = *(const LAS bf16x8*)(Kn + rowfrag_b(lane, tj, ks));
                    kk = __builtin_amdgcn_mfma_f32_16x16x32_bf16(a, bb, kk, 0, 0, 0); }
#pragma unroll
                for (int ks = 0; ks < 4; ++ks) { const bf16x8 a = *(const LAS bf16x8*)(Kn + rowfrag_b(lane, tj, ks)), bb = *(const LAS bf16x8*)(Qn + rowfrag_b(lane, ti, ks));
                    qk = __builtin_amdgcn_mfma_f32_16x16x32_bf16(a, bb, qk, 0, 0, 0); }
            }
            {
                const int j = 16 * tj + n; const float gj = gcS[j];
#pragma unroll
                for (int reg = 0; reg < 4; ++reg) { const int i = 16 * ti + 4 * g + reg; float v = 0.f; if (j < i) v = kk[reg] * betaS[i] * __expf(gcS[i] - gj);
                    Af[i * 65 + j] = v; st_b16(R0, i, j, ti > tj ? v : 0.f); }
            }
            {
                const int i = 16 * ti + n; const float gi = gcS[i]; float o[4];
#pragma unroll
                for (int reg = 0; reg < 4; ++reg) { const int j = 16 * tj + 4 * g + reg; o[reg] = (j <= i) ? qk[reg] * __expf(gi - gcS[j]) : 0.f; }
                u32x2 w; w.x = pk2(o[0], o[1]); w.y = pk2(o[2], o[3]);
                *(u32x2*)(QK + (size_t)u * 4096 + (size_t)((ti * 2 + (tj >> 1)) * 64 + ((2 * tj + (g >> 1)) & 3) * 16 + n) * 8 + 4 * (g & 1)) = w;
            }
        }
        for (int i = tid; i < 9216 / 4; i += 512) ((LAS unsigned*)R1)[i] = 0u;
#pragma unroll
        for (int it = 0; it < 2; ++it) { const int c = tid & 127, tok0 = 8 * ((tid >> 7) + 4 * it); u32x4 w;
#pragma unroll
            for (int e2 = 0; e2 < 4; ++e2) { float v[2];
#pragma unroll
                for (int e1 = 0; e1 < 2; ++e1) { const int tok = tok0 + 2 * e2 + e1; const unsigned short kb = *(const LAS unsigned short*)(Kn + off_b(tok, c >> 3) + (c & 7) * 2); v[e1] = bf2f(kb) * __expf(gcl - gcS[tok]); }
                w[e2] = pk2(v[0], v[1]); }
            *(u32x4*)(KDT + (size_t)u * 8192 + (size_t)(((c >> 4) * 2 + (tok0 >> 5)) * 64 + ((tok0 >> 3) & 3) * 16 + (c & 15)) * 8) = w; }
        __syncthreads();
        if (tid < 64) { const int bI = tid >> 4, cc = tid & 15; float x[16];
#pragma unroll
            for (int i = 0; i < 16; ++i) { float s = (i == cc) ? 1.f : 0.f;
#pragma unroll
                for (int j = 0; j < 16; ++j) if (j < i) s -= Af[(16 * bI + i) * 65 + 16 * bI + j] * x[j];
                x[i] = s; }
#pragma unroll
            for (int i = 0; i < 16; ++i) st_b16(R1, 16 * bI + i, 16 * bI + cc, x[i]); }
        __syncthreads();
#pragma unroll
        for (int rep = 0; rep < 2; ++rep) { const int idx = wave + 8 * rep, ti = idx >> 2, tj = idx & 3; const f32x4 m = mm64_tile(R1, R0, ti, tj, lane);
#pragma unroll
            for (int reg = 0; reg < 4; ++reg) { const int i = 16 * ti + 4 * g + reg, j = 16 * tj + n; st_b16(R2, i, j, m[reg]); st_b16(R3, i, j, (i == j ? 1.f : 0.f) - m[reg]); } }
        __syncthreads();
#pragma unroll
        for (int rep = 0; rep < 2; ++rep) { const int idx = wave + 8 * rep, ti = idx >> 2, tj = idx & 3; const f32x4 m = mm64_tile(R2, R2, ti, tj, lane);
#pragma unroll
            for (int reg = 0; reg < 4; ++reg) { const int i = 16 * ti + 4 * g + reg, j = 16 * tj + n; st_b16(R4, i, j, (i == j ? 1.f : 0.f) + m[reg]); } }
        __syncthreads();
#pragma unroll
        for (int rep = 0; rep < 2; ++rep) { const int idx = wave + 8 * rep, ti = idx >> 2, tj = idx & 3; const f32x4 m = mm64_tile(R4, R1, ti, tj, lane);
#pragma unroll
            for (int reg = 0; reg < 4; ++reg) { const int i = 16 * ti + 4 * g + reg, j = 16 * tj + n; st_b16(R0, i, j, m[reg]); } }
        __syncthreads();
#pragma unroll
        for (int rep = 0; rep < 2; ++rep) { const int idx = wave + 8 * rep, ti = idx >> 2, tj = idx & 3; const f32x4 m = mm64_tile(R3, R0, ti, tj, lane);
            const int j = 16 * tj + n; const float bj = betaS[j], bw = bj * __expf(gcS[j]);
#pragma unroll
            for (int reg = 0; reg < 4; ++reg) { const int i = 16 * ti + 4 * g + reg; st_b16(R2, i, j, m[reg] * bj); st_b16(R4, i, j, m[reg] * bw); } }
        __syncthreads();
        {
            const int tt = wave >> 1, dvb = 4 * (wave & 1);
#pragma unroll
            for (int k = 0; k < 4; ++k) { const int dvt = dvb + k; f32x4 acc = {0.f, 0.f, 0.f, 0.f};
#pragma unroll
                for (int ks = 0; ks < 2; ++ks) { const bf16x8 a = *(const LAS bf16x8*)(R2 + (16 * tt + n) * MST + 16 * (4 * ks + g));
                    const bf16x8 bb = tr_pair(Vn + trfrag_b(lane, dvt, ks, 0), Vn + trfrag_b(lane, dvt, ks, 1));
                    acc = __builtin_amdgcn_mfma_f32_16x16x32_bf16(a, bb, acc, 0, 0, 0); }
                u32x2 w; w.x = pk2(acc[0], acc[1]); w.y = pk2(acc[2], acc[3]);
                *(u32x2*)(UT + (size_t)u * 8192 + (size_t)((tt * 8 + dvt) * 64 + lane) * 4) = w; }
            const int dkt = wave;
#pragma unroll
            for (int t4 = 0; t4 < 4; ++t4) { f32x4 acc = {0.f, 0.f, 0.f, 0.f};
#pragma unroll
                for (int ks = 0; ks < 2; ++ks) { const bf16x8 a = tr_pair(Kn + trfrag_b(lane, dkt, ks, 0), Kn + trfrag_b(lane, dkt, ks, 1));
                    const bf16x8 bb = *(const LAS bf16x8*)(R4 + (16 * t4 + n) * MST + 16 * (4 * ks + g));
                    acc = __builtin_amdgcn_mfma_f32_16x16x32_bf16(a, bb, acc, 0, 0, 0); }
                u32x2 w; w.x = pk2(acc[0], acc[1]); w.y = pk2(acc[2], acc[3]);
                *(u32x2*)(WM + (size_t)u * 8192 + (size_t)((t4 * 4 + (dkt >> 1)) * 64 + ((2 * dkt + (g >> 1)) & 3) * 16 + n) * 8 + 4 * (g & 1)) = w; }
        }
    }
}

#undef PREP_LOAD
__device__ __forceinline__ void p4_gdn_scan(Frame& F) {
    if (F.blk >= 64) return;
    const int tid = opaque_tid(), lane = tid & 63, wave = __builtin_amdgcn_readfirstlane(tid >> 6), n = lane & 15, g = lane >> 4;
    const int b = F.blk >> 3, h = F.blk & 7; const size_t u0 = (size_t)F.blk * 32;
    LAS unsigned char* SbT0 = F.lds; LAS unsigned char* VNT = F.lds + 69632; LAS unsigned char* Os0 = F.lds + 88064; LAS float* ngS = (LAS float*)(F.lds + 122880);
    const bf16_t* UT = (const bf16_t*)(F.ws + WS_UT); const bf16_t* WM = (const bf16_t*)(F.ws + WS_WM); const bf16_t* QD = (const bf16_t*)(F.ws + WS_QD);
    const bf16_t* KDT = (const bf16_t*)(F.ws + WS_KDT); const bf16_t* QK = (const bf16_t*)(F.ws + WS_QK); const float* GT = (const float*)(F.ws + WS_GT);
    const bf16_t* GZ = (const bf16_t*)(F.ob + OUT_GZ); bf16_t* YA = (bf16_t*)(F.ws + WS_YA);
    const int tt = wave >> 1, dvb = 4 * (wave & 1);
    const int tok = tid >> 3, seg = tid & 7;
    f32x4 S[8];
#pragma unroll
    for (int i = 0; i < 8; ++i) S[i] = (f32x4){0.f, 0.f, 0.f, 0.f};
    if (tid < 128) ngS[tid] = inp(I_GNG)[tid];
    bf16x8 wfA[4], wfB[4], qdf[4], qkf[2], kdf[2]; u32x2 ufA[4], ufB[4]; u32x4 zc[2], zp[2]; float gtA, gtB;
    const unsigned lo_w = (unsigned)((tt * 4) * 64 + lane) * 16u, lo_u = (unsigned)((tt * 8 + dvb) * 64 + lane) * 8u, lo_qk = (unsigned)((tt * 2) * 64 + lane) * 16u,
                   lo_kd = (unsigned)((wave * 2) * 64 + lane) * 16u, lo_z = (unsigned)(tok * 1024 + h * 128 + 16 * seg) * 2u;
    const char* const pWM = (const char*)(WM + u0 * 8192); const char* const pQD = (const char*)(QD + u0 * 8192); const char* const pUT = (const char*)(UT + u0 * 8192);
    const char* const pKD = (const char*)(KDT + u0 * 8192); const char* const pQK = (const char*)(QK + u0 * 4096); const char* const pGZ = (const char*)(GZ + (size_t)b * SEQ * 1024);
#define LD_SET(X, nn_) do { const size_t c16_ = (size_t)(nn_) * 16384; \
        _Pragma("unroll") for (int ks = 0; ks < 4; ++ks) wf##X[ks] = *(const bf16x8*)(pWM + c16_ + lo_w + 1024 * ks); \
        _Pragma("unroll") for (int k = 0; k < 4; ++k) uf##X[k] = *(const u32x2*)(pUT + c16_ + lo_u + 512 * k); \
        gt##X = GT[u0 + (nn_)]; } while (0)
#define LD_MID(nn_) do { const size_t c16_ = (size_t)(nn_) * 16384, c8_ = (size_t)(nn_) * 8192, cz_ = (size_t)(nn_) * 64 * 2048; \
        _Pragma("unroll") for (int ks = 0; ks < 4; ++ks) qdf[ks] = *(const bf16x8*)(pQD + c16_ + lo_w + 1024 * ks); \
        _Pragma("unroll") for (int ks = 0; ks < 2; ++ks) qkf[ks] = *(const bf16x8*)(pQK + c8_ + lo_qk + 1024 * ks); \
        _Pragma("unroll") for (int ks = 0; ks < 2; ++ks) kdf[ks] = *(const bf16x8*)(pKD + c16_ + lo_kd + 1024 * ks); \
        zc[0] = *(const u32x4*)(pGZ + cz_ + lo_z); zc[1] = *(const u32x4*)(pGZ + cz_ + lo_z + 16); } while (0)
#define NORM_OUT(OsB, nc_, Z) do { const size_t t = (size_t)b * SEQ + 64 * (nc_) + tok; \
        const u32x4 o0 = *(const LAS u32x4*)((OsB) + tok * 272 + 32 * seg), o1 = *(const LAS u32x4*)((OsB) + tok * 272 + 32 * seg + 16); float o[16]; float ss = 0.f; \
        _Pragma("unroll") for (int i = 0; i < 4; ++i) { o[2 * i] = bflo(o0[i]); o[2 * i + 1] = bfhi(o0[i]); o[8 + 2 * i] = bflo(o1[i]); o[9 + 2 * i] = bfhi(o1[i]); } \
        _Pragma("unroll") for (int i = 0; i < 16; ++i) ss += o[i] * o[i]; \
        ss = red8(ss); \
        const float rstd = rsqrtf(ss * (1.f / 128.f) + EPS); \
        u32x4 y0, y1; \
        _Pragma("unroll") for (int i = 0; i < 4; ++i) { y0[i] = pk2(o[2 * i] * rstd * ngS[16 * seg + 2 * i] * siluf_(bflo(Z[0][i])), o[2 * i + 1] * rstd * ngS[16 * seg + 2 * i + 1] * siluf_(bfhi(Z[0][i]))); \
            y1[i] = pk2(o[8 + 2 * i] * rstd * ngS[16 * seg + 8 + 2 * i] * siluf_(bflo(Z[1][i])), o[9 + 2 * i] * rstd * ngS[16 * seg + 9 + 2 * i] * siluf_(bfhi(Z[1][i]))); } \
        *(u32x4*)(YA + t * 1024 + h * 128 + 16 * seg) = y0; *(u32x4*)(YA + t * 1024 + h * 128 + 16 * seg + 8) = y1; } while (0)
#define CHUNK(X, nc_, P) do { LAS unsigned char* const SbT = SbT0 + (P) * 34816; LAS unsigned char* const OsW = Os0 + (P) * 17408; \
          \
        _Pragma("unroll") for (int dvt = 0; dvt < 8; ++dvt) { u32x2 w; w.x = pk2(S[dvt][0], S[dvt][1]); w.y = pk2(S[dvt][2], S[dvt][3]); \
            *(LAS u32x2*)(SbT + (16 * dvt + n) * 272 + (16 * wave + 4 * g) * 2) = w; } \
        __syncthreads(); \
          \
        if ((nc_) > 0) { NORM_OUT(Os0 + (1 - (P)) * 17408, (nc_) - 1, zp); } \
          \
        { f32x4 acc[4]; \
          _Pragma("unroll") for (int k = 0; k < 4; ++k) acc[k] = (f32x4){0.f, 0.f, 0.f, 0.f}; \
          _Pragma("unroll") for (int ks = 0; ks < 4; ++ks) { bf16x8 bb[4]; \
            _Pragma("unroll") for (int k = 0; k < 4; ++k) bb[k] = *(const LAS bf16x8*)(SbT + (16 * (dvb + k) + n) * 272 + 16 * (4 * ks + g)); \
            _Pragma("unroll") for (int k = 0; k < 4; ++k) acc[k] = __builtin_amdgcn_mfma_f32_16x16x32_bf16(wf##X[ks], bb[k], acc[k], 0, 0, 0); } \
          _Pragma("unroll") for (int k = 0; k < 4; ++k) { u32x2 w; w.x = pk2(bflo(uf##X[k].x) - acc[k][0], bfhi(uf##X[k].x) - acc[k][1]); w.y = pk2(bflo(uf##X[k].y) - acc[k][2], bfhi(uf##X[k].y) - acc[k][3]); \
            *(LAS u32x2*)(VNT + (16 * (dvb + k) + n) * MST + (16 * tt + 4 * g) * 2) = w; } } \
        __syncthreads(); \
          \
        { f32x4 acc[4]; \
          _Pragma("unroll") for (int k = 0; k < 4; ++k) acc[k] = (f32x4){0.f, 0.f, 0.f, 0.f}; \
          _Pragma("unroll") for (int ks = 0; ks < 4; ++ks) { bf16x8 bb[4]; \
            _Pragma("unroll") for (int k = 0; k < 4; ++k) bb[k] = *(const LAS bf16x8*)(SbT + (16 * (dvb + k) + n) * 272 + 16 * (4 * ks + g)); \
            _Pragma("unroll") for (int k = 0; k < 4; ++k) acc[k] = __builtin_amdgcn_mfma_f32_16x16x32_bf16(qdf[ks], bb[k], acc[k], 0, 0, 0); } \
          _Pragma("unroll") for (int ks = 0; ks < 2; ++ks) { bf16x8 bb[4]; \
            _Pragma("unroll") for (int k = 0; k < 4; ++k) bb[k] = *(const LAS bf16x8*)(VNT + (16 * (dvb + k) + n) * MST + 16 * (4 * ks + g)); \
            _Pragma("unroll") for (int k = 0; k < 4; ++k) acc[k] = __builtin_amdgcn_mfma_f32_16x16x32_bf16(qkf[ks], bb[k], acc[k], 0, 0, 0); } \
          _Pragma("unroll") for (int k = 0; k < 4; ++k) _Pragma("unroll") for (int reg = 0; reg < 4; ++reg) \
              *(LAS unsigned short*)(OsW + (16 * tt + 4 * g + reg) * 272 + (16 * (dvb + k) + n) * 2) = (unsigned short)pk2(acc[k][reg], 0.f); } \
          \
        _Pragma("unroll") for (int dvt = 0; dvt < 8; ++dvt) S[dvt] = S[dvt] * gt##X; \
        _Pragma("unroll") for (int ks = 0; ks < 2; ++ks) { bf16x8 bb[8]; \
            _Pragma("unroll") for (int dvt = 0; dvt < 8; ++dvt) bb[dvt] = *(const LAS bf16x8*)(VNT + (16 * dvt + n) * MST + 16 * (4 * ks + g)); \
            _Pragma("unroll") for (int dvt = 0; dvt < 8; ++dvt) S[dvt] = __builtin_amdgcn_mfma_f32_16x16x32_bf16(kdf[ks], bb[dvt], S[dvt], 0, 0, 0); } \
        zp[0] = zc[0]; zp[1] = zc[1]; \
    } while (0)
    LD_SET(A, 0);
#pragma unroll 1
    for (int nc = 0; nc < 32; nc += 2) {
        LD_MID(nc); LD_SET(B, nc + 1);
        CHUNK(A, nc, 0);
        LD_MID(nc + 1); if (nc + 2 < 32) { LD_SET(A, nc + 2); }
        CHUNK(B, nc + 1, 1);
    }
    __syncthreads();
    NORM_OUT(Os0 + 17408, 31, zp);
#undef LD_SET
#undef LD_MID
#undef NORM_OUT
#undef CHUNK
}

__device__ __forceinline__ void p7_route(Frame& F, const bool emit) {
    const int ftid = opaque_tid(), flane = ftid & 63, fwave = __builtin_amdgcn_readfirstlane(ftid >> 6);
    constexpr int HS = 132, WSS = 80, LS = 65;
    LAS float* Hs = (LAS float*)F.lds;
    LAS float* Wsm = (LAS float*)(F.lds + 34816);
    LAS float* Ls = (LAS float*)(F.lds + 77824);
    LAS float* SelS = (LAS float*)(F.lds + 96256);
    LAS int* hist = (LAS int*)(F.lds + 114688);
    const float* MOD = (const float*)(F.ws + WS_MOD); const float* X1 = F.out; bf16_t* H2 = (bf16_t*)(F.ws + WS_H);
    int* LIST = (int*)(F.ws + WS_LIST); float* LISTW = (float*)(F.ws + WS_LISTW); gu32* gcnt = (gu32*)(F.ws + WS_CTL) + CW_CNT;
    const int tid = ftid, lane = flane, wave = fwave;
    for (int grp = F.blk; grp < T / 64; grp += F.G) {
        const int row0 = grp * 64, b = row0 / SEQ;
        const float* sh2 = MOD + b * 6144 + 3 * 1024; const float* sc2 = sh2 + 1024;
        float rstd[8];
#pragma unroll
        for (int hb = 0; hb < 2; ++hb) {
            f32x4 xx[4][4];
#pragma unroll
            for (int rr = 0; rr < 4; ++rr) { const f32x4* xr = (const f32x4*)(X1 + (size_t)(row0 + 8 * wave + 4 * hb + rr) * DM) + lane;
#pragma unroll
                for (int j = 0; j < 4; ++j) xx[rr][j] = xr[64 * j]; }
#pragma unroll
            for (int rr = 0; rr < 4; ++rr) { float ss = 0.f;
#pragma unroll
                for (int j = 0; j < 4; ++j) { const f32x4 v = xx[rr][j]; ss += (v.x * v.x + v.y * v.y) + (v.z * v.z + v.w * v.w); }
                rstd[4 * hb + rr] = rsqrtf(wave_sum(ss) * (1.f / DM) + EPS); }
        }
        f32x4 acc0 = {0.f, 0.f, 0.f, 0.f}, acc1 = {0.f, 0.f, 0.f, 0.f};
        const int rg = wave & 3, et = (wave >> 2) * 2;
        f32x2 xn[8];
#pragma unroll
        for (int rr = 0; rr < 8; ++rr) xn[rr] = *(const f32x2*)(X1 + (size_t)(row0 + 8 * wave + rr) * DM + 2 * lane);
        for (int c = 0; c < 8; ++c) {
            const int k = c * 128 + 2 * lane;
            const f32x2 g2 = *(const f32x2*)(inp(I_GFFN) + k), s2 = *(const f32x2*)(sc2 + k), h2 = *(const f32x2*)(sh2 + k);
#pragma unroll
            for (int rr = 0; rr < 8; ++rr) { const size_t row = (size_t)(row0 + 8 * wave + rr);
                const f32x2 xv = xn[rr];
                const f32x2 hv = (xv * rstd[rr]) * g2 * (s2 + 1.0f) + h2;
                *(LAS f32x2*)(Hs + (8 * wave + rr) * HS + 2 * lane) = hv;
                *(unsigned*)(H2 + row * DM + k) = pk2(hv.x, hv.y); }
#pragma unroll
            for (int j = 0; j < 4; ++j) { const int kk = (tid >> 4) + 32 * j, e4 = (tid & 15) * 4;
                *(LAS f32x4*)(Wsm + kk * WSS + e4) = *(const f32x4*)(inp(I_WR) + (size_t)(c * 128 + kk) * 64 + e4); }
            __syncthreads();
            if (c < 7) {
#pragma unroll
                for (int rr = 0; rr < 8; ++rr) xn[rr] = *(const f32x2*)(X1 + (size_t)(row0 + 8 * wave + rr) * DM + (c + 1) * 128 + 2 * lane); }
#pragma unroll 4
            for (int kk = 0; kk < 32; ++kk) {
                const float a = Hs[(rg * 16 + (lane & 15)) * HS + 4 * kk + (lane >> 4)];
                const float b0 = Wsm[(4 * kk + (lane >> 4)) * WSS + et * 16 + (lane & 15)], b1 = Wsm[(4 * kk + (lane >> 4)) * WSS + et * 16 + 16 + (lane & 15)];
                acc0 = __builtin_amdgcn_mfma_f32_16x16x4f32(a, b0, acc0, 0, 0, 0);
                acc1 = __builtin_amdgcn_mfma_f32_16x16x4f32(a, b1, acc1, 0, 0, 0);
            }
            __syncthreads();
        }
#pragma unroll
        for (int reg = 0; reg < 4; ++reg) { const int r = rg * 16 + 4 * (lane >> 4) + reg; Ls[r * LS + et * 16 + (lane & 15)] = acc0[reg]; Ls[r * LS + et * 16 + 16 + (lane & 15)] = acc1[reg]; }
        if (tid < 128) hist[tid] = 0;
        __syncthreads();
        {
            const int r = tid >> 3, q = tid & 7;
            float s[8], sel[8];
#pragma unroll
            for (int i = 0; i < 8; ++i) { s[i] = sigmoidf_(Ls[r * LS + q * 8 + i]); sel[i] = s[i] + inp(I_RB)[q * 8 + i]; }
            float m1 = -INFINITY, m2 = -INFINITY;
#pragma unroll
            for (int i = 0; i < 8; ++i) { const float v = sel[i]; if (v > m1) { m2 = m1; m1 = v; } else if (v > m2) m2 = v; }
            const float gs = m1 + m2;
            int rank = 0;
#pragma unroll
            for (int j = 0; j < 8; ++j) { const float o = __shfl(gs, (lane & ~7) + j); rank += ((o > gs) || (o == gs && j < q)) ? 1 : 0; }
            const bool gsel = rank < 4;
#pragma unroll
            for (int i = 0; i < 8; ++i) SelS[r * 64 + q * 8 + i] = gsel ? sel[i] : -INFINITY;
            __syncthreads();
            int cn[8];
#pragma unroll
            for (int i = 0; i < 8; ++i) cn[i] = 0;
            for (int j = 0; j < 64; ++j) { const float o = SelS[r * 64 + j];
#pragma unroll
                for (int i = 0; i < 8; ++i) cn[i] += ((o > sel[i]) || (o == sel[i] && j < q * 8 + i)) ? 1 : 0; }
            float part = 0.f;
#pragma unroll
            for (int i = 0; i < 8; ++i) if (gsel && cn[i] < 8) part += s[i];
            part = red8(part);
            const float inv = 2.5f / part;
            int lp[8];
#pragma unroll
            for (int i = 0; i < 8; ++i) { lp[i] = -1; if (emit && gsel && cn[i] < 8) lp[i] = atomicAdd((int*)(hist + q * 8 + i), 1); }
            __syncthreads();
            if (emit && tid < 64) hist[64 + tid] = (int)__hip_atomic_fetch_add(gcnt + tid, (unsigned)hist[tid], RLX_AGENT);
            __syncthreads();
#pragma unroll
            for (int i = 0; i < 8; ++i) if (lp[i] >= 0) { const int e = q * 8 + i; const size_t li = (size_t)e * T + hist[64 + e] + lp[i]; LIST[li] = (row0 + r) * 8 + cn[i]; LISTW[li] = s[i] * inv; }
            __syncthreads();
        }
    }
}


__device__ __forceinline__ void p9_combine(Frame& F) {
    const int tid = opaque_tid();
    const float* MOD = (const float*)(F.ws + WS_MOD); const unsigned char* SLOT = F.ws + WS_SLOT; const bf16_t* SH = (const bf16_t*)(F.ws + WS_SH); float* out = F.out;
    for (size_t it = (size_t)F.blk * 512 + tid; it < (size_t)T * 64; it += (size_t)F.G * 512) {
        const size_t t = it >> 6; const int c0 = (int)(it & 63) * 16; const int b = (int)(t / SEQ);
        u32x4 sl[8];
#pragma unroll
        for (int k = 0; k < 8; ++k) sl[k] = *(const u32x4*)(SLOT + (t * 8 + k) * 1024 + c0);
        const u32x4 s0 = *(const u32x4*)(SH + t * 1024 + c0), s1 = *(const u32x4*)(SH + t * 1024 + c0 + 8);
        f32x4 xv[4], gv[4];
#pragma unroll
        for (int i = 0; i < 4; ++i) { xv[i] = *(const f32x4*)(out + t * 1024 + c0 + 4 * i); gv[i] = *(const f32x4*)(MOD + b * 6144 + 5 * 1024 + c0 + 4 * i); }
        float acc[16];
#pragma unroll
        for (int i = 0; i < 4; ++i) { acc[2 * i] = bflo(s0[i]); acc[2 * i + 1] = bfhi(s0[i]); acc[8 + 2 * i] = bflo(s1[i]); acc[9 + 2 * i] = bfhi(s1[i]); }
#pragma unroll
        for (int k = 0; k < 8; ++k)
#pragma unroll
            for (int i = 0; i < 4; ++i) { const f32x2 lo = __builtin_amdgcn_cvt_pk_f32_fp8((int)sl[k][i], false), hi = __builtin_amdgcn_cvt_pk_f32_fp8((int)sl[k][i], true);
                acc[4 * i] += lo.x; acc[4 * i + 1] += lo.y; acc[4 * i + 2] += hi.x; acc[4 * i + 3] += hi.y; }
#pragma unroll
        for (int i = 0; i < 4; ++i) { f32x4 o; o.x = xv[i].x + gv[i].x * acc[4 * i]; o.y = xv[i].y + gv[i].y * acc[4 * i + 1]; o.z = xv[i].z + gv[i].z * acc[4 * i + 2]; o.w = xv[i].w + gv[i].w * acc[4 * i + 3];
            *(f32x4*)(out + t * 1024 + c0 + 4 * i) = o; }
    }
}

struct Args { const float* in[24]; float* out; unsigned char* ws; };
__global__ void __launch_bounds__(512, 2) mega_fwd(Args args) {
    extern __shared__ __attribute__((aligned(16))) unsigned char lds_raw[];
    Frame F;
    F.lds = (LAS unsigned char*)lds_raw;
    F.G = gridDim.x; F.blk = blockIdx.x;
    F.out = args.out; F.ws = args.ws; F.ob = (unsigned char*)args.out;
    volatile LAS unsigned* MISC = (volatile LAS unsigned*)(F.lds + MISC_OFF);
    for (int u = threadIdx.x; u < 64; u += 512) MISC[u] = 0u;
    __syncthreads();
    XcdBarrier bar = xcd_barrier_post((unsigned*)(F.ws + WS_CTL) + CW_BAR, MISC + 8);
#define GRID_BAR() xcd_barrier(bar)
    unsigned char* ws = F.ws;
    const float* MOD = (const float*)(ws + WS_MOD);

#ifndef DUPMASK
#define DUPMASK 0
#endif
#define REP(k) _Pragma("unroll 1") for (int rep_ = 0; rep_ < (((DUPMASK) >> (k)) & 1 ? 2 : 1); ++rep_)
    REP(0) { p0_mod(F); }
    GRID_BAR();
    REP(1) { p1_norm(F); }
    __syncthreads();
    p0_weights(F);
    GRID_BAR();
    REP(2) { pg8::DenseOrder S; S.init(T, NPROJ, 1024, F.G, F.blk, ws + WS_H, ws + WS_WIN);
      EpiProj E{ws, (bf16_t*)(F.ob + OUT_GZ)};
      pg8::gemm_phase<EpiProj, pg8::DenseOrder, true, false>(F.lds, 1024, S, E); }
    GRID_BAR();
    REP(3) { p3_attn(F); }
    GRID_BAR();
    REP(4) { p3b_gdn_prep(F); }
    REP(5) { p3_merge(F); }
    GRID_BAR();
    REP(6) { p4_gdn_scan(F); }
    REP(12) { convert_experts(F, 64, F.G - 64); }
    GRID_BAR();
    REP(7) {
    { pg8::DenseOrder S; S.init(T, 1024, 1024, F.G, F.blk, ws + WS_YA, ws + WS_WUPG); EpiStore E{(bf16_t*)(ws + WS_UA), 1024};
      pg8::gemm_phase<EpiStore, pg8::DenseOrder, true, false>(F.lds, 1024, S, E); }
    { pg8::DenseOrder S; S.init(T, 1024, 512, F.G, F.blk, F.ob + OUT_YB, ws + WS_WUPD); EpiStore E{(bf16_t*)(ws + WS_UB), 1024};
      pg8::gemm_phase<EpiStore, pg8::DenseOrder, true, false>(F.lds, 512, S, E); }
    }
    GRID_BAR();
    REP(8) { pg8::DenseOrder S; S.init(T, 2048, 1024, F.G, F.blk, ws + WS_H, ws + WS_WG); EpiGate E{(const bf16_t*)(ws + WS_UA), (const bf16_t*)(ws + WS_UB), (bf16_t*)(ws + WS_MG)};
      pg8::gemm_phase<EpiGate, pg8::DenseOrder, true, false>(F.lds, 1024, S, E); }
    GRID_BAR();
    REP(9) { pg8::DenseOrder S; S.init(T, 1024, 1024, F.G, F.blk, ws + WS_MG, ws + WS_WOUT); EpiX1 E{inp(I_X), MOD, F.out};
      pg8::gemm_phase<EpiX1, pg8::DenseOrder, true, false>(F.lds, 1024, S, E); }
    GRID_BAR();
    if ((DUPMASK >> 13) & 1) p7_route(F, false);
    p7_route(F, true);
    GRID_BAR();
    REP(10) { MoeTab tb = build_moetab(F);
      G1Order S{tb, F.G, F.blk, (const int*)(ws + WS_LIST), (const char*)(ws + WS_H), (const char*)(ws + WS_WGU), (const char*)(ws + WS_WSGU)};
      LAS int* tokb = (LAS int*)(F.lds + INFO_OFF); LAS float* wkb = (LAS float*)(F.lds + INFO_OFF + 6144);
      S.preload(tokb, wkb, (const float*)(ws + WS_LISTW));
      EpiAct E{tb, wkb, (bf16_t*)(ws + WS_ACT), (bf16_t*)(ws + WS_ACTS)};
      pg8::gemm_phase<EpiAct, G1Order, true, true>(F.lds, 1024, S, E, tokb); }
    GRID_BAR();
    REP(11) { MoeTab tb = build_moetab(F);
      G2Order S{tb, F.G, F.blk, (const char*)(ws + WS_ACT), (const char*)(ws + WS_WD), (const char*)(ws + WS_ACTS), (const char*)(ws + WS_WSD)};
      LAS int* pairb = (LAS int*)(F.lds + INFO_OFF);
      S.preload(pairb, (const int*)(ws + WS_LIST));
      EpiSlot E{tb, pairb, ws + WS_SLOT, (bf16_t*)(ws + WS_SH)};
      pg8::gemm_phase<EpiSlot, G2Order, true, false>(F.lds, 256, S, E); }
    GRID_BAR();
    if ((DUPMASK >> 14) & 1) { for (int r_ = 0; r_ < 13; ++r_) GRID_BAR(); }
    p9_combine(F);
#undef REP
#undef GRID_BAR
}

extern "C" void kernel_launch(void* const* d_in, const int* in_sizes, int n_in, void* d_out, int out_size, void* d_ws, size_t ws_size, hipStream_t stream) {
    static int grid = 0;
    if (grid == 0) {
        if (n_in != 24 || out_size != T * DM || ws_size < WS_END) { fprintf(stderr, "kernel_launch: unexpected shapes / workspace (n_in %d out %d ws %zu, need %zu)\n", n_in, out_size, ws_size, (size_t)WS_END); grid = -1; return; }
        int dev = 0, cus = 0;
        if (hipGetDevice(&dev) != hipSuccess || hipDeviceGetAttribute(&cus, hipDeviceAttributeMultiprocessorCount, dev) != hipSuccess) { grid = -1; return; }
        if (hipFuncSetAttribute((const void*)mega_fwd, hipFuncAttributeMaxDynamicSharedMemorySize, LDS_BYTES) != hipSuccess) { fprintf(stderr, "kernel_launch: hipFuncSetAttribute failed\n"); grid = -1; return; }
        int per_cu = 0;
        if (hipOccupancyMaxActiveBlocksPerMultiprocessor(&per_cu, (const void*)mega_fwd, 512, LDS_BYTES) != hipSuccess || per_cu < 1) fprintf(stderr, "kernel_launch: occupancy query reports %d blocks per CU\n", per_cu);
        (void)hipGetLastError();
        grid = cus;
    }
    if (grid < 0) return;
    if (hipMemsetAsync((char*)d_ws + WS_CTL, 0, CTL_ZERO_BYTES, stream) != hipSuccess) return;
    Args a{};
    for (int i = 0; i < 24; ++i) a.in[i] = (const float*)d_in[i];
    a.out = (float*)d_out; a.ws = (unsigned char*)d_ws;
    hipLaunchKernelGGL(mega_fwd, dim3(grid), dim3(512), LDS_BYTES, stream, a);
}
```

```cpp
#include <hip/hip_runtime.h>
#include <cstdio>
#include <cstdint>

#define LAS __attribute__((address_space(3)))
#define GAS __attribute__((address_space(1)))
typedef unsigned short bf16_t;
typedef short bf16x8 __attribute__((ext_vector_type(8)));
typedef float f32x2 __attribute__((ext_vector_type(2)));
typedef float f32x4 __attribute__((ext_vector_type(4)));
typedef unsigned u32x2 __attribute__((ext_vector_type(2)));
typedef unsigned u32x4 __attribute__((ext_vector_type(4)));

constexpr int BATCH = 8, SEQ = 2048, DM = 1024, T = BATCH * SEQ;
constexpr int IN_W = 10768;
constexpr int NPROJ = 8704;
constexpr int NEXP = 64, DEXP = 256;
constexpr float EPS = 1e-6f;

__device__ __forceinline__ unsigned f2bf(float f) { unsigned u = __builtin_bit_cast(unsigned, f); return (u + 0x7fffu + ((u >> 16) & 1u)) >> 16; }
typedef __bf16 bf16x2_t __attribute__((ext_vector_type(2)));
__device__ __forceinline__ unsigned pk2(float lo, float hi) { const f32x2 v = {lo, hi}; const bf16x2_t b = __builtin_convertvector(v, bf16x2_t); return __builtin_bit_cast(unsigned, b); }
__device__ __forceinline__ float bf2f(unsigned h) { return __builtin_bit_cast(float, h << 16); }
__device__ __forceinline__ float bflo(unsigned w) { return __builtin_bit_cast(float, w << 16); }
__device__ __forceinline__ float bfhi(unsigned w) { return __builtin_bit_cast(float, w & 0xffff0000u); }
__device__ __forceinline__ float sigmoidf_(float x) { return __builtin_amdgcn_rcpf(1.0f + __builtin_amdgcn_exp2f(-1.4426950408889634f * x)); }
__device__ __forceinline__ float siluf_(float x) { return x * __builtin_amdgcn_rcpf(1.0f + __builtin_amdgcn_exp2f(-1.4426950408889634f * x)); }
__device__ __forceinline__ int opaque_tid() { int t = threadIdx.x; asm volatile("" : "+v"(t)); return t; }
template <int CTRL> __device__ __forceinline__ float dppf(float v) { return __builtin_bit_cast(float, __builtin_amdgcn_update_dpp(0, __builtin_bit_cast(int, v), CTRL, 0xF, 0xF, true)); }
__device__ __forceinline__ float red4(float v) { v += dppf<0xB1>(v); v += dppf<0x4E>(v); return v; }
__device__ __forceinline__ float red8(float v) { v = red4(v); v += dppf<0x141>(v); return v; }
__device__ __forceinline__ float red16(float v) { v = red8(v); v += dppf<0x140>(v); return v; }
__device__ __forceinline__ float wave_sum(float v) { v = red16(v); v += __shfl_xor(v, 16); v += __shfl_xor(v, 32); return v; }

namespace pg8 {
#define PG8_LAS __attribute__((address_space(3)))
constexpr int BM = 256, BK = 64, HALF = 128, HTB = HALF * BK * 2, STAGE_BYTES = 8 * HTB, NXCD = 8, WGM = 8;

__host__ __device__ __forceinline__ int lds_byte(int r, int c) { const int st = (r >> 4) * 2 + (c >> 5), rr = r & 15, cc = c & 31, ob = rr * 64 + cc * 2; return st * 1024 + (ob ^ (((ob >> 9) & 1) << 5)); }
__host__ __device__ __forceinline__ void stage_rc(int b, int& R, int& C) { const int st = b / 1024, sb = b % 1024, swz = sb ^ (((sb >> 9) & 1) << 5); R = (st >> 1) * 16 + swz / 64; C = (st & 1) * 32 + (swz % 64) / 2; }
__host__ __device__ __forceinline__ int perm32(int rho) { const int n = rho >> 4, i = rho & 15; return 8 * (i >> 2) + 4 * n + (i & 3); }

struct Unit { int pm, pn; const char* Ap; const char* Bp; int e, mt; };

struct DenseOrder {
    int nM, nN, nwg, G, c; const char* A; const char* Bt; size_t tstep;
    __device__ __forceinline__ void init(int M, int N, int K, int G_, int c_, const void* A_, const void* Bt_) { nM = M / BM; nN = N / BM; nwg = nM * nN; G = G_; c = c_; A = (const char*)A_; Bt = (const char*)Bt_; tstep = (size_t)BM * K * 2; }
    __device__ __forceinline__ bool next(int i, Unit& u) const {
        const long L = (long)i * G + c; if (L >= nwg) return false;
        int wgid = (int)L; { const int q = nwg / NXCD, r = nwg % NXCD, xcd = wgid % NXCD, off = wgid / NXCD; wgid = (xcd < r ? xcd * (q + 1) : r * (q + 1) + (xcd - r) * q) + off; }
        const int nig = WGM * nN, gid = wgid / nig, fm = gid * WGM, gsz = (nM - fm) < WGM ? (nM - fm) : WGM;
        u.pm = fm + ((wgid % nig) % gsz); u.pn = (wgid % nig) / gsz; u.Ap = A + (size_t)u.pm * tstep; u.Bp = Bt + (size_t)u.pn * tstep; u.e = 0; u.mt = 0; return true;
    }
    __device__ __forceinline__ unsigned a_off(const Unit&, int r, int K) const { return (unsigned)(r * K) * 2u; }
};

__device__ __forceinline__ unsigned cvt_pk_bf16(float lo, float hi) { unsigned r; asm volatile("v_cvt_pk_bf16_f32 %0, %1, %2" : "=v"(r) : "v"(lo), "v"(hi)); return r; }

template <class Epi, class Sched, bool ALIGN_EPI, bool GATHER>
__device__ __forceinline__ void gemm_phase(PG8_LAS unsigned char* lds, const int K, const Sched& S, const Epi& E, PG8_LAS int* tokb = nullptr) {
    const int tid = opaque_tid(), wid = __builtin_amdgcn_readfirstlane(tid >> 6), lane = tid & 63, wr = wid >> 2, wc = wid & 3, fr = lane & 15, fq = lane >> 4;
    const int nt = K / BK;
    unsigned voffB[2];
#pragma unroll
    for (int i = 0; i < 2; ++i) { int R, C; stage_rc(tid * 16 + i * 8192, R, C); const int Rb = Epi::PERM ? ((R & ~31) + perm32(R & 31)) : R;
        voffB[i] = (unsigned)(Rb * K + C) * 2u; }
    const size_t kstep = (size_t)(BK * 2);
    const size_t hstep = (size_t)HALF * K * 2;
    const unsigned ldsw = (unsigned)wid * 1024u;
    const int aoff = lds_byte(wr * 64 + fr, fq * 8), boff = lds_byte(wc * 32 + fr, fq * 8);
#define PG8_SA(b, h) (((b) * 2 + (h)) * HTB)
#define PG8_SB(b, h) ((4 + (b) * 2 + (h)) * HTB)
#define PG8_GLDS(gptr, bufoff, i_) __builtin_amdgcn_global_load_lds((const unsigned*)(gptr), (PG8_LAS unsigned*)(lds + (bufoff) + ldsw + (i_) * 8192), 16, 0, 0)
#define PG8_STAGE_B(bufoff, gbase) do { _Pragma("unroll") for (int _i = 0; _i < 2; ++_i) PG8_GLDS((const char*)(gbase) + voffB[_i], bufoff, _i); } while (0)
#define PG8_STAGE_A(bufoff, gbase, h) do { _Pragma("unroll") for (int _i = 0; _i < 2; ++_i) PG8_GLDS((const char*)(gbase) + vAc[h][_i], bufoff, _i); } while (0)
#define PG8_STAGE_A2(bufoff, gbase, h) PG8_STAGE_A(bufoff, gbase, h)
#define PG8_NEXT_A() do { const int _t = opaque_tid(); const PG8_LAS int* _tb = tokb + (ui + 1) * 256; _Pragma("unroll") for (int _i = 0; _i < 2; ++_i) { int _R, _C; stage_rc(_t * 16 + _i * 8192, _R, _C); \
        _Pragma("unroll") for (int _h = 0; _h < 2; ++_h) vAc[_h][_i] = (unsigned)(_tb[_h * 128 + _R] * K + _C) * 2u; } } while (0)
#define PG8_CALC_A(u, v) do { const int _t = opaque_tid(); _Pragma("unroll") for (int _i = 0; _i < 2; ++_i) { int _R, _C; stage_rc(_t * 16 + _i * 8192, _R, _C); _Pragma("unroll") for (int _h = 0; _h < 2; ++_h) v[_h][_i] = (GATHER ? (unsigned)(tokb[_h * 128 + _R] * K) * 2u : S.a_off(u, _h * 128 + _R, K)) + (unsigned)_C * 2u; } } while (0)
#define PG8_LDA(dst, b, h) do { _Pragma("unroll") for (int m = 0; m < 4; ++m) _Pragma("unroll") for (int k = 0; k < 2; ++k) dst[m][k] = *(const PG8_LAS bf16x8*)(lds + PG8_SA(b, h) + aoff + m * 2048 + k * 1024); } while (0)
#define PG8_LDB(dst, b, h) do { _Pragma("unroll") for (int n = 0; n < 2; ++n) _Pragma("unroll") for (int k = 0; k < 2; ++k) dst[n][k] = *(const PG8_LAS bf16x8*)(lds + PG8_SB(b, h) + boff + n * 2048 + k * 1024); } while (0)
#define PG8_MMA(ai, bj, At, Bt) do { __builtin_amdgcn_s_setprio(1); _Pragma("unroll") for (int m = 0; m < 4; ++m) _Pragma("unroll") for (int n = 0; n < 2; ++n) _Pragma("unroll") for (int k = 0; k < 2; ++k) \
        acc[ai][bj][m][n] = __builtin_amdgcn_mfma_f32_16x16x32_bf16(Bt[n][k], At[m][k], acc[ai][bj][m][n], 0, 0, 0); __builtin_amdgcn_s_setprio(0); } while (0)
#define PG8_WAIT_V(n) asm volatile("s_waitcnt vmcnt(" #n ")" ::: "memory")
#define PG8_WAIT_L(n) asm volatile("s_waitcnt lgkmcnt(" #n ")" ::: "memory")
#define PG8_BAR __builtin_amdgcn_s_barrier()
#define PG8_SCHED __builtin_amdgcn_sched_barrier(0)
    Unit cur, nxt; int ui = 0;
    if (!S.next(0, cur)) return;
    f32x4 acc[2][2][4][2];
#pragma unroll
    for (int a = 0; a < 2; ++a)
#pragma unroll
        for (int b = 0; b < 2; ++b)
#pragma unroll
            for (int m = 0; m < 4; ++m)
#pragma unroll
                for (int n = 0; n < 2; ++n) acc[a][b][m][n] = (f32x4){0.f, 0.f, 0.f, 0.f};
    bf16x8 At[4][2], B0[2][2], B1[2][2];
    unsigned vAc[2][2];
    PG8_CALC_A(cur, vAc);
    const char* cA = cur.Ap; const char* cB = cur.Bp;
    PG8_STAGE_B(PG8_SB(0, 0), cB); PG8_STAGE_B(PG8_SB(0, 1), cB + hstep); PG8_STAGE_A(PG8_SA(0, 0), cA, 0); PG8_STAGE_A(PG8_SA(0, 1), cA, 1);
    if (wr == 1) PG8_BAR;
    PG8_WAIT_V(2); PG8_BAR;
    PG8_STAGE_B(PG8_SB(1, 0), cB + kstep); PG8_STAGE_A(PG8_SA(1, 0), cA + kstep, 0); PG8_STAGE_B(PG8_SB(1, 1), cB + hstep + kstep);
    PG8_WAIT_V(6); PG8_BAR;
    for (;;) {
        const bool has_next = S.next(ui + 1, nxt);
        const char* nA = has_next ? nxt.Ap : cA; const char* nB = has_next ? nxt.Bp : cB;
#pragma unroll 1
        for (int t = 0; t < nt; t += 2) {
            const bool last = (t == nt - 2);
            const char* a1 = cA + (size_t)(t + 1) * kstep;
            const char* a2 = last ? nA : cA + (size_t)(t + 2) * kstep; const char* b2 = last ? nB : cB + (size_t)(t + 2) * kstep;
            const char* a3 = a2 + kstep; const char* b3 = b2 + kstep;
            PG8_LDB(B0, 0, 0); PG8_LDB(B1, 0, 1); PG8_SCHED; PG8_LDA(At, 0, 0); PG8_STAGE_A(PG8_SA(1, 1), a1, 1);
            if constexpr (GATHER) { if (last && has_next) { PG8_NEXT_A(); } }
            PG8_WAIT_V(8); PG8_WAIT_L(0); PG8_BAR; PG8_MMA(0, 0, At, B0); PG8_MMA(0, 1, At, B1); PG8_BAR; PG8_SCHED;
            PG8_LDA(At, 0, 1); PG8_STAGE_B(PG8_SB(0, 0), b2); PG8_STAGE_B(PG8_SB(0, 1), b2 + hstep); PG8_STAGE_A2(PG8_SA(0, 0), a2, 0);
            PG8_WAIT_V(8); PG8_WAIT_L(0); PG8_BAR; PG8_MMA(1, 0, At, B0); PG8_MMA(1, 1, At, B1); PG8_BAR; PG8_SCHED;
            PG8_LDB(B0, 1, 0); PG8_LDB(B1, 1, 1); PG8_SCHED; PG8_LDA(At, 1, 0); PG8_STAGE_A2(PG8_SA(0, 1), a2, 1);
            PG8_WAIT_V(8); PG8_WAIT_L(0); PG8_BAR; PG8_MMA(0, 0, At, B0); PG8_MMA(0, 1, At, B1); PG8_BAR; PG8_SCHED;
            PG8_LDA(At, 1, 1); PG8_STAGE_B(PG8_SB(1, 0), b3); PG8_STAGE_B(PG8_SB(1, 1), b3 + hstep); PG8_STAGE_A2(PG8_SA(1, 0), a3, 0);
            PG8_WAIT_V(8); PG8_WAIT_L(0); PG8_BAR; PG8_MMA(1, 0, At, B0); PG8_MMA(1, 1, At, B1); PG8_BAR; PG8_SCHED;
        }
        if constexpr (ALIGN_EPI) { if (wr == 0) PG8_BAR; }
        E(acc, cur, ui);
        if (!has_next) break;
#pragma unroll
        for (int a = 0; a < 2; ++a)
#pragma unroll
            for (int b = 0; b < 2; ++b)
#pragma unroll
                for (int m = 0; m < 4; ++m)
#pragma unroll
                    for (int n = 0; n < 2; ++n) acc[a][b][m][n] = (f32x4){0.f, 0.f, 0.f, 0.f};
        cur = nxt; cA = nA; cB = nB; ++ui;
        if constexpr (ALIGN_EPI) { if (wr == 1) PG8_BAR; }
    }
    PG8_WAIT_V(0);
    if constexpr (!ALIGN_EPI) { if (wr == 0) PG8_BAR; }
    PG8_BAR;
#undef PG8_SA
#undef PG8_SB
#undef PG8_GLDS
#undef PG8_STAGE_A
#undef PG8_STAGE_A2
#undef PG8_NEXT_A
#undef PG8_STAGE_B
#undef PG8_CALC_A
#undef PG8_LDA
#undef PG8_LDB
#undef PG8_MMA
#undef PG8_WAIT_V
#undef PG8_WAIT_L
#undef PG8_BAR
#undef PG8_SCHED
}
}

constexpr size_t MiB = 1u << 20;
constexpr size_t WS_CTL = 0, CTL_ZERO_BYTES = 128 * 1024;
constexpr size_t WS_MOD = 1 * MiB;
constexpr size_t WS_BA = 2 * MiB;
constexpr size_t WS_PW = 3 * MiB;
constexpr size_t WS_WIN = 4 * MiB;
constexpr size_t WS_LIST = 4 * MiB;
constexpr size_t WS_LISTW = 8 * MiB;
constexpr size_t WS_WSGU = 12 * MiB;
constexpr size_t WS_WSD = 13 * MiB;
constexpr size_t WS_WG = 21 * MiB;
constexpr size_t WS_WUPG = 25 * MiB, WS_WUPD = 27 * MiB, WS_WOUT = 28 * MiB;
constexpr size_t WS_H = 30 * MiB;
constexpr size_t WS_GQ = 62 * MiB, WS_GK = 94 * MiB, WS_GV = 126 * MiB;
constexpr size_t WS_YA = 62 * MiB;
constexpr size_t WS_WGU = 94 * MiB;
constexpr size_t WS_DQ = 158 * MiB, WS_DK = 206 * MiB, WS_DV = 254 * MiB;
constexpr size_t WS_UA = 158 * MiB, WS_UB = 190 * MiB, WS_MG = 222 * MiB;
constexpr size_t WS_ACT = 158 * MiB;
constexpr size_t WS_ACTS = 231 * MiB;
constexpr size_t WS_WD = 302 * MiB;
constexpr size_t WS_SLOT = 30 * MiB;
constexpr size_t WS_SH = 240 * MiB;
constexpr size_t WS_END = 334 * MiB;
constexpr size_t OUT_GZ = 0, OUT_YB = 32 * MiB;

constexpr int CW_BAR = 4096;
constexpr int CW_CNT = 16384;

constexpr int RING_BYTES = 131072;
constexpr int MISC_OFF = 143360;
constexpr int INFO_OFF = 131072;
constexpr int LDS_BYTES = 147456;

typedef GAS unsigned gu32;
#define RLX_AGENT __ATOMIC_RELAXED, __HIP_MEMORY_SCOPE_AGENT

#define XB_TMO      128
#define XB_XCNT(j)  (256  + 64 * (j))
#define XB_XSUB(j)  (1280 + 64 * (j))
#define XB_XGEN(j)  (2304 + 64 * (j))
#define XB_TOP      3328
#define XB_TOPGEN   3392
#define XCD_BAR_WORDS 3456
#define XB_SPIN_CAP (1u << 22)
__device__ __forceinline__ unsigned xb_ld(unsigned* p)              { return __hip_atomic_load(p, __ATOMIC_RELAXED, __HIP_MEMORY_SCOPE_AGENT); }
__device__ __forceinline__ unsigned xb_add(unsigned* p, unsigned v) { return __hip_atomic_fetch_add(p, v, __ATOMIC_RELAXED, __HIP_MEMORY_SCOPE_AGENT); }
__device__ __forceinline__ unsigned xb_xcc_id() { return (unsigned)__builtin_amdgcn_s_getreg((3 << 11) | 20) & 0xFu; }
#define XB_SPIN(cond, bar) do { unsigned _sp = 0; while (cond) { __builtin_amdgcn_s_sleep(1); \
    if ((++_sp & 255u) == 0u) { if (xb_ld(&(bar)[XB_TMO])) break; if (_sp > XB_SPIN_CAP) { atomicAdd(&(bar)[XB_TMO], 1u); break; } } } } while (0)
struct XcdBarrier { unsigned* bar; unsigned x; volatile LAS unsigned* st; };
__device__ __forceinline__ XcdBarrier xcd_barrier_post(unsigned* bar, volatile LAS unsigned* st) {
    XcdBarrier b; b.bar = bar; b.x = xb_xcc_id(); b.st = st;
    if (threadIdx.x == 0) (void)xb_add(&bar[XB_XCNT(b.x)], 1u);
    return b;
}
__device__ __forceinline__ void xcd_barrier_complete(unsigned* bar, unsigned x, unsigned& nloc, unsigned& nx) {
    const unsigned G = gridDim.x * gridDim.y * gridDim.z;
    unsigned sum, cnt, mine, sp = 0u;
    for (;;) {
        sum = 0u; cnt = 0u; mine = 0u;
#pragma unroll
        for (unsigned j = 0; j < 16; ++j) { const unsigned c = xb_ld(&bar[XB_XCNT(j)]); sum += c; cnt += (c > 0u) ? 1u : 0u; mine = (j == x) ? c : mine; }
        if (sum == G) break;
        __builtin_amdgcn_s_sleep(1);
        if ((++sp & 255u) == 0u) { if (xb_ld(&bar[XB_TMO])) break; if (sp > XB_SPIN_CAP) { atomicAdd(&bar[XB_TMO], 1u); break; } }
    }
    nloc = mine > 0u ? mine : 1u; nx = cnt > 0u ? cnt : 1u;
}
__device__ __forceinline__ void xcd_barrier(const XcdBarrier& b) {
    asm volatile("s_waitcnt vmcnt(0)" ::: "memory");
    __syncthreads();
    if (threadIdx.x == 0) {
        unsigned* bar = b.bar;
        __builtin_amdgcn_s_waitcnt(0);
        unsigned nloc = b.st[0], nx = b.st[1];
        if (nloc == 0u) { xcd_barrier_complete(bar, b.x, nloc, nx); b.st[0] = nloc; b.st[1] = nx; }
        const unsigned old = xb_add(&bar[XB_XSUB(b.x)], 1u);
        const unsigned gen = old / nloc;
        if (old + 1u == (gen + 1u) * nloc) {
            __builtin_amdgcn_fence(__ATOMIC_RELEASE, "agent");
            asm volatile("s_waitcnt vmcnt(0)" ::: "memory");
            const unsigned og = xb_add(&bar[XB_TOP], 1u);
            const unsigned tg = og / nx;
            if (og + 1u == (tg + 1u) * nx) xb_add(&bar[XB_TOPGEN], 1u);
            else XB_SPIN(xb_ld(&bar[XB_TOPGEN]) == tg, bar);
            __builtin_amdgcn_fence(__ATOMIC_ACQUIRE, "agent");
            xb_add(&bar[XB_XGEN(b.x)], 1u);
            asm volatile("s_waitcnt vmcnt(0)" ::: "memory");
        } else {
            XB_SPIN(xb_ld(&bar[XB_XGEN(b.x)]) == gen, bar);
            __builtin_amdgcn_fence(__ATOMIC_ACQUIRE, "agent");
            asm volatile("s_waitcnt vmcnt(0)" ::: "memory");
        }
    }
    __syncthreads();
}

struct Frame {
    LAS unsigned char* lds;
    int G, blk;
    float* out; unsigned char* ws; unsigned char* ob;
};
enum { I_X = 0, I_C, I_WADA, I_BADA, I_GMIX, I_WIN, I_CONVW, I_ALOG, I_DTB, I_GNG, I_QNG, I_KNG, I_WUPG, I_WUPD, I_WOUT, I_GFFN, I_WR, I_RB, I_WEG, I_WEU, I_WED, I_WSG, I_WSU, I_WSD };
__device__ __forceinline__ const float* inp(int i) { return ((const float* const __attribute__((address_space(4)))*)__builtin_amdgcn_kernarg_segment_ptr())[i]; }

__device__ __forceinline__ void transpose_item(const float* W, int ldn, int n0s, int k0, bf16_t* WT, int dK, int drow0, LAS float* scr, int lane) {
#pragma unroll 8
    for (int i = 0; i < 32; ++i) { const int kk = 2 * i + (lane >> 5); scr[kk * 33 + (lane & 31)] = W[(size_t)(k0 + kk) * ldn + n0s + (lane & 31)]; }
    asm volatile("s_waitcnt lgkmcnt(0)" ::: "memory");
    const int c = lane & 7;
#pragma unroll
    for (int j = 0; j < 4; ++j) { const int n = (lane >> 3) + 8 * j; const LAS float* s = scr + (8 * c) * 33 + n;
        u32x4 o; o.x = pk2(s[0 * 33], s[1 * 33]); o.y = pk2(s[2 * 33], s[3 * 33]); o.z = pk2(s[4 * 33], s[5 * 33]); o.w = pk2(s[6 * 33], s[7 * 33]);
        *(GAS u32x4*)(WT + (size_t)(drow0 + n) * dK + k0 + 8 * c) = o; }
    asm volatile("s_waitcnt lgkmcnt(0)" ::: "memory");
}

__device__ __forceinline__ void p0_mod(Frame& F) {
    const int ftid = opaque_tid(), flane = ftid & 63, fwave = __builtin_amdgcn_readfirstlane(ftid >> 6);
    LAS float* cs = (LAS float*)(F.lds);
    LAS float* red = (LAS float*)(F.lds + 32768);
    for (int i = ftid; i < 8 * 1024; i += 512) cs[i] = siluf_(inp(I_C)[i]);
    __syncthreads();
    float* MOD = (float*)(F.ws + WS_MOD);
    for (int cb = F.blk; cb < 6144 / 24; cb += F.G) {
        const int col = ftid & 31, kg = ftid >> 5;
        float acc[8];
#pragma unroll
        for (int b = 0; b < 8; ++b) acc[b] = 0.f;
        if (col < 24) {
            for (int i = 0; i < 64; ++i) { const int k = kg + 16 * i; const float w = inp(I_WADA)[(size_t)k * 6144 + cb * 24 + col];
#pragma unroll
                for (int b = 0; b < 8; ++b) acc[b] += cs[b * 1024 + k] * w; }
        }
#pragma unroll
        for (int b = 0; b < 8; ++b) red[(kg * 8 + b) * 32 + col] = acc[b];
        __syncthreads();
        if (ftid < 256) { const int b = ftid >> 5, cc = ftid & 31;
            if (cc < 24) { float s = inp(I_BADA)[cb * 24 + cc];
                for (int g = 0; g < 16; ++g) s += red[(g * 8 + b) * 32 + cc];
                MOD[b * 6144 + cb * 24 + cc] = s; } }
        __syncthreads();
    }
}
__device__ __forceinline__ void p0_weights(Frame& F) {
    const int ftid = opaque_tid(), flane = ftid & 63, fwave = __builtin_amdgcn_readfirstlane(ftid >> 6);
    LAS float* scr = (LAS float*)(F.lds + 49152 + fwave * 8448);
    const int gw = F.blk * 8 + fwave, NGW = F.G * 8;
    bf16_t* WIN = (bf16_t*)(F.ws + WS_WIN); bf16_t* WG = (bf16_t*)(F.ws + WS_WG);
    bf16_t* WUPG = (bf16_t*)(F.ws + WS_WUPG); bf16_t* WUPD = (bf16_t*)(F.ws + WS_WUPD); bf16_t* WOUT = (bf16_t*)(F.ws + WS_WOUT);
    constexpr int I_IN = 16 * (NPROJ / 32), I_G = 16 * 64, I_UG = 16 * 32, I_UD = 8 * 32, I_O = 16 * 32;
    constexpr int NIT = I_IN + I_G + I_UG + I_UD + I_O;
    for (int it = gw; it < NIT; it += NGW) {
        int r = it;
        if (r < I_IN) { const int kb = r / (NPROJ / 32), nb = r % (NPROJ / 32), n0 = nb * 32; transpose_item(inp(I_WIN), IN_W, n0 + (n0 >= 4096 ? 16 : 0), kb * 64, WIN, 1024, n0, scr, flane); continue; } r -= I_IN;
        if (r < I_G) { const int kb = r / 64, nb = r % 64, p = nb >> 3, hf = (nb >> 2) & 1, i0 = (nb & 3) * 32;
            transpose_item(inp(I_WIN), IN_W, 8720 + hf * 1024 + p * 128 + i0, kb * 64, WG, 1024, p * 256 + hf * 128 + i0, scr, flane); continue; } r -= I_G;
        if (r < I_UG) { const int kb = r / 32, nb = r % 32; transpose_item(inp(I_WUPG), 1024, nb * 32, kb * 64, WUPG, 1024, nb * 32, scr, flane); continue; } r -= I_UG;
        if (r < I_UD) { const int kb = r / 32, nb = r % 32; transpose_item(inp(I_WUPD), 1024, nb * 32, kb * 64, WUPD, 512, nb * 32, scr, flane); continue; } r -= I_UD;
        { const int kb = r / 32, nb = r % 32; transpose_item(inp(I_WOUT), 1024, nb * 32, kb * 64, WOUT, 1024, nb * 32, scr, flane); }
    }
}
__device__ __forceinline__ void tr16_item(const float* src, int ldn, int n0, int k0, bf16_t* d0, bf16_t* d1, bf16_t* d2, bf16_t* d3, int lane) {
    f32x4 v[16];
#pragma unroll
    for (int i = 0; i < 16; ++i) v[i] = *(const f32x4*)(src + (size_t)(k0 + i) * ldn + n0 + 4 * lane);
    u32x4 a0, a1, b0, b1, c0, c1, e0, e1;
#pragma unroll
    for (int i = 0; i < 4; ++i) { a0[i] = pk2(v[2 * i].x, v[2 * i + 1].x); a1[i] = pk2(v[8 + 2 * i].x, v[9 + 2 * i].x); b0[i] = pk2(v[2 * i].y, v[2 * i + 1].y); b1[i] = pk2(v[8 + 2 * i].y, v[9 + 2 * i].y);
        c0[i] = pk2(v[2 * i].z, v[2 * i + 1].z); c1[i] = pk2(v[8 + 2 * i].z, v[9 + 2 * i].z); e0[i] = pk2(v[2 * i].w, v[2 * i + 1].w); e1[i] = pk2(v[8 + 2 * i].w, v[9 + 2 * i].w); }
    *(u32x4*)(d0 + k0) = a0; *(u32x4*)(d0 + k0 + 8) = a1; *(u32x4*)(d1 + k0) = b0; *(u32x4*)(d1 + k0 + 8) = b1;
    *(u32x4*)(d2 + k0) = c0; *(u32x4*)(d2 + k0 + 8) = c1; *(u32x4*)(d3 + k0) = e0; *(u32x4*)(d3 + k0 + 8) = e1;
}
__device__ __forceinline__ void convert_experts(Frame& F, int b0, int nb) {
    const int ftid = opaque_tid(), flane = ftid & 63, fwave = __builtin_amdgcn_readfirstlane(ftid >> 6);
    if (F.blk < b0 || F.blk >= b0 + nb) return;
    const int gw = (F.blk - b0) * 8 + fwave, NGW = nb * 8;
    bf16_t* WGU = (bf16_t*)(F.ws + WS_WGU); bf16_t* WD = (bf16_t*)(F.ws + WS_WD); bf16_t* WSGU = (bf16_t*)(F.ws + WS_WSGU); bf16_t* WSD = (bf16_t*)(F.ws + WS_WSD);
    constexpr int PER_E = 192, NIT = 65 * PER_E;
    for (int it = gw; it < NIT; it += NGW) {
        const int e = it / PER_E; const int r = it % PER_E;
        bf16_t* dgu = e < 64 ? WGU + (size_t)e * 512 * 1024 : WSGU; bf16_t* dd = e < 64 ? WD + (size_t)e * 1024 * 256 : WSD;
        if (r < 128) { const int hf = r >> 6, k0 = (r & 63) * 16;
            const float* src = hf ? (e < 64 ? inp(I_WEU) + (size_t)e * 1024 * 256 : inp(I_WSU)) : (e < 64 ? inp(I_WEG) + (size_t)e * 1024 * 256 : inp(I_WSG));
            const int n = 4 * flane; bf16_t* d = dgu + (size_t)((n >> 7) * 256 + hf * 128 + (n & 127)) * 1024;
            tr16_item(src, 256, 0, k0, d, d + 1024, d + 2048, d + 3072, flane); }
        else { const int q = r - 128, k0 = (q >> 2) * 16, n0 = (q & 3) * 256;
            const float* src = e < 64 ? inp(I_WED) + (size_t)e * 256 * 1024 : inp(I_WSD);
            bf16_t* d = dd + (size_t)(n0 + 4 * flane) * 256;
            tr16_item(src, 1024, n0, k0, d, d + 256, d + 512, d + 768, flane); }
    }
}

__device__ __forceinline__ void p1_norm(Frame& F) {
    const int ftid = opaque_tid(), flane = ftid & 63, fwave = __builtin_amdgcn_readfirstlane(ftid >> 6);
    LAS float* WbT = (LAS float*)(F.lds);
    for (int it = 0; it < 8; ++it) { const int k = (ftid >> 2) + 128 * it, j4 = (ftid & 3) * 4;
        const f32x4 v = *(const f32x4*)(inp(I_WIN) + (size_t)k * IN_W + 4096 + j4);
        WbT[(j4 + 0) * 1024 + k] = v.x; WbT[(j4 + 1) * 1024 + k] = v.y; WbT[(j4 + 2) * 1024 + k] = v.z; WbT[(j4 + 3) * 1024 + k] = v.w; }
    __syncthreads();
    const float* MOD = (const float*)(F.ws + WS_MOD); bf16_t* H = (bf16_t*)(F.ws + WS_H); float* BA = (float*)(F.ws + WS_BA);
    const int gw = F.blk * 8 + fwave, NGW = F.G * 8;
    for (int rg = gw; rg < T / 8; rg += NGW) {
        const int row0 = rg * 8, b = row0 / SEQ;
        const float* sh = MOD + b * 6144; const float* sc = sh + 1024;
        f32x4 gm[4], s1[4], h1[4];
#pragma unroll
        for (int j = 0; j < 4; ++j) { const int k = 4 * flane + 256 * j; gm[j] = *(const f32x4*)(inp(I_GMIX) + k); s1[j] = *(const f32x4*)(sc + k) + 1.0f; h1[j] = *(const f32x4*)(sh + k); gm[j] = gm[j] * s1[j]; }
        f32x4 cur[4], nxt[4];
        { const f32x4* xr = (const f32x4*)(inp(I_X) + (size_t)row0 * DM) + flane;
#pragma unroll
          for (int j = 0; j < 4; ++j) cur[j] = xr[64 * j]; }
#pragma unroll 1
        for (int r = 0; r < 8; ++r) {
            const int row = row0 + r;
            if (r < 7) { const f32x4* xr = (const f32x4*)(inp(I_X) + (size_t)(row + 1) * DM) + flane;
#pragma unroll
                for (int j = 0; j < 4; ++j) nxt[j] = xr[64 * j]; }
            f32x4 v[4]; float ss = 0.f;
#pragma unroll
            for (int j = 0; j < 4; ++j) { v[j] = cur[j]; ss += (v[j].x * v[j].x + v[j].y * v[j].y) + (v[j].z * v[j].z + v[j].w * v[j].w); }
            const float rstd = rsqrtf(wave_sum(ss) * (1.f / DM) + EPS);
#pragma unroll
            for (int j = 0; j < 4; ++j) { const int k = 4 * flane + 256 * j;
                v[j] = (v[j] * rstd) * gm[j] + h1[j];
                u32x2 o; o.x = pk2(v[j].x, v[j].y); o.y = pk2(v[j].z, v[j].w);
                *(u32x2*)(H + (size_t)row * DM + k) = o; }
            float a[16];
#pragma unroll
            for (int jj = 0; jj < 16; ++jj) { float s = 0.f;
#pragma unroll
                for (int j = 0; j < 4; ++j) { const f32x4 w = *(const LAS f32x4*)(WbT + jj * 1024 + 4 * flane + 256 * j); s += (v[j].x * w.x + v[j].y * w.y) + (v[j].z * w.z + v[j].w * w.w); }
                a[jj] = s; if ((jj & 3) == 3) asm volatile("" ::: "memory"); }
            float v8[8], v4[4], v2[2], v1;
            { const bool hi = (flane & 32) != 0;
#pragma unroll
              for (int i = 0; i < 8; ++i) { const float x = hi ? a[i] : a[8 + i]; const float rr = __shfl_xor(x, 32); v8[i] = (hi ? a[8 + i] : a[i]) + rr; } }
            { const bool hi = (flane & 16) != 0;
#pragma unroll
              for (int i = 0; i < 4; ++i) { const float x = hi ? v8[i] : v8[4 + i]; const float rr = __shfl_xor(x, 16); v4[i] = (hi ? v8[4 + i] : v8[i]) + rr; } }
            { const bool hi = (flane & 8) != 0;
#pragma unroll
              for (int i = 0; i < 2; ++i) { const float x = hi ? v4[i] : v4[2 + i]; const float rr = __shfl_xor(x, 8); v2[i] = (hi ? v4[2 + i] : v4[i]) + rr; } }
            { const bool hi = (flane & 4) != 0; const float x = hi ? v2[0] : v2[1]; const float rr = __shfl_xor(x, 4); v1 = (hi ? v2[1] : v2[0]) + rr; }
            v1 = red4(v1);
            if ((flane & 3) == 0) BA[(size_t)row * 16 + (flane >> 2)] = v1;
#pragma unroll
            for (int j = 0; j < 4; ++j) cur[j] = nxt[j];
        }
    }
}

using pg8::Unit; using pg8::cvt_pk_bf16;
struct EpiProj {
    static constexpr bool PERM = true;
    unsigned char* ws; bf16_t* gz;
    __device__ __forceinline__ void operator()(const f32x4 (&acc)[2][2][4][2], const Unit& u, const int ui) const {
        const int tid_ = opaque_tid(), lane_ = tid_ & 63, wid_ = tid_ >> 6, wr = wid_ >> 2, wc = wid_ & 3, fr = lane_ & 15, fq = lane_ >> 4;
        bf16_t* base; int ldc, colt;
        if (u.pn < 16) { const int t = u.pn >> 2; base = (bf16_t*)(ws + WS_GQ + (size_t)t * (32 * MiB)); if (t == 3) base = gz; ldc = 1024; colt = (u.pn & 3) * 256; }
        else { const int d = u.pn - 16, t = d / 6; base = (bf16_t*)(ws + WS_DQ + (size_t)t * (48 * MiB)); ldc = 1536; colt = (d % 6) * 256; }
        const int row0 = u.pm * 256 + wr * 64 + fr, col0 = colt + wc * 32 + 8 * fq;
#pragma unroll
        for (int ai = 0; ai < 2; ++ai)
#pragma unroll
            for (int m = 0; m < 4; ++m) { bf16_t* rowp = base + (size_t)(row0 + ai * 128 + m * 16) * ldc + col0;
#pragma unroll
                for (int bj = 0; bj < 2; ++bj) { const f32x4 v0 = acc[ai][bj][m][0], v1 = acc[ai][bj][m][1];
                    u32x4 w; w.x = pk2(v0[0], v0[1]); w.y = pk2(v0[2], v0[3]); w.z = pk2(v1[0], v1[1]); w.w = pk2(v1[2], v1[3]);
                    *(u32x4*)(rowp + bj * 128) = w; } }
    }
};
struct EpiStore {
    static constexpr bool PERM = true;
    bf16_t* O; int ldc;
    __device__ __forceinline__ void operator()(const f32x4 (&acc)[2][2][4][2], const Unit& u, const int ui) const {
        const int tid_ = opaque_tid(), lane_ = tid_ & 63, wid_ = tid_ >> 6, wr = wid_ >> 2, wc = wid_ & 3, fr = lane_ & 15, fq = lane_ >> 4;
        const int row0 = u.pm * 256 + wr * 64 + fr, col0 = u.pn * 256 + wc * 32 + 8 * fq;
#pragma unroll
        for (int ai = 0; ai < 2; ++ai)
#pragma unroll
            for (int m = 0; m < 4; ++m) { bf16_t* rowp = O + (size_t)(row0 + ai * 128 + m * 16) * ldc + col0;
#pragma unroll
                for (int bj = 0; bj < 2; ++bj) { const f32x4 v0 = acc[ai][bj][m][0], v1 = acc[ai][bj][m][1];
                    u32x4 w; w.x = pk2(v0[0], v0[1]); w.y = pk2(v0[2], v0[3]); w.z = pk2(v1[0], v1[1]); w.w = pk2(v1[2], v1[3]);
                    *(u32x4*)(rowp + bj * 128) = w; } }
    }
};
struct EpiGate {
    static constexpr bool PERM = true;
    const bf16_t* UA; const bf16_t* UB; bf16_t* MG;
    __device__ __forceinline__ void operator()(const f32x4 (&acc)[2][2][4][2], const Unit& u, const int ui) const {
        const int tid_ = opaque_tid(), lane_ = tid_ & 63, wid_ = tid_ >> 6, wr = wid_ >> 2, wc = wid_ & 3, fr = lane_ & 15, fq = lane_ >> 4;
        const int row0 = u.pm * 256 + wr * 64 + fr, col0 = u.pn * 128 + wc * 32 + 8 * fq;
#pragma unroll
        for (int ai = 0; ai < 2; ++ai) {
            u32x4 ua[4], ub[4];
#pragma unroll
            for (int m = 0; m < 4; ++m) { const size_t off = (size_t)(row0 + ai * 128 + m * 16) * 1024 + col0; ua[m] = *(const u32x4*)(UA + off); ub[m] = *(const u32x4*)(UB + off); }
#pragma unroll
            for (int m = 0; m < 4; ++m) { const size_t off = (size_t)(row0 + ai * 128 + m * 16) * 1024 + col0;
                float o[8];
#pragma unroll
                for (int n = 0; n < 2; ++n)
#pragma unroll
                    for (int j = 0; j < 4; ++j) { const int q = n * 4 + j; const unsigned wa = ua[m][q >> 1], wb = ub[m][q >> 1];
                        const float fa = (q & 1) ? bfhi(wa) : bflo(wa), fb = (q & 1) ? bfhi(wb) : bflo(wb);
                        o[q] = sigmoidf_(acc[ai][0][m][n][j]) * fa + sigmoidf_(acc[ai][1][m][n][j]) * fb; }
                u32x4 w; w.x = pk2(o[0], o[1]); w.y = pk2(o[2], o[3]); w.z = pk2(o[4], o[5]); w.w = pk2(o[6], o[7]);
                *(u32x4*)(MG + off) = w; }
            asm volatile("" ::: "memory");
        }
    }
};
struct EpiX1 {
    static constexpr bool PERM = false;
    const float* x; const float* mod; float* out;
    __device__ __forceinline__ void operator()(const f32x4 (&acc)[2][2][4][2], const Unit& u, const int ui) const {
        const int tid_ = opaque_tid(), lane_ = tid_ & 63, wid_ = tid_ >> 6, wr = wid_ >> 2, wc = wid_ & 3, fr = lane_ & 15, fq = lane_ >> 4;
        const int row0 = u.pm * 256 + wr * 64 + fr, col0 = u.pn * 256 + wc * 32 + 4 * fq; const int b = u.pm >> 3;
        f32x4 gt[2][2];
#pragma unroll
        for (int bj = 0; bj < 2; ++bj)
#pragma unroll
            for (int n = 0; n < 2; ++n) gt[bj][n] = *(const f32x4*)(mod + b * 6144 + 2048 + col0 + bj * 128 + n * 16);
#pragma unroll
        for (int ai = 0; ai < 2; ++ai) {
            f32x4 xv[4][2][2];
#pragma unroll
            for (int m = 0; m < 4; ++m) { const size_t off = (size_t)(row0 + ai * 128 + m * 16) * 1024 + col0;
#pragma unroll
                for (int bj = 0; bj < 2; ++bj)
#pragma unroll
                    for (int n = 0; n < 2; ++n) xv[m][bj][n] = *(const f32x4*)(x + off + bj * 128 + n * 16); }
#pragma unroll
            for (int m = 0; m < 4; ++m) { const size_t off = (size_t)(row0 + ai * 128 + m * 16) * 1024 + col0;
#pragma unroll
                for (int bj = 0; bj < 2; ++bj)
#pragma unroll
                    for (int n = 0; n < 2; ++n) *(f32x4*)(out + off + bj * 128 + n * 16) = xv[m][bj][n] + gt[bj][n] * acc[ai][bj][m][n]; }
            asm volatile("" ::: "memory");
        }
    }
};
struct MoeTab { const LAS int* tp; const LAS int* cnt; const LAS unsigned short* te; };
struct EpiAct {
    static constexpr bool PERM = true;
    MoeTab tb; const LAS float* wkb; bf16_t* ACT; bf16_t* ACTS;
    __device__ __forceinline__ void operator()(const f32x4 (&acc)[2][2][4][2], const Unit& u, const int ui) const {
        const int tid_ = opaque_tid(), lane_ = tid_ & 63, wid_ = tid_ >> 6, wr = wid_ >> 2, wc = wid_ & 3, fr = lane_ & 15, fq = lane_ >> 4;
        const int e = u.e;
        bf16_t* base = e < 64 ? ACT + (size_t)u.pm * 256 * 256 : ACTS + (size_t)u.mt * 256 * 256;
        const int col0 = u.pn * 128 + wc * 32 + 8 * fq;
        float wk[2][4];
#pragma unroll
        for (int ai = 0; ai < 2; ++ai)
#pragma unroll
            for (int m = 0; m < 4; ++m) wk[ai][m] = wkb[ui * 256 + ai * 128 + wr * 64 + m * 16 + fr];
#pragma unroll
        for (int ai = 0; ai < 2; ++ai)
#pragma unroll
            for (int m = 0; m < 4; ++m) { const int r = ai * 128 + wr * 64 + m * 16 + fr;
                float o[8];
#pragma unroll
                for (int n = 0; n < 2; ++n)
#pragma unroll
                    for (int j = 0; j < 4; ++j) o[n * 4 + j] = siluf_(acc[ai][0][m][n][j]) * acc[ai][1][m][n][j] * wk[ai][m];
                u32x4 w; w.x = pk2(o[0], o[1]); w.y = pk2(o[2], o[3]); w.z = pk2(o[4], o[5]); w.w = pk2(o[6], o[7]);
                *(u32x4*)(base + (size_t)r * 256 + col0) = w; }
    }
};
struct EpiSlot {
    static constexpr bool PERM = true;
    MoeTab tb; const LAS int* pairb; unsigned char* SLOT; bf16_t* SH;
    __device__ __forceinline__ void operator()(const f32x4 (&acc)[2][2][4][2], const Unit& u, const int ui) const {
        const int tid_ = opaque_tid(), lane_ = tid_ & 63, wid_ = tid_ >> 6, wr = wid_ >> 2, wc = wid_ & 3, fr = lane_ & 15, fq = lane_ >> 4;
        const int e = u.e; const int col0 = u.pn * 256 + wc * 32 + 8 * fq;
        if (e == 64) {
#pragma unroll
            for (int ai = 0; ai < 2; ++ai)
#pragma unroll
                for (int m = 0; m < 4; ++m) { bf16_t* rowp = SH + (size_t)(u.mt * 256 + ai * 128 + wr * 64 + m * 16 + fr) * 1024 + col0;
#pragma unroll
                    for (int bj = 0; bj < 2; ++bj) { const f32x4 v0 = acc[ai][bj][m][0], v1 = acc[ai][bj][m][1];
                        u32x4 w; w.x = pk2(v0[0], v0[1]); w.y = pk2(v0[2], v0[3]); w.z = pk2(v1[0], v1[1]); w.w = pk2(v1[2], v1[3]);
                        *(u32x4*)(rowp + bj * 128) = w; } }
            return;
        }
        int pair[2][4];
#pragma unroll
        for (int ai = 0; ai < 2; ++ai)
#pragma unroll
            for (int m = 0; m < 4; ++m) pair[ai][m] = pairb[ui * 256 + ai * 128 + wr * 64 + m * 16 + fr];
#pragma unroll
        for (int ai = 0; ai < 2; ++ai)
#pragma unroll
            for (int m = 0; m < 4; ++m) {
                if (pair[ai][m] >= 0) { unsigned char* rowp = SLOT + (size_t)pair[ai][m] * 1024 + col0;
#pragma unroll
                    for (int bj = 0; bj < 2; ++bj) { const f32x4 v0 = acc[ai][bj][m][0], v1 = acc[ai][bj][m][1];
                        int p0 = 0, p1 = 0;
                        p0 = __builtin_amdgcn_cvt_pk_fp8_f32(v0[0], v0[1], p0, false); p0 = __builtin_amdgcn_cvt_pk_fp8_f32(v0[2], v0[3], p0, true);
                        p1 = __builtin_amdgcn_cvt_pk_fp8_f32(v1[0], v1[1], p1, false); p1 = __builtin_amdgcn_cvt_pk_fp8_f32(v1[2], v1[3], p1, true);
                        u32x2 w; w.x = (unsigned)p0; w.y = (unsigned)p1; *(u32x2*)(rowp + bj * 128) = w; } } }
    }
};
struct G1Order {
    MoeTab tb; int G, c; const int* list; const char* H2; const char* WGU; const char* WSGU;
    __device__ __forceinline__ bool next(int i, Unit& u) const {
        const int NR = tb.tp[64]; const long L = (long)i * G + c; if (L >= (long)(NR + 64) * 2) return false;
        const int tile = (int)(L >> 1), j = (int)(L & 1);
        u.pn = j; u.Ap = H2;
        if (tile < NR) { const int e = tb.te[tile]; u.e = e; u.mt = tile - tb.tp[e]; u.pm = tile; u.Bp = WGU + ((size_t)e * 512 + j * 256) * 1024 * 2; }
        else { u.e = 64; u.mt = tile - NR; u.pm = 0; u.Bp = WSGU + (size_t)(j * 256) * 1024 * 2; }
        return true;
    }
    __device__ __forceinline__ int a_row(const Unit& u, int r) const {
        int tok;
        if (u.e == 64) tok = u.mt * 256 + r;
        else { const int pos = u.mt * 256 + r; tok = 0; if (pos < tb.cnt[u.e]) tok = list[(size_t)u.e * T + pos] >> 3; }
        return tok;
    }
    __device__ __forceinline__ unsigned a_off(const Unit& u, int r, int K) const { return (unsigned)(a_row(u, r) * K) * 2u; }
    __device__ __forceinline__ void preload(LAS int* tokb, LAS float* wkb, const float* listw) const {
        const int t = opaque_tid(); Unit u;
        for (int i = 0; i < 6 && next(i, u); ++i) if (t < 256) {
            int tok; float w = 1.0f;
            if (u.e == 64) tok = u.mt * 256 + t;
            else { const int pos = u.mt * 256 + t; tok = 0; w = 0.f; if (pos < tb.cnt[u.e]) { tok = list[(size_t)u.e * T + pos] >> 3; w = listw[(size_t)u.e * T + pos]; } }
            tokb[i * 256 + t] = tok; wkb[i * 256 + t] = w; }
        __syncthreads();
    }
};
struct G2Order {
    MoeTab tb; int G, c; const char* ACT; const char* WD; const char* ACTS; const char* WSD;
    __device__ __forceinline__ bool next(int i, Unit& u) const {
        const int NR = tb.tp[64]; const long L = (long)i * G + c; if (L >= (long)(NR + 64) * 4) return false;
        const int tile = (int)(L >> 2), pn = (int)(L & 3);
        u.pn = pn;
        if (tile < NR) { const int e = tb.te[tile];
            u.e = e; u.mt = tile - tb.tp[e]; u.pm = tile; u.Ap = ACT + (size_t)tile * 256 * 256 * 2; u.Bp = WD + ((size_t)e * 1024 + pn * 256) * 256 * 2; }
        else { u.e = 64; u.mt = tile - NR; u.pm = 0; u.Ap = ACTS + (size_t)u.mt * 256 * 256 * 2; u.Bp = WSD + (size_t)(pn * 256) * 256 * 2; }
        return true;
    }
    __device__ __forceinline__ unsigned a_off(const Unit&, int r, int K) const { return (unsigned)(r * K) * 2u; }
    __device__ __forceinline__ void preload(LAS int* pairb, const int* list) const {
        const int t = opaque_tid(); Unit u;
        for (int i = 0; i < 12 && next(i, u); ++i) if (t < 256) {
            int p = -1;
            if (u.e < 64) { const int pos = u.mt * 256 + t; if (pos < tb.cnt[u.e]) p = list[(size_t)u.e * T + pos]; }
            pairb[i * 256 + t] = p; }
        __syncthreads();
    }
};
__device__ __forceinline__ MoeTab build_moetab(Frame& F) {
    const int ftid = opaque_tid();
    LAS int* tp = (LAS int*)(F.lds + MISC_OFF + 1024); LAS int* cnt = (LAS int*)(F.lds + MISC_OFF + 2048); LAS unsigned short* te = (LAS unsigned short*)(F.lds + MISC_OFF + 2304);
    const gu32* gc = (const gu32*)(F.ws + WS_CTL) + CW_CNT;
    __syncthreads();
    if (ftid < 64) { int v = (int)__hip_atomic_load(gc + ftid, RLX_AGENT); if (v > T) v = T; if (v < 0) v = 0; cnt[ftid] = v; }
    __syncthreads();
    if (ftid == 0) { int s = 0; for (int e = 0; e < 64; ++e) { tp[e] = s; s += (cnt[e] + 255) >> 8; } tp[64] = s; }
    __syncthreads();
    if (ftid < 64) { const int t0 = tp[ftid], t1 = tp[ftid + 1]; for (int t = t0; t < t1 && t < 640; ++t) te[t] = (unsigned short)ftid; }
    __syncthreads();
    MoeTab t; t.tp = tp; t.cnt = cnt; t.te = te; return t;
}


typedef short v4i16_t __attribute__((ext_vector_type(4)));
constexpr size_t WS_OG01 = 302 * MiB;
constexpr size_t OUT_OG2 = 48 * MiB;
constexpr size_t WS_LSE = 3 * MiB + 512 * 1024;
__device__ __forceinline__ void p3_attn(Frame& F) {
    const int tid = opaque_tid(), lane = tid & 63, wave = __builtin_amdgcn_readfirstlane(tid >> 6), n = lane & 15, g = lane >> 4;
    const bf16_t* DQ = (const bf16_t*)(F.ws + WS_DQ); const bf16_t* DK = (const bf16_t*)(F.ws + WS_DK); const bf16_t* DV = (const bf16_t*)(F.ws + WS_DV);
    LAS unsigned char* Ks = F.lds; LAS unsigned char* Vs = F.lds + 65536; LAS float* rkS = (LAS float*)(F.lds + 131072);
    const float* gqp = inp(I_QNG); const float* gkp = inp(I_KNG);
    u32x4 kreg[8], vreg[8];
#define ATT_DECODE(u_, b_, h_, dsh_, r_, qb_) const int b_ = (u_) / 192, rem_##b_ = (u_) % 192, h_ = rem_##b_ >> 4, rq_##b_ = rem_##b_ & 15, dsh_ = 2 * (h_ >> 2), r_ = rq_##b_ / (16 >> dsh_), qb_ = rq_##b_ % (16 >> dsh_)
#define ATT_LOADKV(u_) do { ATT_DECODE(u_, lb, lh, ldsh, lr, lqb); \
        _Pragma("unroll") for (int pass = 0; pass < 8; ++pass) { if (lqb == 0 && pass < 4) continue; \
            const int wi = pass * 32 + (tid >> 4), c = tid & 15, m = lqb * 128 - 128 + wi; \
            const size_t t = (size_t)lb * SEQ + (size_t)((m << ldsh) + lr); \
            kreg[pass] = *(const u32x4*)(DK + t * 1536 + lh * 128 + c * 8); vreg[pass] = *(const u32x4*)(DV + t * 1536 + lh * 128 + c * 8); } } while (0)
    if (F.blk < BATCH * 12 * 16) { ATT_LOADKV(F.blk); }
#pragma unroll 1
    for (int u = F.blk; u < BATCH * 12 * 16; u += F.G) {
        ATT_DECODE(u, b, h, dsh, r, qb); const int grp = h >> 2, s = h & 3, dil = 1 << dsh, m0 = qb * 128;
        const size_t rowb = (size_t)b * SEQ;
        __syncthreads();
#pragma unroll
        for (int pass = 0; pass < 8; ++pass) {
            if (qb == 0 && pass < 4) continue;
            const int wi = pass * 32 + (tid >> 4), c = tid & 15;
            const u32x4 kv = kreg[pass], vv = vreg[pass];
            float ss = 0.f;
#pragma unroll
            for (int i = 0; i < 4; ++i) { const float a0 = bflo(kv[i]), a1 = bfhi(kv[i]); ss += a0 * a0 + a1 * a1; }
            ss = red16(ss);
            if (c == 0) rkS[wi] = rsqrtf(ss * (1.f / 128.f) + EPS);
            *(LAS u32x4*)(Ks + wi * 256 + ((c ^ (wi & 15)) << 4)) = kv;
            *(LAS u32x4*)(Vs + wi * 256 + ((c ^ ((wi & 7) << 1)) << 4)) = vv;
        }
        const size_t tq = rowb + (size_t)((m0 + 16 * wave + n) * dil + r);
        bf16x8 qf[4];
        {
            u32x4 qraw[4]; float ss = 0.f;
#pragma unroll
            for (int ks = 0; ks < 4; ++ks) { qraw[ks] = *(const u32x4*)(DQ + tq * 1536 + h * 128 + 32 * ks + 8 * g);
#pragma unroll
                for (int i = 0; i < 4; ++i) { const float a0 = bflo(qraw[ks][i]), a1 = bfhi(qraw[ks][i]); ss += a0 * a0 + a1 * a1; } }
            ss += __shfl_xor(ss, 16); ss += __shfl_xor(ss, 32);
            const float rqs = rsqrtf(ss * (1.f / 128.f) + EPS) * (0.08838834764831845f * 1.4426950408889634f);
#pragma unroll
            for (int ks = 0; ks < 4; ++ks) { u32x4 o;
#pragma unroll
                for (int i = 0; i < 4; ++i) { const int d = 32 * ks + 8 * g + 2 * i;
                    o[i] = pk2(bflo(qraw[ks][i]) * rqs * gqp[d] * gkp[d], bfhi(qraw[ks][i]) * rqs * gqp[d + 1] * gkp[d + 1]); }
                qf[ks] = __builtin_bit_cast(bf16x8, o); }
        }
        __syncthreads();
        if (u + F.G < BATCH * 12 * 16) { ATT_LOADKV(u + F.G); }
        f32x4 st[16];
        float mx = -INFINITY;
#pragma unroll
        for (int tau = 0; tau < 16; ++tau) {
            const bool act = tau < 8 ? (qb > 0 && tau >= wave) : (tau - 8 <= wave);
            st[tau] = (f32x4){-INFINITY, -INFINITY, -INFINITY, -INFINITY};
            if (act) {
                f32x4 a = {0.f, 0.f, 0.f, 0.f};
                const int wi = 16 * tau + n;
#pragma unroll
                for (int ks = 0; ks < 4; ++ks) { const bf16x8 kf = *(const LAS bf16x8*)(Ks + wi * 256 + (((4 * ks + g) ^ n) << 4));
                    a = __builtin_amdgcn_mfma_f32_16x16x32_bf16(kf, qf[ks], a, 0, 0, 0); }
                const f32x4 rk = *(const LAS f32x4*)(rkS + 16 * tau + 4 * g);
                a = a * rk;
                const int jt = tau & 7;
                if (jt == wave) {
#pragma unroll
                    for (int reg = 0; reg < 4; ++reg) { const int kk = 4 * g + reg; const bool ok = tau < 8 ? (kk >= n) : (kk <= n); if (!ok) a[reg] = -INFINITY; }
                }
                st[tau] = a;
                mx = fmaxf(mx, fmaxf(fmaxf(a[0], a[1]), fmaxf(a[2], a[3])));
            }
        }
        mx = fmaxf(mx, __shfl_xor(mx, 16)); mx = fmaxf(mx, __shfl_xor(mx, 32));
        float lsum = 0.f;
#pragma unroll
        for (int tau = 0; tau < 16; ++tau)
#pragma unroll
            for (int reg = 0; reg < 4; ++reg) { const float p = __builtin_amdgcn_exp2f(st[tau][reg] - mx); st[tau][reg] = p; lsum += p; }
        lsum += __shfl_xor(lsum, 16); lsum += __shfl_xor(lsum, 32);
        f32x4 o[8];
#pragma unroll
        for (int dt = 0; dt < 8; ++dt) o[dt] = (f32x4){0.f, 0.f, 0.f, 0.f};
        const int q4 = (lane & 15) >> 2, p4 = lane & 3;
#pragma unroll
        for (int a = 0; a < 8; ++a) {
            const bool act = a < 4 ? (qb > 0 && 2 * a + 1 >= wave) : (2 * (a - 4) <= wave);
            if (act) {
                u32x4 pw; pw[0] = pk2(st[2 * a][0], st[2 * a][1]); pw[1] = pk2(st[2 * a][2], st[2 * a][3]); pw[2] = pk2(st[2 * a + 1][0], st[2 * a + 1][1]); pw[3] = pk2(st[2 * a + 1][2], st[2 * a + 1][3]);
                const bf16x8 pf = __builtin_bit_cast(bf16x8, pw);
                const int row0 = 32 * a + 4 * g + q4, row1 = row0 + 16;
#pragma unroll
                for (int dt = 0; dt < 8; ++dt) {
                    const int c = 2 * dt + (p4 >> 1);
                    const v4i16_t v0 = __builtin_amdgcn_ds_read_tr16_b64_v4i16((LAS v4i16_t*)(Vs + row0 * 256 + ((c ^ ((row0 & 7) << 1)) << 4) + 8 * (p4 & 1)));
                    const v4i16_t v1 = __builtin_amdgcn_ds_read_tr16_b64_v4i16((LAS v4i16_t*)(Vs + row1 * 256 + ((c ^ ((row1 & 7) << 1)) << 4) + 8 * (p4 & 1)));
                    const bf16x8 vf = (bf16x8){v0[0], v0[1], v0[2], v0[3], v1[0], v1[1], v1[2], v1[3]};
                    o[dt] = __builtin_amdgcn_mfma_f32_16x16x32_bf16(vf, pf, o[dt], 0, 0, 0);
                }
            }
        }
        const float il = 1.f / lsum;
        bf16_t* OG = grp < 2 ? (bf16_t*)(F.ws + WS_OG01) + (size_t)grp * T * 512 : (bf16_t*)(F.ob + OUT_OG2);
#pragma unroll
        for (int dt = 0; dt < 8; ++dt) { u32x2 w; w.x = pk2(o[dt][0] * il, o[dt][1] * il); w.y = pk2(o[dt][2] * il, o[dt][3] * il);
            *(u32x2*)(OG + tq * 512 + s * 128 + 16 * dt + 4 * g) = w; }
        if (g == 0) ((float*)(F.ws + WS_LSE))[((size_t)grp * T + tq) * 4 + s] = (mx + __builtin_amdgcn_logf(lsum)) * 0.6931471805599453f;
    }
}
#undef ATT_DECODE
#undef ATT_LOADKV
__device__ __forceinline__ void p3_merge(Frame& F) {
    const int tid = opaque_tid();
    const bf16_t* OG0 = (const bf16_t*)(F.ws + WS_OG01); const bf16_t* OG1 = OG0 + (size_t)T * 512; const bf16_t* OG2 = (const bf16_t*)(F.ob + OUT_OG2);
    const float* LSE = (const float*)(F.ws + WS_LSE); bf16_t* YB = (bf16_t*)(F.ob + OUT_YB);
    for (size_t it = (size_t)F.blk * 512 + tid; it < (size_t)T * 64; it += (size_t)F.G * 512) {
        const size_t t = it >> 6; const int ch = (int)(it & 63), s = ch >> 4;
        const float l0 = LSE[t * 4 + s], l1 = LSE[((size_t)T + t) * 4 + s], l2 = LSE[((size_t)2 * T + t) * 4 + s];
        const float m = fmaxf(l0, fmaxf(l1, l2)); const float e0 = __expf(l0 - m), e1 = __expf(l1 - m), e2 = __expf(l2 - m); const float inv = 1.f / (e0 + e1 + e2);
        const float w0 = e0 * inv, w1 = e1 * inv, w2 = e2 * inv;
        const u32x4 a = *(const u32x4*)(OG0 + t * 512 + ch * 8), bq = *(const u32x4*)(OG1 + t * 512 + ch * 8), cq = *(const u32x4*)(OG2 + t * 512 + ch * 8);
        u32x4 o;
#pragma unroll
        for (int i = 0; i < 4; ++i) o[i] = pk2(w0 * bflo(a[i]) + w1 * bflo(bq[i]) + w2 * bflo(cq[i]), w0 * bfhi(a[i]) + w1 * bfhi(bq[i]) + w2 * bfhi(cq[i]));
        *(u32x4*)(YB + t * 512 + ch * 8) = o;
    }
}

constexpr size_t WS_UT = 158 * MiB, WS_WM = 190 * MiB, WS_QD = 222 * MiB, WS_KDT = 254 * MiB, WS_QK = 286 * MiB;
constexpr size_t WS_GT = 1 * MiB + 512 * 1024;
__device__ __forceinline__ unsigned off_b(unsigned row, unsigned ch) { return 256u * row + 16u * (ch ^ (((row & 3) << 2) | ((row >> 2) & 3))); }
__device__ __forceinline__ unsigned rowfrag_b(unsigned lane, unsigned rb, unsigned s) { return off_b((lane & 15) + 16 * rb, 4 * s + (lane >> 4)); }
__device__ __forceinline__ unsigned trfrag_b(unsigned lane, unsigned c, unsigned ks, unsigned t) { const unsigned g = lane >> 4, q = (lane & 15) >> 2, p = lane & 3; return off_b(32 * ks + 8 * g + 4 * t + q, 2 * c + (p >> 1)) + 8 * (p & 1); }
__device__ __forceinline__ bf16x8 tr_pair(LAS unsigned char* a0, LAS unsigned char* a1) {
    const v4i16_t v0 = __builtin_amdgcn_ds_read_tr16_b64_v4i16((LAS v4i16_t*)a0), v1 = __builtin_amdgcn_ds_read_tr16_b64_v4i16((LAS v4i16_t*)a1);
    return (bf16x8){v0[0], v0[1], v0[2], v0[3], v1[0], v1[1], v1[2], v1[3]};
}
constexpr int MST = 144;
__device__ __forceinline__ f32x4 mm64_tile(LAS unsigned char* X, LAS unsigned char* Y, int ti, int tj, int lane) {
    const int n = lane & 15, g = lane >> 4, q = n >> 2, p = lane & 3;
    f32x4 acc = {0.f, 0.f, 0.f, 0.f};
#pragma unroll
    for (int ks = 0; ks < 2; ++ks) {
        const bf16x8 a = *(const LAS bf16x8*)(X + (16 * ti + n) * MST + 16 * (4 * ks + g));
        LAS unsigned char* yb = Y + (32 * ks + 8 * g + q) * MST + 32 * tj + 8 * p;
        const bf16x8 b = tr_pair(yb, yb + 4 * MST);
        acc = __builtin_amdgcn_mfma_f32_16x16x32_bf16(a, b, acc, 0, 0, 0);
    }
    return acc;
}
__device__ __forceinline__ void st_b16(LAS unsigned char* M, int row, int col, float v) { *(LAS unsigned short*)(M + row * MST + col * 2) = (unsigned short)pk2(v, 0.f); }

__device__ __forceinline__ void p3b_gdn_prep(Frame& F) {
    LAS unsigned char* Kn = F.lds; LAS unsigned char* Qn = F.lds + 16384; LAS unsigned char* Vn = F.lds + 32768;
    LAS unsigned char* R0 = F.lds + 49152; LAS unsigned char* R1 = R0 + 9216; LAS unsigned char* R2 = R1 + 9216; LAS unsigned char* R3 = R2 + 9216; LAS unsigned char* R4 = R3 + 9216;
    LAS float* Af = (LAS float*)(F.lds + 95232);
    LAS float* CW = (LAS float*)(F.lds + 111872);
    LAS float* betaS = (LAS float*)(F.lds + 118016); LAS float* gS = betaS + 64; LAS float* gcS = gS + 64;
    const bf16_t* GQ = (const bf16_t*)(F.ws + WS_GQ); const float* BA = (const float*)(F.ws + WS_BA);
    bf16_t* UT = (bf16_t*)(F.ws + WS_UT); bf16_t* WM = (bf16_t*)(F.ws + WS_WM); bf16_t* QD = (bf16_t*)(F.ws + WS_QD); bf16_t* KDT = (bf16_t*)(F.ws + WS_KDT); bf16_t* QK = (bf16_t*)(F.ws + WS_QK);
    float* GT = (float*)(F.ws + WS_GT);
    const float* convw = inp(I_CONVW);
    LAS unsigned char* RAW = F.lds + 49152;
    u32x4 own[3][2], halo; float cwr[3], bar0 = 0.f, bar1 = 0.f;
#define PREP_LOAD(u_) do { const int t_ = opaque_tid(), tr_ = t_ >> 3, cg_ = t_ & 7, h_ = ((u_) >> 5) & 7, nch_ = (u_) & 31; const size_t t0_ = (size_t)((u_) >> 8) * SEQ + 64 * nch_; \
        _Pragma("unroll") for (int tens = 0; tens < 3; ++tens) { const bf16_t* src = GQ + (size_t)tens * T * 1024 + (t0_ + tr_) * 1024 + h_ * 128 + 16 * cg_; own[tens][0] = *(const u32x4*)src; own[tens][1] = *(const u32x4*)(src + 8); } \
        halo = (u32x4){0u, 0u, 0u, 0u}; \
        if (t_ < 144 && nch_ > 0) { const int tens = t_ / 48, rem = t_ % 48; halo = *(const u32x4*)(GQ + (size_t)tens * T * 1024 + (t0_ - 3 + (rem >> 4)) * 1024 + h_ * 128 + (rem & 15) * 8); } \
        _Pragma("unroll") for (int i = 0; i < 3; ++i) { const int ii = t_ + 512 * i; cwr[i] = convw[((ii >> 7) & 3) * 3072 + (ii >> 9) * 1024 + h_ * 128 + (ii & 127)]; } \
        if (cg_ == 0) { bar0 = BA[(t0_ + tr_) * 16 + h_]; bar1 = BA[(t0_ + tr_) * 16 + 8 + h_]; } } while (0)
    if (F.blk < 2048) { PREP_LOAD(F.blk); }
#pragma unroll 1
    for (int u = F.blk; u < 2048; u += F.G) {
        const int tid = opaque_tid(), lane = tid & 63, wave = __builtin_amdgcn_readfirstlane(tid >> 6), n = lane & 15, g = lane >> 4;
        const int h = (u >> 5) & 7, nch = u & 31;
        const int tr = tid >> 3, cg = tid & 7;
        __syncthreads();
#pragma unroll
        for (int i = 0; i < 3; ++i) CW[tid + 512 * i] = cwr[i];
#pragma unroll
        for (int tens = 0; tens < 3; ++tens) { LAS unsigned char* rp = RAW + (tens * 67 + 3 + tr) * 272 + 32 * cg; *(LAS u32x4*)rp = own[tens][0]; *(LAS u32x4*)(rp + 16) = own[tens][1]; }
        if (tid < 144) { const int tens = tid / 48, rem = tid % 48; *(LAS u32x4*)(RAW + (tens * 67 + (rem >> 4)) * 272 + (rem & 15) * 16) = halo; }
        __syncthreads();
        float qv[16], kv[16];
        {
            float vv[16];
#pragma unroll
            for (int tens = 0; tens < 3; ++tens) {
                float acc[16];
#pragma unroll
                for (int c = 0; c < 16; ++c) acc[c] = 0.f;
#pragma unroll
                for (int j = 0; j < 4; ++j) { const LAS unsigned char* rp = RAW + (tens * 67 + tr + j) * 272 + 32 * cg; const u32x4 x0 = *(const LAS u32x4*)rp, x1 = *(const LAS u32x4*)(rp + 16);
                        const LAS float* w = CW + (tens * 4 + j) * 128 + 16 * cg;
#pragma unroll
                        for (int i = 0; i < 4; ++i) { acc[2 * i] += w[2 * i] * bflo(x0[i]); acc[2 * i + 1] += w[2 * i + 1] * bfhi(x0[i]); acc[8 + 2 * i] += w[8 + 2 * i] * bflo(x1[i]); acc[9 + 2 * i] += w[9 + 2 * i] * bfhi(x1[i]); } }
#pragma unroll
                for (int c = 0; c < 16; ++c) { const float y = siluf_(acc[c]); if (tens == 0) qv[c] = y; else if (tens == 1) kv[c] = y; else vv[c] = y; }
            }
            float sq = 0.f, sk = 0.f;
#pragma unroll
            for (int c = 0; c < 16; ++c) { sq += qv[c] * qv[c]; sk += kv[c] * kv[c]; }
            sq = red8(sq); sk = red8(sk);
            const float rq = rsqrtf(sq + EPS) * 0.08838834764831845f, rk = rsqrtf(sk + EPS);
#pragma unroll
            for (int c = 0; c < 16; ++c) { qv[c] *= rq; kv[c] *= rk; }
#pragma unroll
            for (int hf = 0; hf < 2; ++hf) { u32x4 a, bq, cq;
#pragma unroll
                for (int i = 0; i < 4; ++i) { a[i] = pk2(kv[8 * hf + 2 * i], kv[8 * hf + 2 * i + 1]); bq[i] = pk2(qv[8 * hf + 2 * i], qv[8 * hf + 2 * i + 1]); cq[i] = pk2(vv[8 * hf + 2 * i], vv[8 * hf + 2 * i + 1]); }
                const unsigned o = off_b(tr, 2 * cg + hf);
                *(LAS u32x4*)(Kn + o) = a; *(LAS u32x4*)(Qn + o) = bq; *(LAS u32x4*)(Vn + o) = cq; }
        }
        if (cg == 0) { const float bb = bar0, aa = bar1; const float sp = aa + inp(I_DTB)[h]; const float spl = sp > 20.f ? sp : log1pf(__expf(sp));
            betaS[tr] = sigmoidf_(bb); gS[tr] = -__expf(inp(I_ALOG)[h]) * spl; }
        __syncthreads();
        if (wave == 0) { float v = gS[lane];
#pragma unroll
            for (int d = 1; d < 64; d <<= 1) { const float t = __shfl_up(v, d); if (lane >= d) v += t; }
            gcS[lane] = v; }
        __syncthreads();
        {
            const float eg = __expf(gcS[tr]);
            u32x4 a, bq;
#pragma unroll
            for (int i = 0; i < 4; ++i) { a[i] = pk2(qv[2 * i] * eg, qv[2 * i + 1] * eg); bq[i] = pk2(qv[8 + 2 * i] * eg, qv[9 + 2 * i] * eg); }
            bf16_t* d = QD + (size_t)u * 8192 + (size_t)(((tr >> 4) * 4 + (cg >> 1)) * 64 + (tr & 15)) * 8;
            *(u32x4*)(d + (((2 * cg) & 3) * 16) * 8) = a; *(u32x4*)(d + (((2 * cg + 1) & 3) * 16) * 8) = bq;
        }
        if (u + F.G < 2048) { PREP_LOAD(u + F.G); }
        const float gcl = gcS[63];
        if (tid == 0) GT[u] = __expf(gcl);
#pragma unroll
        for (int rep = 0; rep < 2; ++rep) {
            const int idx = wave + 8 * rep, ti = idx >> 2, tj = idx & 3;
            f32x4 kk = {0.f, 0.f, 0.f, 0.f}, qk = {0.f, 0.f, 0.f, 0.f};
            if (ti >= tj) {
#pragma unroll
                for (int ks = 0; ks < 4; ++ks) { const bf16x8 a = *(const LAS bf16x8*)(Kn + rowfrag_b(lane, ti, ks)), bb = *(const LAS bf16x8*)(Kn + rowfrag_b(lane, tj, ks));
                    kk = __builtin_amdgcn_mfma_f32_16x16x32_bf16(a, bb, kk, 0, 0, 0); }
#pragma unroll
                for (int ks = 0; ks < 4; ++ks) { const bf16x8 a = *(const LAS bf16x8*)(Kn + rowfrag_b(lane, tj, ks)), bb = *(const LAS bf16x8*)(Qn + rowfrag_b(lane, ti, ks));
                    qk = __builtin_amdgcn_mfma_f32_16x16x32_bf16(a, bb, qk, 0, 0, 0); }
            }
            {
                const int j = 16 * tj + n; const float gj = gcS[j];
#pragma unroll
                for (int reg = 0; reg < 4; ++reg) { const int i = 16 * ti + 4 * g + reg; float v = 0.f; if (j < i) v = kk[reg] * betaS[i] * __expf(gcS[i] - gj);
                    Af[i * 65 + j] = v; st_b16(R0, i, j, ti > tj ? v : 0.f); }
            }
            {
                const int i = 16 * ti + n; const float gi = gcS[i]; float o[4];
#pragma unroll
                for (int reg = 0; reg < 4; ++reg) { const int j = 16 * tj + 4 * g + reg; o[reg] = (j <= i) ? qk[reg] * __expf(gi - gcS[j]) : 0.f; }
                u32x2 w; w.x = pk2(o[0], o[1]); w.y = pk2(o[2], o[3]);
                *(u32x2*)(QK + (size_t)u * 4096 + (size_t)((ti * 2 + (tj >> 1)) * 64 + ((2 * tj + (g >> 1)) & 3) * 16 + n) * 8 + 4 * (g & 1)) = w;
            }
        }
        for (int i = tid; i < 9216 / 4; i += 512) ((LAS unsigned*)R1)[i] = 0u;
#pragma unroll
        for (int it = 0; it < 2; ++it) { const int c = tid & 127, tok0 = 8 * ((tid >> 7) + 4 * it); u32x4 w;
#pragma unroll
            for (int e2 = 0; e2 < 4; ++e2) { float v[2];
#pragma unroll
                for (int e1 = 0; e1 < 2; ++e1) { const int tok = tok0 + 2 * e2 + e1; const unsigned short kb = *(const LAS unsigned short*)(Kn + off_b(tok, c >> 3) + (c & 7) * 2); v[e1] = bf2f(kb) * __expf(gcl - gcS[tok]); }
                w[e2] = pk2(v[0], v[1]); }
            *(u32x4*)(KDT + (size_t)u * 8192 + (size_t)(((c >> 4) * 2 + (tok0 >> 5)) * 64 + ((tok0 >> 3) & 3) * 16 + (c & 15)) * 8) = w; }
        __syncthreads();
        if (tid < 64) { const int bI = tid >> 4, cc = tid & 15; float x[16];
#pragma unroll
            for (int i = 0; i < 16; ++i) { float s = (i == cc) ? 1.f : 0.f;
#pragma unroll
                for (int j = 0; j < 16; ++j) if (j < i) s -= Af[(16 * bI + i) * 65 + 16 * bI + j] * x[j];
                x[i] = s; }
#pragma unroll
            for (int i = 0; i < 16; ++i) st_b16(R1, 16 * bI + i, 16 * bI + cc, x[i]); }
        __syncthreads();
#pragma unroll
        for (int rep = 0; rep < 2; ++rep) { const int idx = wave + 8 * rep, ti = idx >> 2, tj = idx & 3; const f32x4 m = mm64_tile(R1, R0, ti, tj, lane);
#pragma unroll
            for (int reg = 0; reg < 4; ++reg) { const int i = 16 * ti + 4 * g + reg, j = 16 * tj + n; st_b16(R2, i, j, m[reg]); st_b16(R3, i, j, (i == j ? 1.f : 0.f) - m[reg]); } }
        __syncthreads();
#pragma unroll
        for (int rep = 0; rep < 2; ++rep) { const int idx = wave + 8 * rep, ti = idx >> 2, tj = idx & 3; const f32x4 m = mm64_tile(R2, R2, ti, tj, lane);
#pragma unroll
            for (int reg = 0; reg < 4; ++reg) { const int i = 16 * ti + 4 * g + reg, j = 16 * tj + n; st_b16(R4, i, j, (i == j ? 1.f : 0.f) + m[reg]); } }
        __syncthreads();
#pragma unroll
        for (int rep = 0; rep < 2; ++rep) { const int idx = wave + 8 * rep, ti = idx >> 2, tj = idx & 3; const f32x4 m = mm64_tile(R4, R1, ti, tj, lane);
#pragma unroll
            for (int reg = 0; reg < 4; ++reg) { const int i = 16 * ti + 4 * g + reg, j = 16 * tj + n; st_b16(R0, i, j, m[reg]); } }
        __syncthreads();
#pragma unroll
        for (int rep = 0; rep < 2; ++rep) { const int idx = wave + 8 * rep, ti = idx >> 2, tj = idx & 3; const f32x4 m = mm64_tile(R3, R0, ti, tj, lane);
            const int j = 16 * tj + n; const float bj = betaS[j], bw = bj * __expf(gcS[j]);
#pragma unroll
            for (int reg = 0; reg < 4; ++reg) { const int i = 16 * ti + 4 * g + reg; st_b16(R2, i, j, m[reg] * bj); st_b16(R4, i, j, m[reg] * bw); } }
        __syncthreads();
        {
            const int tt = wave >> 1, dvb = 4 * (wave & 1);
#pragma unroll
            for (int k = 0; k < 4; ++k) { const int dvt = dvb + k; f32x4 acc = {0.f, 0.f, 0.f, 0.f};
#pragma unroll
                for (int ks = 0; ks < 2; ++ks) { const bf16x8 a = *(const LAS bf16x8*)(R2 + (16 * tt + n) * MST + 16 * (4 * ks + g));
                    const bf16x8 bb = tr_pair(Vn + trfrag_b(lane, dvt, ks, 0), Vn + trfrag_b(lane, dvt, ks, 1));
                    acc = __builtin_amdgcn_mfma_f32_16x16x32_bf16(a, bb, acc, 0, 0, 0); }
                u32x2 w; w.x = pk2(acc[0], acc[1]); w.y = pk2(acc[2], acc[3]);
                *(u32x2*)(UT + (size_t)u * 8192 + (size_t)((tt * 8 + dvt) * 64 + lane) * 4) = w; }
            const int dkt = wave;
#pragma unroll
            for (int t4 = 0; t4 < 4; ++t4) { f32x4 acc = {0.f, 0.f, 0.f, 0.f};
#pragma unroll
                for (int ks = 0; ks < 2; ++ks) { const bf16x8 a = tr_pair(Kn + trfrag_b(lane, dkt, ks, 0), Kn + trfrag_b(lane, dkt, ks, 1));
                    const bf16x8 bb = *(const LAS bf16x8*)(R4 + (16 * t4 + n) * MST + 16 * (4 * ks + g));
                    acc = __builtin_amdgcn_mfma_f32_16x16x32_bf16(a, bb, acc, 0, 0, 0); }
                u32x2 w; w.x = pk2(acc[0], acc[1]); w.y = pk2(acc[2], acc[3]);
                *(u32x2*)(WM + (size_t)u * 8192 + (size_t)((t4 * 4 + (dkt >> 1)) * 64 + ((2 * dkt + (g >> 1)) & 3) * 16 + n) * 8 + 4 * (g & 1)) = w; }
        }
    }
}

#undef PREP_LOAD
__device__ __forceinline__ void p4_gdn_scan(Frame& F) {
    if (F.blk >= 64) return;
    const int tid = opaque_tid(), lane = tid & 63, wave = __builtin_amdgcn_readfirstlane(tid >> 6), n = lane & 15, g = lane >> 4;
    const int b = F.blk >> 3, h = F.blk & 7; const size_t u0 = (size_t)F.blk * 32;
    LAS unsigned char* SbT0 = F.lds; LAS unsigned char* VNT = F.lds + 69632; LAS unsigned char* Os0 = F.lds + 88064; LAS float* ngS = (LAS float*)(F.lds + 122880);
    const bf16_t* UT = (const bf16_t*)(F.ws + WS_UT); const bf16_t* WM = (const bf16_t*)(F.ws + WS_WM); const bf16_t* QD = (const bf16_t*)(F.ws + WS_QD);
    const bf16_t* KDT = (const bf16_t*)(F.ws + WS_KDT); const bf16_t* QK = (const bf16_t*)(F.ws + WS_QK); const float* GT = (const float*)(F.ws + WS_GT);
    const bf16_t* GZ = (const bf16_t*)(F.ob + OUT_GZ); bf16_t* YA = (bf16_t*)(F.ws + WS_YA);
    const int tt = wave >> 1, dvb = 4 * (wave & 1);
    const int tok = tid >> 3, seg = tid & 7;
    f32x4 S[8];
#pragma unroll
    for (int i = 0; i < 8; ++i) S[i] = (f32x4){0.f, 0.f, 0.f, 0.f};
    if (tid < 128) ngS[tid] = inp(I_GNG)[tid];
    bf16x8 wfA[4], wfB[4], qdf[4], qkf[2], kdf[2]; u32x2 ufA[4], ufB[4]; u32x4 zc[2], zp[2]; float gtA, gtB;
    const unsigned lo_w = (unsigned)((tt * 4) * 64 + lane) * 16u, lo_u = (unsigned)((tt * 8 + dvb) * 64 + lane) * 8u, lo_qk = (unsigned)((tt * 2) * 64 + lane) * 16u,
                   lo_kd = (unsigned)((wave * 2) * 64 + lane) * 16u, lo_z = (unsigned)(tok * 1024 + h * 128 + 16 * seg) * 2u;
    const char* const pWM = (const char*)(WM + u0 * 8192); const char* const pQD = (const char*)(QD + u0 * 8192); const char* const pUT = (const char*)(UT + u0 * 8192);
    const char* const pKD = (const char*)(KDT + u0 * 8192); const char* const pQK = (const char*)(QK + u0 * 4096); const char* const pGZ = (const char*)(GZ + (size_t)b * SEQ * 1024);
#define LD_SET(X, nn_) do { const size_t c16_ = (size_t)(nn_) * 16384; \
        _Pragma("unroll") for (int ks = 0; ks < 4; ++ks) wf##X[ks] = *(const bf16x8*)(pWM + c16_ + lo_w + 1024 * ks); \
        _Pragma("unroll") for (int k = 0; k < 4; ++k) uf##X[k] = *(const u32x2*)(pUT + c16_ + lo_u + 512 * k); \
        gt##X = GT[u0 + (nn_)]; } while (0)
#define LD_Q(nn_) do { const size_t c16_ = (size_t)(nn_) * 16384, c8_ = (size_t)(nn_) * 8192; \
        _Pragma("unroll") for (int ks = 0; ks < 4; ++ks) qdf[ks] = *(const bf16x8*)(pQD + c16_ + lo_w + 1024 * ks); \
        _Pragma("unroll") for (int ks = 0; ks < 2; ++ks) qkf[ks] = *(const bf16x8*)(pQK + c8_ + lo_qk + 1024 * ks); } while (0)
#define LD_K(nn_) do { const size_t c16_ = (size_t)(nn_) * 16384, cz_ = (size_t)(nn_) * 64 * 2048; \
        _Pragma("unroll") for (int ks = 0; ks < 2; ++ks) kdf[ks] = *(const bf16x8*)(pKD + c16_ + lo_kd + 1024 * ks); \
        zc[0] = *(const u32x4*)(pGZ + cz_ + lo_z); zc[1] = *(const u32x4*)(pGZ + cz_ + lo_z + 16); } while (0)
#define NORM_OUT(OsB, nc_, Z) do { const size_t t = (size_t)b * SEQ + 64 * (nc_) + tok; \
        const u32x4 o0 = *(const LAS u32x4*)((OsB) + tok * 272 + 32 * seg), o1 = *(const LAS u32x4*)((OsB) + tok * 272 + 32 * seg + 16); float o[16]; float ss = 0.f; \
        _Pragma("unroll") for (int i = 0; i < 4; ++i) { o[2 * i] = bflo(o0[i]); o[2 * i + 1] = bfhi(o0[i]); o[8 + 2 * i] = bflo(o1[i]); o[9 + 2 * i] = bfhi(o1[i]); } \
        _Pragma("unroll") for (int i = 0; i < 16; ++i) ss += o[i] * o[i]; \
        ss = red8(ss); \
        const float rstd = rsqrtf(ss * (1.f / 128.f) + EPS); \
        u32x4 y0, y1; \
        _Pragma("unroll") for (int i = 0; i < 4; ++i) { y0[i] = pk2(o[2 * i] * rstd * ngS[16 * seg + 2 * i] * siluf_(bflo(Z[0][i])), o[2 * i + 1] * rstd * ngS[16 * seg + 2 * i + 1] * siluf_(bfhi(Z[0][i]))); \
            y1[i] = pk2(o[8 + 2 * i] * rstd * ngS[16 * seg + 8 + 2 * i] * siluf_(bflo(Z[1][i])), o[9 + 2 * i] * rstd * ngS[16 * seg + 9 + 2 * i] * siluf_(bfhi(Z[1][i]))); } \
        *(u32x4*)(YA + t * 1024 + h * 128 + 16 * seg) = y0; *(u32x4*)(YA + t * 1024 + h * 128 + 16 * seg + 8) = y1; } while (0)
#define CHUNK(X, nc_, P) do { LAS unsigned char* const SbT = SbT0 + (P) * 34816; LAS unsigned char* const OsW = Os0 + (P) * 17408; \
          \
        _Pragma("unroll") for (int dvt = 0; dvt < 8; ++dvt) { u32x2 w; w.x = pk2(S[dvt][0], S[dvt][1]); w.y = pk2(S[dvt][2], S[dvt][3]); \
            *(LAS u32x2*)(SbT + (16 * dvt + n) * 272 + (16 * wave + 4 * g) * 2) = w; } \
        __syncthreads(); \
          \
        if ((nc_) > 0) { NORM_OUT(Os0 + (1 - (P)) * 17408, (nc_) - 1, zp); } \
          \
        { f32x4 acc[4]; \
          _Pragma("unroll") for (int k = 0; k < 4; ++k) acc[k] = (f32x4){0.f, 0.f, 0.f, 0.f}; \
          _Pragma("unroll") for (int ks = 0; ks < 4; ++ks) { bf16x8 bb[4]; \
            _Pragma("unroll") for (int k = 0; k < 4; ++k) bb[k] = *(const LAS bf16x8*)(SbT + (16 * (dvb + k) + n) * 272 + 16 * (4 * ks + g)); \
            _Pragma("unroll") for (int k = 0; k < 4; ++k) acc[k] = __builtin_amdgcn_mfma_f32_16x16x32_bf16(wf##X[ks], bb[k], acc[k], 0, 0, 0); } \
          _Pragma("unroll") for (int k = 0; k < 4; ++k) { u32x2 w; w.x = pk2(bflo(uf##X[k].x) - acc[k][0], bfhi(uf##X[k].x) - acc[k][1]); w.y = pk2(bflo(uf##X[k].y) - acc[k][2], bfhi(uf##X[k].y) - acc[k][3]); \
            *(LAS u32x2*)(VNT + (16 * (dvb + k) + n) * MST + (16 * tt + 4 * g) * 2) = w; } } \
        __syncthreads(); \
          \
        { f32x4 acc[4]; \
          _Pragma("unroll") for (int k = 0; k < 4; ++k) acc[k] = (f32x4){0.f, 0.f, 0.f, 0.f}; \
          _Pragma("unroll") for (int ks = 0; ks < 4; ++ks) { bf16x8 bb[4]; \
            _Pragma("unroll") for (int k = 0; k < 4; ++k) bb[k] = *(const LAS bf16x8*)(SbT + (16 * (dvb + k) + n) * 272 + 16 * (4 * ks + g)); \
            _Pragma("unroll") for (int k = 0; k < 4; ++k) acc[k] = __builtin_amdgcn_mfma_f32_16x16x32_bf16(qdf[ks], bb[k], acc[k], 0, 0, 0); } \
          _Pragma("unroll") for (int ks = 0; ks < 2; ++ks) { bf16x8 bb[4]; \
            _Pragma("unroll") for (int k = 0; k < 4; ++k) bb[k] = *(const LAS bf16x8*)(VNT + (16 * (dvb + k) + n) * MST + 16 * (4 * ks + g)); \
            _Pragma("unroll") for (int k = 0; k < 4; ++k) acc[k] = __builtin_amdgcn_mfma_f32_16x16x32_bf16(qkf[ks], bb[k], acc[k], 0, 0, 0); } \
          _Pragma("unroll") for (int k = 0; k < 4; ++k) _Pragma("unroll") for (int reg = 0; reg < 4; ++reg) \
              *(LAS unsigned short*)(OsW + (16 * tt + 4 * g + reg) * 272 + (16 * (dvb + k) + n) * 2) = (unsigned short)pk2(acc[k][reg], 0.f); } \
        if ((nc_) + 1 < 32) { LD_Q((nc_) + 1); }     \
          \
        _Pragma("unroll") for (int dvt = 0; dvt < 8; ++dvt) S[dvt] = S[dvt] * gt##X; \
        _Pragma("unroll") for (int ks = 0; ks < 2; ++ks) { bf16x8 bb[8]; \
            _Pragma("unroll") for (int dvt = 0; dvt < 8; ++dvt) bb[dvt] = *(const LAS bf16x8*)(VNT + (16 * dvt + n) * MST + 16 * (4 * ks + g)); \
            _Pragma("unroll") for (int dvt = 0; dvt < 8; ++dvt) S[dvt] = __builtin_amdgcn_mfma_f32_16x16x32_bf16(kdf[ks], bb[dvt], S[dvt], 0, 0, 0); } \
        zp[0] = zc[0]; zp[1] = zc[1]; \
        if ((nc_) + 1 < 32) { LD_K((nc_) + 1); } \
    } while (0)
    LD_SET(A, 0); LD_Q(0); LD_K(0);
#pragma unroll 1
    for (int nc = 0; nc < 32; nc += 2) {
        LD_SET(B, nc + 1);
        CHUNK(A, nc, 0);
        if (nc + 2 < 32) { LD_SET(A, nc + 2); }
        CHUNK(B, nc + 1, 1);
    }
    __syncthreads();
    NORM_OUT(Os0 + 17408, 31, zp);
#undef LD_SET
#undef LD_Q
#undef LD_K
#undef NORM_OUT
#undef CHUNK
}

__device__ __forceinline__ void p7_route(Frame& F, const bool emit) {
    const int ftid = opaque_tid(), flane = ftid & 63, fwave = __builtin_amdgcn_readfirstlane(ftid >> 6);
    constexpr int HS = 132, WSS = 80, LS = 65;
    LAS float* Hs = (LAS float*)F.lds;
    LAS float* Wsm = (LAS float*)(F.lds + 34816);
    LAS float* Ls = (LAS float*)(F.lds + 77824);
    LAS float* SelS = (LAS float*)(F.lds + 96256);
    LAS int* hist = (LAS int*)(F.lds + 114688);
    const float* MOD = (const float*)(F.ws + WS_MOD); const float* X1 = F.out; bf16_t* H2 = (bf16_t*)(F.ws + WS_H);
    int* LIST = (int*)(F.ws + WS_LIST); float* LISTW = (float*)(F.ws + WS_LISTW); gu32* gcnt = (gu32*)(F.ws + WS_CTL) + CW_CNT;
    const int tid = ftid, lane = flane, wave = fwave;
    for (int grp = F.blk; grp < T / 64; grp += F.G) {
        const int row0 = grp * 64, b = row0 / SEQ;
        const float* sh2 = MOD + b * 6144 + 3 * 1024; const float* sc2 = sh2 + 1024;
        float rstd[8];
#pragma unroll
        for (int hb = 0; hb < 2; ++hb) {
            f32x4 xx[4][4];
#pragma unroll
            for (int rr = 0; rr < 4; ++rr) { const f32x4* xr = (const f32x4*)(X1 + (size_t)(row0 + 8 * wave + 4 * hb + rr) * DM) + lane;
#pragma unroll
                for (int j = 0; j < 4; ++j) xx[rr][j] = xr[64 * j]; }
#pragma unroll
            for (int rr = 0; rr < 4; ++rr) { float ss = 0.f;
#pragma unroll
                for (int j = 0; j < 4; ++j) { const f32x4 v = xx[rr][j]; ss += (v.x * v.x + v.y * v.y) + (v.z * v.z + v.w * v.w); }
                rstd[4 * hb + rr] = rsqrtf(wave_sum(ss) * (1.f / DM) + EPS); }
        }
        f32x4 acc0 = {0.f, 0.f, 0.f, 0.f}, acc1 = {0.f, 0.f, 0.f, 0.f};
        const int rg = wave & 3, et = (wave >> 2) * 2;
        f32x2 xn[8];
#pragma unroll
        for (int rr = 0; rr < 8; ++rr) xn[rr] = *(const f32x2*)(X1 + (size_t)(row0 + 8 * wave + rr) * DM + 2 * lane);
        for (int c = 0; c < 8; ++c) {
            const int k = c * 128 + 2 * lane;
            const f32x2 g2 = *(const f32x2*)(inp(I_GFFN) + k), s2 = *(const f32x2*)(sc2 + k), h2 = *(const f32x2*)(sh2 + k);
#pragma unroll
            for (int rr = 0; rr < 8; ++rr) { const size_t row = (size_t)(row0 + 8 * wave + rr);
                const f32x2 xv = xn[rr];
                const f32x2 hv = (xv * rstd[rr]) * g2 * (s2 + 1.0f) + h2;
                *(LAS f32x2*)(Hs + (8 * wave + rr) * HS + 2 * lane) = hv;
                *(unsigned*)(H2 + row * DM + k) = pk2(hv.x, hv.y); }
#pragma unroll
            for (int j = 0; j < 4; ++j) { const int kk = (tid >> 4) + 32 * j, e4 = (tid & 15) * 4;
                *(LAS f32x4*)(Wsm + kk * WSS + e4) = *(const f32x4*)(inp(I_WR) + (size_t)(c * 128 + kk) * 64 + e4); }
            __syncthreads();
            if (c < 7) {
#pragma unroll
                for (int rr = 0; rr < 8; ++rr) xn[rr] = *(const f32x2*)(X1 + (size_t)(row0 + 8 * wave + rr) * DM + (c + 1) * 128 + 2 * lane); }
#pragma unroll 4
            for (int kk = 0; kk < 32; ++kk) {
                const float a = Hs[(rg * 16 + (lane & 15)) * HS + 4 * kk + (lane >> 4)];
                const float b0 = Wsm[(4 * kk + (lane >> 4)) * WSS + et * 16 + (lane & 15)], b1 = Wsm[(4 * kk + (lane >> 4)) * WSS + et * 16 + 16 + (lane & 15)];
                acc0 = __builtin_amdgcn_mfma_f32_16x16x4f32(a, b0, acc0, 0, 0, 0);
                acc1 = __builtin_amdgcn_mfma_f32_16x16x4f32(a, b1, acc1, 0, 0, 0);
            }
            __syncthreads();
        }
#pragma unroll
        for (int reg = 0; reg < 4; ++reg) { const int r = rg * 16 + 4 * (lane >> 4) + reg; Ls[r * LS + et * 16 + (lane & 15)] = acc0[reg]; Ls[r * LS + et * 16 + 16 + (lane & 15)] = acc1[reg]; }
        if (tid < 128) hist[tid] = 0;
        __syncthreads();
        {
            const int r = tid >> 3, q = tid & 7;
            float s[8], sel[8];
#pragma unroll
            for (int i = 0; i < 8; ++i) { s[i] = sigmoidf_(Ls[r * LS + q * 8 + i]); sel[i] = s[i] + inp(I_RB)[q * 8 + i]; }
            float m1 = -INFINITY, m2 = -INFINITY;
#pragma unroll
            for (int i = 0; i < 8; ++i) { const float v = sel[i]; if (v > m1) { m2 = m1; m1 = v; } else if (v > m2) m2 = v; }
            const float gs = m1 + m2;
            int rank = 0;
#pragma unroll
            for (int j = 0; j < 8; ++j) { const float o = __shfl(gs, (lane & ~7) + j); rank += ((o > gs) || (o == gs && j < q)) ? 1 : 0; }
            const bool gsel = rank < 4;
#pragma unroll
            for (int i = 0; i < 8; ++i) SelS[r * 64 + q * 8 + i] = gsel ? sel[i] : -INFINITY;
            __syncthreads();
            int cn[8];
#pragma unroll
            for (int i = 0; i < 8; ++i) cn[i] = 0;
            for (int j = 0; j < 64; ++j) { const float o = SelS[r * 64 + j];
#pragma unroll
                for (int i = 0; i < 8; ++i) cn[i] += ((o > sel[i]) || (o == sel[i] && j < q * 8 + i)) ? 1 : 0; }
            float part = 0.f;
#pragma unroll
            for (int i = 0; i < 8; ++i) if (gsel && cn[i] < 8) part += s[i];
            part = red8(part);
            const float inv = 2.5f / part;
            int lp[8];
#pragma unroll
            for (int i = 0; i < 8; ++i) { lp[i] = -1; if (emit && gsel && cn[i] < 8) lp[i] = atomicAdd((int*)(hist + q * 8 + i), 1); }
            __syncthreads();
            if (emit && tid < 64) hist[64 + tid] = (int)__hip_atomic_fetch_add(gcnt + tid, (unsigned)hist[tid], RLX_AGENT);
            __syncthreads();
#pragma unroll
            for (int i = 0; i < 8; ++i) if (lp[i] >= 0) { const int e = q * 8 + i; const size_t li = (size_t)e * T + hist[64 + e] + lp[i]; LIST[li] = (row0 + r) * 8 + cn[i]; LISTW[li] = s[i] * inv; }
            __syncthreads();
        }
    }
}


__device__ __forceinline__ void p9_combine(Frame& F) {
    const int tid = opaque_tid();
    const float* MOD = (const float*)(F.ws + WS_MOD); const unsigned char* SLOT = F.ws + WS_SLOT; const bf16_t* SH = (const bf16_t*)(F.ws + WS_SH); float* out = F.out;
    for (size_t it = (size_t)F.blk * 512 + tid; it < (size_t)T * 64; it += (size_t)F.G * 512) {
        const size_t t = it >> 6; const int c0 = (int)(it & 63) * 16; const int b = (int)(t / SEQ);
        u32x4 sl[8];
#pragma unroll
        for (int k = 0; k < 8; ++k) sl[k] = *(const u32x4*)(SLOT + (t * 8 + k) * 1024 + c0);
        const u32x4 s0 = *(const u32x4*)(SH + t * 1024 + c0), s1 = *(const u32x4*)(SH + t * 1024 + c0 + 8);
        f32x4 xv[4], gv[4];
#pragma unroll
        for (int i = 0; i < 4; ++i) { xv[i] = *(const f32x4*)(out + t * 1024 + c0 + 4 * i); gv[i] = *(const f32x4*)(MOD + b * 6144 + 5 * 1024 + c0 + 4 * i); }
        float acc[16];
#pragma unroll
        for (int i = 0; i < 4; ++i) { acc[2 * i] = bflo(s0[i]); acc[2 * i + 1] = bfhi(s0[i]); acc[8 + 2 * i] = bflo(s1[i]); acc[9 + 2 * i] = bfhi(s1[i]); }
#pragma unroll
        for (int k = 0; k < 8; ++k)
#pragma unroll
            for (int i = 0; i < 4; ++i) { const f32x2 lo = __builtin_amdgcn_cvt_pk_f32_fp8((int)sl[k][i], false), hi = __builtin_amdgcn_cvt_pk_f32_fp8((int)sl[k][i], true);
                acc[4 * i] += lo.x; acc[4 * i + 1] += lo.y; acc[4 * i + 2] += hi.x; acc[4 * i + 3] += hi.y; }
#pragma unroll
        for (int i = 0; i < 4; ++i) { f32x4 o; o.x = xv[i].x + gv[i].x * acc[4 * i]; o.y = xv[i].y + gv[i].y * acc[4 * i + 1]; o.z = xv[i].z + gv[i].z * acc[4 * i + 2]; o.w = xv[i].w + gv[i].w * acc[4 * i + 3];
            *(f32x4*)(out + t * 1024 + c0 + 4 * i) = o; }
    }
}

struct Args { const float* in[24]; float* out; unsigned char* ws; };
__global__ void __launch_bounds__(512, 2) mega_fwd(Args args) {
    extern __shared__ __attribute__((aligned(16))) unsigned char lds_raw[];
    Frame F;
    F.lds = (LAS unsigned char*)lds_raw;
    F.G = gridDim.x; F.blk = blockIdx.x;
    F.out = args.out; F.ws = args.ws; F.ob = (unsigned char*)args.out;
    volatile LAS unsigned* MISC = (volatile LAS unsigned*)(F.lds + MISC_OFF);
    for (int u = threadIdx.x; u < 64; u += 512) MISC[u] = 0u;
    __syncthreads();
    XcdBarrier bar = xcd_barrier_post((unsigned*)(F.ws + WS_CTL) + CW_BAR, MISC + 8);
#define GRID_BAR() xcd_barrier(bar)
    unsigned char* ws = F.ws;
    const float* MOD = (const float*)(ws + WS_MOD);

#ifndef DUPMASK
#define DUPMASK 0
#endif
#define REP(k) _Pragma("unroll 1") for (int rep_ = 0; rep_ < (((DUPMASK) >> (k)) & 1 ? 2 : 1); ++rep_)
    REP(0) { p0_mod(F); }
    GRID_BAR();
    REP(1) { p1_norm(F); }
    __syncthreads();
    p0_weights(F);
    GRID_BAR();
    REP(2) { pg8::DenseOrder S; S.init(T, NPROJ, 1024, F.G, F.blk, ws + WS_H, ws + WS_WIN);
      EpiProj E{ws, (bf16_t*)(F.ob + OUT_GZ)};
      pg8::gemm_phase<EpiProj, pg8::DenseOrder, true, false>(F.lds, 1024, S, E); }
    GRID_BAR();
    REP(3) { p3_attn(F); }
    GRID_BAR();
    REP(4) { p3b_gdn_prep(F); }
    REP(5) { p3_merge(F); }
    GRID_BAR();
    REP(6) { p4_gdn_scan(F); }
    REP(12) { convert_experts(F, 64, F.G - 64); }
    GRID_BAR();
    REP(7) {
    { pg8::DenseOrder S; S.init(T, 1024, 1024, F.G, F.blk, ws + WS_YA, ws + WS_WUPG); EpiStore E{(bf16_t*)(ws + WS_UA), 1024};
      pg8::gemm_phase<EpiStore, pg8::DenseOrder, true, false>(F.lds, 1024, S, E); }
    { pg8::DenseOrder S; S.init(T, 1024, 512, F.G, F.blk, F.ob + OUT_YB, ws + WS_WUPD); EpiStore E{(bf16_t*)(ws + WS_UB), 1024};
      pg8::gemm_phase<EpiStore, pg8::DenseOrder, true, false>(F.lds, 512, S, E); }
    }
    GRID_BAR();
    REP(8) { pg8::DenseOrder S; S.init(T, 2048, 1024, F.G, F.blk, ws + WS_H, ws + WS_WG); EpiGate E{(const bf16_t*)(ws + WS_UA), (const bf16_t*)(ws + WS_UB), (bf16_t*)(ws + WS_MG)};
      pg8::gemm_phase<EpiGate, pg8::DenseOrder, true, false>(F.lds, 1024, S, E); }
    GRID_BAR();
    REP(9) { pg8::DenseOrder S; S.init(T, 1024, 1024, F.G, F.blk, ws + WS_MG, ws + WS_WOUT); EpiX1 E{inp(I_X), MOD, F.out};
      pg8::gemm_phase<EpiX1, pg8::DenseOrder, true, false>(F.lds, 1024, S, E); }
    GRID_BAR();
    if ((DUPMASK >> 13) & 1) p7_route(F, false);
    p7_route(F, true);
    GRID_BAR();
    REP(10) { MoeTab tb = build_moetab(F);
      G1Order S{tb, F.G, F.blk, (const int*)(ws + WS_LIST), (const char*)(ws + WS_H), (const char*)(ws + WS_WGU), (const char*)(ws + WS_WSGU)};
      LAS int* tokb = (LAS int*)(F.lds + INFO_OFF); LAS float* wkb = (LAS float*)(F.lds + INFO_OFF + 6144);
      S.preload(tokb, wkb, (const float*)(ws + WS_LISTW));
      EpiAct E{tb, wkb, (bf16_t*)(ws + WS_ACT), (bf16_t*)(ws + WS_ACTS)};
      pg8::gemm_phase<EpiAct, G1Order, true, true>(F.lds, 1024, S, E, tokb); }
    GRID_BAR();
    REP(11) { MoeTab tb = build_moetab(F);
      G2Order S{tb, F.G, F.blk, (const char*)(ws + WS_ACT), (const char*)(ws + WS_WD), (const char*)(ws + WS_ACTS), (const char*)(ws + WS_WSD)};
      LAS int* pairb = (LAS int*)(F.lds + INFO_OFF);
      S.preload(pairb, (const int*)(ws + WS_LIST));
      EpiSlot E{tb, pairb, ws + WS_SLOT, (bf16_t*)(ws + WS_SH)};
      pg8::gemm_phase<EpiSlot, G2Order, true, false>(F.lds, 256, S, E); }
    GRID_BAR();
    if ((DUPMASK >> 14) & 1) { for (int r_ = 0; r_ < 13; ++r_) GRID_BAR(); }
    p9_combine(F);
#undef REP
#undef GRID_BAR
}

extern "C" void kernel_launch(void* const* d_in, const int* in_sizes, int n_in, void* d_out, int out_size, void* d_ws, size_t ws_size, hipStream_t stream) {
    static int grid = 0;
    if (grid == 0) {
        if (n_in != 24 || out_size != T * DM || ws_size < WS_END) { fprintf(stderr, "kernel_launch: unexpected shapes / workspace (n_in %d out %d ws %zu, need %zu)\n", n_in, out_size, ws_size, (size_t)WS_END); grid = -1; return; }
        int dev = 0, cus = 0;
        if (hipGetDevice(&dev) != hipSuccess || hipDeviceGetAttribute(&cus, hipDeviceAttributeMultiprocessorCount, dev) != hipSuccess) { grid = -1; return; }
        if (hipFuncSetAttribute((const void*)mega_fwd, hipFuncAttributeMaxDynamicSharedMemorySize, LDS_BYTES) != hipSuccess) { fprintf(stderr, "kernel_launch: hipFuncSetAttribute failed\n"); grid = -1; return; }
        int per_cu = 0;
        if (hipOccupancyMaxActiveBlocksPerMultiprocessor(&per_cu, (const void*)mega_fwd, 512, LDS_BYTES) != hipSuccess || per_cu < 1) fprintf(stderr, "kernel_launch: occupancy query reports %d blocks per CU\n", per_cu);
        (void)hipGetLastError();
        grid = cus;
    }
    if (grid < 0) return;
    if (hipMemsetAsync((char*)d_ws + WS_CTL, 0, CTL_ZERO_BYTES, stream) != hipSuccess) return;
    Args a{};
    for (int i = 0; i < 24; ++i) a.in[i] = (const float*)d_in[i];
    a.out = (float*)d_out; a.ws = (unsigned char*)d_ws;
    hipLaunchKernelGGL(mega_fwd, dim3(grid), dim3(512), LDS_BYTES, stream, a);
}
```

```cpp
#include <hip/hip_runtime.h>
#include <cstdio>
#include <cstdint>

#define LAS __attribute__((address_space(3)))
#define GAS __attribute__((address_space(1)))
typedef unsigned short bf16_t;
typedef short bf16x8 __attribute__((ext_vector_type(8)));
typedef float f32x2 __attribute__((ext_vector_type(2)));
typedef float f32x4 __attribute__((ext_vector_type(4)));
typedef unsigned u32x2 __attribute__((ext_vector_type(2)));
typedef long i64x2 __attribute__((ext_vector_type(2)));
typedef unsigned u32x4 __attribute__((ext_vector_type(4)));

#ifdef PROBE_SEL
#ifndef PROBE_BLK
#define PROBE_BLK 0
#endif
__device__ unsigned long long g_ts[64];
#define TS_SLOT(ldsbase) ((volatile __attribute__((address_space(3))) unsigned*)((ldsbase) + 143424))
#define TS_DECL
#define TS_BEGIN() do { if (blockIdx.x == PROBE_BLK && threadIdx.x == 0) *TS_SLOT(lds) = (unsigned)__builtin_amdgcn_s_memrealtime(); } while (0)
#define TS_END(k) do { if (blockIdx.x == PROBE_BLK && threadIdx.x == 0) { const unsigned t1_ = (unsigned)__builtin_amdgcn_s_memrealtime(); g_ts[k] += (unsigned long long)(t1_ - *TS_SLOT(lds)); *TS_SLOT(lds) = t1_; } } while (0)
#else
#define TS_DECL
#define TS_BEGIN() do {} while (0)
#define TS_END(k) do {} while (0)
#endif

constexpr int BATCH = 8, SEQ = 2048, DM = 1024, T = BATCH * SEQ;
constexpr int IN_W = 10768;
constexpr int NPROJ = 8704;
constexpr int NEXP = 64, DEXP = 256;
constexpr float EPS = 1e-6f;

__device__ __forceinline__ unsigned f2bf(float f) { unsigned u = __builtin_bit_cast(unsigned, f); return (u + 0x7fffu + ((u >> 16) & 1u)) >> 16; }
typedef __bf16 bf16x2_t __attribute__((ext_vector_type(2)));
__device__ __forceinline__ unsigned pk2(float lo, float hi) { const f32x2 v = {lo, hi}; const bf16x2_t b = __builtin_convertvector(v, bf16x2_t); return __builtin_bit_cast(unsigned, b); }
__device__ __forceinline__ float bf2f(unsigned h) { return __builtin_bit_cast(float, h << 16); }
__device__ __forceinline__ float bflo(unsigned w) { return __builtin_bit_cast(float, w << 16); }
__device__ __forceinline__ float bfhi(unsigned w) { return __builtin_bit_cast(float, w & 0xffff0000u); }
__device__ __forceinline__ float sigmoidf_(float x) { return __builtin_amdgcn_rcpf(1.0f + __builtin_amdgcn_exp2f(-1.4426950408889634f * x)); }
__device__ __forceinline__ float siluf_(float x) { return x * __builtin_amdgcn_rcpf(1.0f + __builtin_amdgcn_exp2f(-1.4426950408889634f * x)); }
__device__ __forceinline__ int opaque_tid() { int t = threadIdx.x; asm volatile("" : "+v"(t)); return t; }
template <int CTRL> __device__ __forceinline__ float dppf(float v) { return __builtin_bit_cast(float, __builtin_amdgcn_update_dpp(0, __builtin_bit_cast(int, v), CTRL, 0xF, 0xF, true)); }
__device__ __forceinline__ float red4(float v) { v += dppf<0xB1>(v); v += dppf<0x4E>(v); return v; }
__device__ __forceinline__ float red8(float v) { v = red4(v); v += dppf<0x141>(v); return v; }
__device__ __forceinline__ float red16(float v) { v = red8(v); v += dppf<0x140>(v); return v; }
__device__ __forceinline__ float wave_sum(float v) { v = red16(v); v += __shfl_xor(v, 16); v += __shfl_xor(v, 32); return v; }

typedef int i32x8 __attribute__((ext_vector_type(8)));
__device__ __forceinline__ f32x4 mfma_fp8_k128(bf16x8 a0, bf16x8 a1, bf16x8 b0, bf16x8 b1, f32x4 c) {
    const u32x4 x0 = __builtin_bit_cast(u32x4, a0), x1 = __builtin_bit_cast(u32x4, a1), y0 = __builtin_bit_cast(u32x4, b0), y1 = __builtin_bit_cast(u32x4, b1);
    const i32x8 a = {(int)x0.x, (int)x0.y, (int)x0.z, (int)x0.w, (int)x1.x, (int)x1.y, (int)x1.z, (int)x1.w}, b = {(int)y0.x, (int)y0.y, (int)y0.z, (int)y0.w, (int)y1.x, (int)y1.y, (int)y1.z, (int)y1.w};
    return __builtin_amdgcn_mfma_scale_f32_16x16x128_f8f6f4(a, b, c, 0, 0, 0, 0x7F7F7F7F, 0, 0x7F7F7F7F);
}
namespace pg8 {
#define PG8_LAS __attribute__((address_space(3)))
constexpr int BM = 256, BK = 64, HALF = 128, HTB = HALF * BK * 2, STAGE_BYTES = 8 * HTB, NXCD = 8, WGM = 8;

__host__ __device__ __forceinline__ int lds_byte(int r, int c) { const int st = (r >> 4) * 2 + (c >> 5), rr = r & 15, cc = c & 31, ob = rr * 64 + cc * 2; return st * 1024 + (ob ^ (((ob >> 9) & 1) << 5)); }
__host__ __device__ __forceinline__ void stage_rc(int b, int& R, int& C) { const int st = b / 1024, sb = b % 1024, swz = sb ^ (((sb >> 9) & 1) << 5); R = (st >> 1) * 16 + swz / 64; C = (st & 1) * 32 + (swz % 64) / 2; }
__host__ __device__ __forceinline__ int perm32(int rho) { const int n = rho >> 4, i = rho & 15; return 8 * (i >> 2) + 4 * n + (i & 3); }

struct Unit { int pm, pn; const char* Ap; const char* Bp; int e, mt; };

struct DenseOrder {
    int nM, nN, nwg, G, c; const char* A; const char* Bt; size_t tstep;
    __device__ __forceinline__ void init(int M, int N, int K, int G_, int c_, const void* A_, const void* Bt_) { nM = M / BM; nN = N / BM; nwg = nM * nN; G = G_; c = c_; A = (const char*)A_; Bt = (const char*)Bt_; tstep = (size_t)BM * K * 2; }
    __device__ __forceinline__ bool next(int i, Unit& u) const {
        const long L = (long)i * G + c; if (L >= nwg) return false;
        int wgid = (int)L; { const int q = nwg / NXCD, r = nwg % NXCD, xcd = wgid % NXCD, off = wgid / NXCD; wgid = (xcd < r ? xcd * (q + 1) : r * (q + 1) + (xcd - r) * q) + off; }
        const int nig = WGM * nN, gid = wgid / nig, fm = gid * WGM, gsz = (nM - fm) < WGM ? (nM - fm) : WGM;
        u.pm = fm + ((wgid % nig) % gsz); u.pn = (wgid % nig) / gsz; u.Ap = A + (size_t)u.pm * tstep; u.Bp = Bt + (size_t)u.pn * tstep; u.e = 0; u.mt = 0; return true;
    }
    __device__ __forceinline__ unsigned a_off(const Unit&, int r, int K) const { return (unsigned)(r * K) * 2u; }
};

struct LocalGateOrder {
    DenseOrder D; const char* A; const char* Bt; size_t tstep;
    __device__ __forceinline__ void init(int M, int K, int G_, int c_, const void* A_, const void* Bt_) { D.init(M, 1024, K, G_, c_, A_, Bt_); A = (const char*)A_; Bt = (const char*)Bt_; tstep = (size_t)BM * K * 2; }
    __device__ __forceinline__ bool next(int i, Unit& u) const {
        Unit t; if (!D.next(i >> 1, t)) return false;
        u.pm = t.pm; u.pn = 2 * t.pn + (i & 1); u.Ap = A + (size_t)u.pm * tstep; u.Bp = Bt + (size_t)u.pn * tstep; u.e = 0; u.mt = 0; return true;
    }
    __device__ __forceinline__ unsigned a_off(const Unit&, int r, int K) const { return (unsigned)(r * K) * 2u; }
};

__device__ __forceinline__ unsigned cvt_pk_bf16(float lo, float hi) { unsigned r; asm volatile("v_cvt_pk_bf16_f32 %0, %1, %2" : "=v"(r) : "v"(lo), "v"(hi)); return r; }

template <class Epi, class Sched, bool ALIGN_EPI, bool GATHER, bool FP8 = false>
__device__ __forceinline__ void gemm_phase(PG8_LAS unsigned char* lds, const int K, const Sched& S, const Epi& E, PG8_LAS int* tokb = nullptr) {
    const int tid = opaque_tid(), wid = __builtin_amdgcn_readfirstlane(tid >> 6), lane = tid & 63, wr = wid >> 2, wc = wid & 3, fr = lane & 15, fq = lane >> 4;
    const int nt = K / BK;
    unsigned voffB[2];
#pragma unroll
    for (int i = 0; i < 2; ++i) { int R, C; stage_rc(tid * 16 + i * 8192, R, C); const int Rb = Epi::PERM ? ((R & ~31) + perm32(R & 31)) : R;
        voffB[i] = (unsigned)(Rb * K + C) * 2u; }
    const size_t kstep = (size_t)(BK * 2);
    const size_t hstep = (size_t)HALF * K * 2;
    const unsigned ldsw = (unsigned)wid * 1024u;
    const int aoff = lds_byte(wr * 64 + fr, fq * 8), boff = lds_byte(wc * 32 + fr, fq * 8);
#define PG8_SA(b, h) (((b) * 2 + (h)) * HTB)
#define PG8_SB(b, h) ((4 + (b) * 2 + (h)) * HTB)
#define PG8_GLDS(gptr, bufoff, i_) __builtin_amdgcn_global_load_lds((const unsigned*)(gptr), (PG8_LAS unsigned*)(lds + (bufoff) + ldsw + (i_) * 8192), 16, 0, 0)
#define PG8_STAGE_B(bufoff, gbase) do { _Pragma("unroll") for (int _i = 0; _i < 2; ++_i) PG8_GLDS((const char*)(gbase) + voffB[_i], bufoff, _i); } while (0)
#define PG8_STAGE_A(bufoff, gbase, h) do { _Pragma("unroll") for (int _i = 0; _i < 2; ++_i) PG8_GLDS((const char*)(gbase) + vAc[h][_i], bufoff, _i); } while (0)
#define PG8_STAGE_A2(bufoff, gbase, h) PG8_STAGE_A(bufoff, gbase, h)
#define PG8_NEXT_A() do { const int _t = opaque_tid(); const PG8_LAS int* _tb = tokb + (ui + 1) * 256; _Pragma("unroll") for (int _i = 0; _i < 2; ++_i) { int _R, _C; stage_rc(_t * 16 + _i * 8192, _R, _C); \
        _Pragma("unroll") for (int _h = 0; _h < 2; ++_h) vAc[_h][_i] = (unsigned)(_tb[_h * 128 + _R] * K + _C) * 2u; } } while (0)
#define PG8_CALC_A(u, v) do { const int _t = opaque_tid(); _Pragma("unroll") for (int _i = 0; _i < 2; ++_i) { int _R, _C; stage_rc(_t * 16 + _i * 8192, _R, _C); _Pragma("unroll") for (int _h = 0; _h < 2; ++_h) v[_h][_i] = (GATHER ? (unsigned)(tokb[_h * 128 + _R] * K) * 2u : S.a_off(u, _h * 128 + _R, K)) + (unsigned)_C * 2u; } } while (0)
#define PG8_LDA(dst, b, h) do { _Pragma("unroll") for (int m = 0; m < 4; ++m) _Pragma("unroll") for (int k = 0; k < 2; ++k) dst[m][k] = *(const PG8_LAS bf16x8*)(lds + PG8_SA(b, h) + aoff + m * 2048 + k * 1024); } while (0)
#define PG8_LDB(dst, b, h) do { _Pragma("unroll") for (int n = 0; n < 2; ++n) _Pragma("unroll") for (int k = 0; k < 2; ++k) dst[n][k] = *(const PG8_LAS bf16x8*)(lds + PG8_SB(b, h) + boff + n * 2048 + k * 1024); } while (0)
#define PG8_MMA(ai, bj, At, Bt) do { __builtin_amdgcn_s_setprio(1); _Pragma("unroll") for (int m = 0; m < 4; ++m) _Pragma("unroll") for (int n = 0; n < 2; ++n) _Pragma("unroll") for (int k = 0; k < 2; ++k) { \
        if (FP8) { if (k == 0) acc[ai][bj][m][n] = mfma_fp8_k128(Bt[n][0], Bt[n][1], At[m][0], At[m][1], acc[ai][bj][m][n]); } \
        else acc[ai][bj][m][n] = __builtin_amdgcn_mfma_f32_16x16x32_bf16(Bt[n][k], At[m][k], acc[ai][bj][m][n], 0, 0, 0); } __builtin_amdgcn_s_setprio(0); } while (0)
#define PG8_WAIT_V(n) asm volatile("s_waitcnt vmcnt(" #n ")" ::: "memory")
#define PG8_WAIT_L(n) asm volatile("s_waitcnt lgkmcnt(" #n ")" ::: "memory")
#define PG8_BAR __builtin_amdgcn_s_barrier()
#define PG8_SCHED __builtin_amdgcn_sched_barrier(0)
    Unit cur, nxt; int ui = 0;
    if (!S.next(0, cur)) return;
    f32x4 acc[2][2][4][2];
#pragma unroll
    for (int a = 0; a < 2; ++a)
#pragma unroll
        for (int b = 0; b < 2; ++b)
#pragma unroll
            for (int m = 0; m < 4; ++m)
#pragma unroll
                for (int n = 0; n < 2; ++n) acc[a][b][m][n] = (f32x4){0.f, 0.f, 0.f, 0.f};
    bf16x8 At[4][2], B0[2][2], B1[2][2];
    unsigned vAc[2][2];
    PG8_CALC_A(cur, vAc);
    const char* cA = cur.Ap; const char* cB = cur.Bp;
    PG8_STAGE_B(PG8_SB(0, 0), cB); PG8_STAGE_B(PG8_SB(0, 1), cB + hstep); PG8_STAGE_A(PG8_SA(0, 0), cA, 0); PG8_STAGE_A(PG8_SA(0, 1), cA, 1);
    if (wr == 1) PG8_BAR;
    PG8_WAIT_V(2); PG8_BAR;
    PG8_STAGE_B(PG8_SB(1, 0), cB + kstep); PG8_STAGE_A(PG8_SA(1, 0), cA + kstep, 0); PG8_STAGE_B(PG8_SB(1, 1), cB + hstep + kstep);
    PG8_WAIT_V(6); PG8_BAR;
    TS_DECL; TS_BEGIN();
    for (;;) {
        const bool has_next = S.next(ui + 1, nxt);
        TS_END(22);
        const char* nA = has_next ? nxt.Ap : cA; const char* nB = has_next ? nxt.Bp : cB;
#pragma unroll 1
        for (int t = 0; t < nt; t += 2) {
            const bool last = (t == nt - 2);
            const char* a1 = cA + (size_t)(t + 1) * kstep;
            const char* a2 = last ? nA : cA + (size_t)(t + 2) * kstep; const char* b2 = last ? nB : cB + (size_t)(t + 2) * kstep;
            const char* a3 = a2 + kstep; const char* b3 = b2 + kstep;
            PG8_LDB(B0, 0, 0); PG8_LDB(B1, 0, 1); PG8_SCHED; PG8_LDA(At, 0, 0); PG8_STAGE_A(PG8_SA(1, 1), a1, 1);
            if constexpr (GATHER) { if (last && has_next) { PG8_NEXT_A(); } }
            PG8_WAIT_V(8); PG8_WAIT_L(0); PG8_BAR; PG8_MMA(0, 0, At, B0); PG8_MMA(0, 1, At, B1); PG8_BAR; PG8_SCHED;
            PG8_LDA(At, 0, 1); PG8_STAGE_B(PG8_SB(0, 0), b2); PG8_STAGE_B(PG8_SB(0, 1), b2 + hstep); PG8_STAGE_A2(PG8_SA(0, 0), a2, 0);
            PG8_WAIT_V(8); PG8_WAIT_L(0); PG8_BAR; PG8_MMA(1, 0, At, B0); PG8_MMA(1, 1, At, B1); PG8_BAR; PG8_SCHED;
            PG8_LDB(B0, 1, 0); PG8_LDB(B1, 1, 1); PG8_SCHED; PG8_LDA(At, 1, 0); PG8_STAGE_A2(PG8_SA(0, 1), a2, 1);
            PG8_WAIT_V(8); PG8_WAIT_L(0); PG8_BAR; PG8_MMA(0, 0, At, B0); PG8_MMA(0, 1, At, B1); PG8_BAR; PG8_SCHED;
            PG8_LDA(At, 1, 1); PG8_STAGE_B(PG8_SB(1, 0), b3); PG8_STAGE_B(PG8_SB(1, 1), b3 + hstep); PG8_STAGE_A2(PG8_SA(1, 0), a3, 0);
            PG8_WAIT_V(8); PG8_WAIT_L(0); PG8_BAR; PG8_MMA(1, 0, At, B0); PG8_MMA(1, 1, At, B1); PG8_BAR; PG8_SCHED;
        }
        TS_END(20);
        if constexpr (ALIGN_EPI) { if (wr == 0) PG8_BAR; }
        E(acc, cur, ui);
        TS_END(21);
        if (!has_next) break;
#pragma unroll
        for (int a = 0; a < 2; ++a)
#pragma unroll
            for (int b = 0; b < 2; ++b)
#pragma unroll
                for (int m = 0; m < 4; ++m)
#pragma unroll
                    for (int n = 0; n < 2; ++n) acc[a][b][m][n] = (f32x4){0.f, 0.f, 0.f, 0.f};
        cur = nxt; cA = nA; cB = nB; ++ui;
        if constexpr (ALIGN_EPI) { if (wr == 1) PG8_BAR; }
    }
    PG8_WAIT_V(0);
    if constexpr (!ALIGN_EPI) { if (wr == 0) PG8_BAR; }
    PG8_BAR;
#undef PG8_SA
#undef PG8_SB
#undef PG8_GLDS
#undef PG8_STAGE_A
#undef PG8_STAGE_A2
#undef PG8_NEXT_A
#undef PG8_STAGE_B
#undef PG8_CALC_A
#undef PG8_LDA
#undef PG8_LDB
#undef PG8_MMA
#undef PG8_WAIT_V
#undef PG8_WAIT_L
#undef PG8_BAR
#undef PG8_SCHED
}
}

constexpr size_t MiB = 1u << 20;
constexpr size_t WS_CTL = 0, CTL_ZERO_BYTES = 128 * 1024;
constexpr size_t WS_MOD = 1 * MiB;
constexpr size_t WS_BA = 2 * MiB;
constexpr size_t WS_PW = 3 * MiB;
constexpr size_t WS_WIN = 4 * MiB;
constexpr size_t WS_LIST = 4 * MiB;
constexpr size_t WS_LISTW = 8 * MiB;
constexpr size_t WS_WSGU = 12 * MiB;
constexpr size_t WS_WSD = 13 * MiB;
constexpr size_t WS_WG = 21 * MiB;
constexpr size_t WS_WUPG = 25 * MiB, WS_WUPD = 27 * MiB, WS_WOUT = 28 * MiB;
constexpr size_t WS_H = 30 * MiB;
constexpr size_t WS_GQ = 62 * MiB, WS_GK = 94 * MiB, WS_GV = 126 * MiB;
constexpr size_t WS_YA = 62 * MiB;
constexpr size_t WS_Y = 62 * MiB;
constexpr size_t WS_WGU = 94 * MiB;
constexpr size_t WS_DQ = 158 * MiB, WS_DK = 206 * MiB, WS_DV = 254 * MiB;
constexpr size_t WS_UA = 158 * MiB, WS_UB = 190 * MiB, WS_MG = 222 * MiB;
constexpr size_t WS_ACT = 142 * MiB;
constexpr size_t WS_ACTS = 178 * MiB;
constexpr size_t WS_YB = 126 * MiB;
constexpr size_t WS_SLOT = 198 * MiB;
constexpr size_t WS_SH = 182 * MiB;
constexpr size_t WS_END = 334 * MiB;
constexpr size_t OUT_GZ = 0, OUT_WD = 32 * MiB;

constexpr int CW_BAR = 4096;
constexpr int CW_CNT = 16384;

constexpr int RING_BYTES = 131072;
constexpr int MISC_OFF = 143360;
constexpr int INFO_OFF = 131072;
constexpr int LDS_BYTES = 147456;

typedef GAS unsigned gu32;
#define RLX_AGENT __ATOMIC_RELAXED, __HIP_MEMORY_SCOPE_AGENT

#define XB_TMO      128
#define XB_XCNT(j)  (256  + 64 * (j))
#define XB_XSUB(j)  (1280 + 64 * (j))
#define XB_XGEN(j)  (2304 + 64 * (j))
#define XB_TOP      3328
#define XB_TOPGEN   3392
#define XCD_BAR_WORDS 3456
#define XB_SPIN_CAP (1u << 22)
__device__ __forceinline__ unsigned xb_ld(unsigned* p)              { return __hip_atomic_load(p, __ATOMIC_RELAXED, __HIP_MEMORY_SCOPE_AGENT); }
__device__ __forceinline__ unsigned xb_add(unsigned* p, unsigned v) { return __hip_atomic_fetch_add(p, v, __ATOMIC_RELAXED, __HIP_MEMORY_SCOPE_AGENT); }
__device__ __forceinline__ unsigned xb_xcc_id() { return (unsigned)__builtin_amdgcn_s_getreg((3 << 11) | 20) & 0xFu; }
#define XB_SPIN(cond, bar) do { unsigned _sp = 0; while (cond) { __builtin_amdgcn_s_sleep(1); \
    if ((++_sp & 255u) == 0u) { if (xb_ld(&(bar)[XB_TMO])) break; if (_sp > XB_SPIN_CAP) { atomicAdd(&(bar)[XB_TMO], 1u); break; } } } } while (0)
struct XcdBarrier { unsigned* bar; unsigned x; volatile LAS unsigned* st; };
__device__ __forceinline__ XcdBarrier xcd_barrier_post(unsigned* bar, volatile LAS unsigned* st) {
    XcdBarrier b; b.bar = bar; b.x = xb_xcc_id(); b.st = st;
    if (threadIdx.x == 0) (void)xb_add(&bar[XB_XCNT(b.x)], 1u);
    return b;
}
__device__ __forceinline__ void xcd_barrier_complete(unsigned* bar, unsigned x, unsigned& nloc, unsigned& nx) {
    const unsigned G = gridDim.x * gridDim.y * gridDim.z;
    unsigned sum, cnt, mine, sp = 0u;
    for (;;) {
        sum = 0u; cnt = 0u; mine = 0u;
#pragma unroll
        for (unsigned j = 0; j < 16; ++j) { const unsigned c = xb_ld(&bar[XB_XCNT(j)]); sum += c; cnt += (c > 0u) ? 1u : 0u; mine = (j == x) ? c : mine; }
        if (sum == G) break;
        __builtin_amdgcn_s_sleep(1);
        if ((++sp & 255u) == 0u) { if (xb_ld(&bar[XB_TMO])) break; if (sp > XB_SPIN_CAP) { atomicAdd(&bar[XB_TMO], 1u); break; } }
    }
    nloc = mine > 0u ? mine : 1u; nx = cnt > 0u ? cnt : 1u;
}
__device__ __forceinline__ void xcd_barrier(const XcdBarrier& b) {
    asm volatile("s_waitcnt vmcnt(0)" ::: "memory");
    __syncthreads();
    if (threadIdx.x == 0) {
        unsigned* bar = b.bar;
        __builtin_amdgcn_s_waitcnt(0);
        unsigned nloc = b.st[0], nx = b.st[1];
        if (nloc == 0u) { xcd_barrier_complete(bar, b.x, nloc, nx); b.st[0] = nloc; b.st[1] = nx; }
        const unsigned old = xb_add(&bar[XB_XSUB(b.x)], 1u);
        const unsigned gen = old / nloc;
        if (old + 1u == (gen + 1u) * nloc) {
            __builtin_amdgcn_fence(__ATOMIC_RELEASE, "agent");
            asm volatile("s_waitcnt vmcnt(0)" ::: "memory");
            const unsigned og = xb_add(&bar[XB_TOP], 1u);
            const unsigned tg = og / nx;
            if (og + 1u == (tg + 1u) * nx) xb_add(&bar[XB_TOPGEN], 1u);
            else XB_SPIN(xb_ld(&bar[XB_TOPGEN]) == tg, bar);
            __builtin_amdgcn_fence(__ATOMIC_ACQUIRE, "agent");
            xb_add(&bar[XB_XGEN(b.x)], 1u);
            asm volatile("s_waitcnt vmcnt(0)" ::: "memory");
        } else {
            XB_SPIN(xb_ld(&bar[XB_XGEN(b.x)]) == gen, bar);
            __builtin_amdgcn_fence(__ATOMIC_ACQUIRE, "agent");
            asm volatile("s_waitcnt vmcnt(0)" ::: "memory");
        }
    }
    __syncthreads();
}

struct Frame {
    LAS unsigned char* lds;
    int G, blk;
    float* out; unsigned char* ws; unsigned char* ob;
};
enum { I_X = 0, I_C, I_WADA, I_BADA, I_GMIX, I_WIN, I_CONVW, I_ALOG, I_DTB, I_GNG, I_QNG, I_KNG, I_WUPG, I_WUPD, I_WOUT, I_GFFN, I_WR, I_RB, I_WEG, I_WEU, I_WED, I_WSG, I_WSU, I_WSD };
__device__ __forceinline__ const float* inp(int i) { return ((const float* const __attribute__((address_space(4)))*)__builtin_amdgcn_kernarg_segment_ptr())[i]; }

__device__ __forceinline__ void transpose_item(const float* W, int ldn, int n0s, int k0, bf16_t* WT, int dK, int drow0, LAS float* scr, int lane) {
#pragma unroll 8
    for (int i = 0; i < 32; ++i) { const int kk = 2 * i + (lane >> 5); scr[kk * 33 + (lane & 31)] = W[(size_t)(k0 + kk) * ldn + n0s + (lane & 31)]; }
    asm volatile("s_waitcnt lgkmcnt(0)" ::: "memory");
    const int c = lane & 7;
#pragma unroll
    for (int j = 0; j < 4; ++j) { const int n = (lane >> 3) + 8 * j; const LAS float* s = scr + (8 * c) * 33 + n;
        u32x4 o; o.x = pk2(s[0 * 33], s[1 * 33]); o.y = pk2(s[2 * 33], s[3 * 33]); o.z = pk2(s[4 * 33], s[5 * 33]); o.w = pk2(s[6 * 33], s[7 * 33]);
        *(GAS u32x4*)(WT + (size_t)(drow0 + n) * dK + k0 + 8 * c) = o; }
    asm volatile("s_waitcnt lgkmcnt(0)" ::: "memory");
}

__device__ __forceinline__ void p0_mod(Frame& F) {
    const int ftid = opaque_tid(), flane = ftid & 63, fwave = __builtin_amdgcn_readfirstlane(ftid >> 6);
    LAS float* cs = (LAS float*)(F.lds);
    LAS float* red = (LAS float*)(F.lds + 32768);
    for (int i = ftid; i < 8 * 1024; i += 512) cs[i] = siluf_(inp(I_C)[i]);
    __syncthreads();
    float* MOD = (float*)(F.ws + WS_MOD);
    for (int cb = F.blk; cb < 6144 / 24; cb += F.G) {
        const int col = ftid & 31, kg = ftid >> 5;
        float acc[8];
#pragma unroll
        for (int b = 0; b < 8; ++b) acc[b] = 0.f;
        if (col < 24) {
            const float* wp = inp(I_WADA) + (size_t)kg * 6144 + cb * 24 + col;
#pragma unroll
            for (int i0 = 0; i0 < 64; i0 += 16) {
                float w[16];
#pragma unroll
                for (int i = 0; i < 16; ++i) w[i] = wp[(size_t)(16 * (i0 + i)) * 6144];
#pragma unroll
                for (int i = 0; i < 16; ++i) { const int k = kg + 16 * (i0 + i);
#pragma unroll
                    for (int b = 0; b < 8; ++b) acc[b] += cs[b * 1024 + k] * w[i]; }
            }
        }
#pragma unroll
        for (int b = 0; b < 8; ++b) red[(kg * 8 + b) * 32 + col] = acc[b];
        __syncthreads();
        if (ftid < 256) { const int b = ftid >> 5, cc = ftid & 31;
            if (cc < 24) { float s = inp(I_BADA)[cb * 24 + cc];
                for (int g = 0; g < 16; ++g) s += red[(g * 8 + b) * 32 + cc];
                MOD[b * 6144 + cb * 24 + cc] = s; } }
        __syncthreads();
    }
}
__device__ __forceinline__ void p0_weights(Frame& F) {
    const int ftid = opaque_tid(), flane = ftid & 63, fwave = __builtin_amdgcn_readfirstlane(ftid >> 6);
    LAS float* scr = (LAS float*)(F.lds + 49152 + fwave * 8448);
    const int gw = F.blk * 8 + fwave, NGW = F.G * 8;
    bf16_t* WIN = (bf16_t*)(F.ws + WS_WIN); bf16_t* WG = (bf16_t*)(F.ws + WS_WG);
    bf16_t* WUPG = (bf16_t*)(F.ws + WS_WUPG); bf16_t* WUPD = (bf16_t*)(F.ws + WS_WUPD); bf16_t* WOUT = (bf16_t*)(F.ws + WS_WOUT);
    constexpr int I_IN = 16 * (NPROJ / 32), I_G = 16 * 64, I_UG = 16 * 32, I_UD = 8 * 32, I_O = 16 * 32;
    constexpr int NIT = I_IN + I_G + I_UG + I_UD + I_O;
    for (int it = gw; it < NIT; it += NGW) {
        int r = it;
        if (r < I_IN) { const int kb = r / (NPROJ / 32), nb = r % (NPROJ / 32), n0 = nb * 32; transpose_item(inp(I_WIN), IN_W, n0 + (n0 >= 4096 ? 16 : 0), kb * 64, WIN, 1024, n0, scr, flane); continue; } r -= I_IN;
        if (r < I_G) { const int kb = r / 64, nb = r % 64, p = nb >> 3, hf = (nb >> 2) & 1, i0 = (nb & 3) * 32;
            transpose_item(inp(I_WIN), IN_W, 8720 + hf * 1024 + p * 128 + i0, kb * 64, WG, 1024, p * 256 + hf * 128 + i0, scr, flane); continue; } r -= I_G;
        if (r < I_UG) { const int kb = r / 32, nb = r % 32; transpose_item(inp(I_WUPG), 1024, nb * 32, kb * 64, WUPG, 1024, nb * 32, scr, flane); continue; } r -= I_UG;
        if (r < I_UD) { const int kb = r / 32, nb = r % 32; transpose_item(inp(I_WUPD), 1024, nb * 32, kb * 64, WUPD, 512, nb * 32, scr, flane); continue; } r -= I_UD;
        { const int kb = r / 32, nb = r % 32; transpose_item(inp(I_WOUT), 1024, nb * 32, kb * 64, WOUT, 1024, nb * 32, scr, flane); }
    }
}
__device__ __forceinline__ void tr16_item(const float* src, int ldn, int n0, int k0, bf16_t* d0, bf16_t* d1, bf16_t* d2, bf16_t* d3, int lane) {
    f32x4 v[16];
#pragma unroll
    for (int i = 0; i < 16; ++i) v[i] = *(const f32x4*)(src + (size_t)(k0 + i) * ldn + n0 + 4 * lane);
    u32x4 a0, a1, b0, b1, c0, c1, e0, e1;
#pragma unroll
    for (int i = 0; i < 4; ++i) { a0[i] = pk2(v[2 * i].x, v[2 * i + 1].x); a1[i] = pk2(v[8 + 2 * i].x, v[9 + 2 * i].x); b0[i] = pk2(v[2 * i].y, v[2 * i + 1].y); b1[i] = pk2(v[8 + 2 * i].y, v[9 + 2 * i].y);
        c0[i] = pk2(v[2 * i].z, v[2 * i + 1].z); c1[i] = pk2(v[8 + 2 * i].z, v[9 + 2 * i].z); e0[i] = pk2(v[2 * i].w, v[2 * i + 1].w); e1[i] = pk2(v[8 + 2 * i].w, v[9 + 2 * i].w); }
    *(u32x4*)(d0 + k0) = a0; *(u32x4*)(d0 + k0 + 8) = a1; *(u32x4*)(d1 + k0) = b0; *(u32x4*)(d1 + k0 + 8) = b1;
    *(u32x4*)(d2 + k0) = c0; *(u32x4*)(d2 + k0 + 8) = c1; *(u32x4*)(d3 + k0) = e0; *(u32x4*)(d3 + k0 + 8) = e1;
}
__device__ __forceinline__ void tr16_item_fp8(const float* src, int ldn, int n0, int k0, unsigned char* d0, unsigned char* d1, unsigned char* d2, unsigned char* d3, int lane, float SC) {
    f32x4 v[16];
#pragma unroll
    for (int i = 0; i < 16; ++i) v[i] = *(const f32x4*)(src + (size_t)(k0 + i) * ldn + n0 + 4 * lane) * SC;
    u32x4 a, b, c, e;
#pragma unroll
    for (int j = 0; j < 4; ++j) { int w;
        w = 0; w = __builtin_amdgcn_cvt_pk_fp8_f32(v[4 * j].x, v[4 * j + 1].x, w, false); w = __builtin_amdgcn_cvt_pk_fp8_f32(v[4 * j + 2].x, v[4 * j + 3].x, w, true); a[j] = (unsigned)w;
        w = 0; w = __builtin_amdgcn_cvt_pk_fp8_f32(v[4 * j].y, v[4 * j + 1].y, w, false); w = __builtin_amdgcn_cvt_pk_fp8_f32(v[4 * j + 2].y, v[4 * j + 3].y, w, true); b[j] = (unsigned)w;
        w = 0; w = __builtin_amdgcn_cvt_pk_fp8_f32(v[4 * j].z, v[4 * j + 1].z, w, false); w = __builtin_amdgcn_cvt_pk_fp8_f32(v[4 * j + 2].z, v[4 * j + 3].z, w, true); c[j] = (unsigned)w;
        w = 0; w = __builtin_amdgcn_cvt_pk_fp8_f32(v[4 * j].w, v[4 * j + 1].w, w, false); w = __builtin_amdgcn_cvt_pk_fp8_f32(v[4 * j + 2].w, v[4 * j + 3].w, w, true); e[j] = (unsigned)w; }
    *(u32x4*)(d0 + k0) = a; *(u32x4*)(d1 + k0) = b; *(u32x4*)(d2 + k0) = c; *(u32x4*)(d3 + k0) = e;
}
constexpr float WD_SCALE = 16.0f;
constexpr float WGU_SCALE = 32.0f;
__device__ __forceinline__ void convert_experts(Frame& F, int b0, int nb, const int part) {
    const int ftid = opaque_tid(), flane = ftid & 63, fwave = __builtin_amdgcn_readfirstlane(ftid >> 6);
    if (F.blk < b0 || F.blk >= b0 + nb) return;
    const int gw = (F.blk - b0) * 8 + fwave, NGW = nb * 8;
    unsigned char* WGU = F.ws + WS_WGU; unsigned char* WD = F.ob + OUT_WD; unsigned char* WSGU = F.ws + WS_WSGU; unsigned char* WSD = F.ws + WS_WSD;
    const int NIT = part == 0 ? 65 * 128 + 64 : 64 * 64;
    LAS unsigned char* const lds = F.lds; (void)lds; TS_BEGIN();
    for (int it = gw; it < NIT; it += NGW) {
        int e, r;
        if (part == 0) { if (it < 65 * 128) { e = it >> 7; r = it & 127; } else { e = 64; r = 128 + (it - 65 * 128); } }
        else { e = it >> 6; r = 128 + (it & 63); }
        unsigned char* dgu = e < 64 ? WGU + (size_t)e * 512 * 1024 : WSGU; unsigned char* dd = e < 64 ? WD + (size_t)e * 1024 * 256 : WSD;
        if (r < 128) { const int hf = r >> 6, k0 = (r & 63) * 16;
            const float* src = hf ? (e < 64 ? inp(I_WEU) + (size_t)e * 1024 * 256 : inp(I_WSU)) : (e < 64 ? inp(I_WEG) + (size_t)e * 1024 * 256 : inp(I_WSG));
            const int n = 4 * flane; unsigned char* d = dgu + (size_t)((n >> 7) * 256 + hf * 128 + (n & 127)) * 1024;
            tr16_item_fp8(src, 256, 0, k0, d, d + 1024, d + 2048, d + 3072, flane, WGU_SCALE); }
        else { const int q = r - 128, k0 = (q >> 2) * 16, n0 = (q & 3) * 256;
            const float* src = e < 64 ? inp(I_WED) + (size_t)e * 256 * 1024 : inp(I_WSD);
            unsigned char* d = dd + (size_t)(n0 + 4 * flane) * 256;
            tr16_item_fp8(src, 1024, n0, k0, d, d + 256, d + 512, d + 768, flane, WD_SCALE); }
    }
    TS_END(28);
}

__device__ __forceinline__ void p1_norm(Frame& F) {
    const int ftid = opaque_tid(), flane = ftid & 63, fwave = __builtin_amdgcn_readfirstlane(ftid >> 6);
    LAS float* WbT = (LAS float*)(F.lds);
    for (int it = 0; it < 8; ++it) { const int k = (ftid >> 2) + 128 * it, j4 = (ftid & 3) * 4;
        const f32x4 v = *(const f32x4*)(inp(I_WIN) + (size_t)k * IN_W + 4096 + j4);
        WbT[(j4 + 0) * 1024 + k] = v.x; WbT[(j4 + 1) * 1024 + k] = v.y; WbT[(j4 + 2) * 1024 + k] = v.z; WbT[(j4 + 3) * 1024 + k] = v.w; }
    __syncthreads();
    const float* MOD = (const float*)(F.ws + WS_MOD); bf16_t* H = (bf16_t*)(F.ws + WS_H); float* BA = (float*)(F.ws + WS_BA);
    const int gw = F.blk * 8 + fwave, NGW = F.G * 8;
    for (int rg = gw; rg < T / 8; rg += NGW) {
        const int row0 = rg * 8, b = row0 / SEQ;
        const float* sh = MOD + b * 6144; const float* sc = sh + 1024;
        f32x4 gm[4], s1[4], h1[4];
#pragma unroll
        for (int j = 0; j < 4; ++j) { const int k = 4 * flane + 256 * j; gm[j] = *(const f32x4*)(inp(I_GMIX) + k); s1[j] = *(const f32x4*)(sc + k) + 1.0f; h1[j] = *(const f32x4*)(sh + k); gm[j] = gm[j] * s1[j]; }
        f32x4 cur[4], nxt[4];
        { const f32x4* xr = (const f32x4*)(inp(I_X) + (size_t)row0 * DM) + flane;
#pragma unroll
          for (int j = 0; j < 4; ++j) cur[j] = xr[64 * j]; }
#pragma unroll 1
        for (int r = 0; r < 8; ++r) {
            const int row = row0 + r;
            if (r < 7) { const f32x4* xr = (const f32x4*)(inp(I_X) + (size_t)(row + 1) * DM) + flane;
#pragma unroll
                for (int j = 0; j < 4; ++j) nxt[j] = xr[64 * j]; }
            f32x4 v[4]; float ss = 0.f;
#pragma unroll
            for (int j = 0; j < 4; ++j) { v[j] = cur[j]; ss += (v[j].x * v[j].x + v[j].y * v[j].y) + (v[j].z * v[j].z + v[j].w * v[j].w); }
            const float rstd = rsqrtf(wave_sum(ss) * (1.f / DM) + EPS);
#pragma unroll
            for (int j = 0; j < 4; ++j) { const int k = 4 * flane + 256 * j;
                v[j] = (v[j] * rstd) * gm[j] + h1[j];
                u32x2 o; o.x = pk2(v[j].x, v[j].y); o.y = pk2(v[j].z, v[j].w);
                *(u32x2*)(H + (size_t)row * DM + k) = o; }
            float a[16];
#pragma unroll
            for (int jj = 0; jj < 16; ++jj) { float s = 0.f;
#pragma unroll
                for (int j = 0; j < 4; ++j) { const f32x4 w = *(const LAS f32x4*)(WbT + jj * 1024 + 4 * flane + 256 * j); s += (v[j].x * w.x + v[j].y * w.y) + (v[j].z * w.z + v[j].w * w.w); }
                a[jj] = s; if ((jj & 3) == 3) asm volatile("" ::: "memory"); }
            float v8[8], v4[4], v2[2], v1;
            { const bool hi = (flane & 32) != 0;
#pragma unroll
              for (int i = 0; i < 8; ++i) { const float x = hi ? a[i] : a[8 + i]; const float rr = __shfl_xor(x, 32); v8[i] = (hi ? a[8 + i] : a[i]) + rr; } }
            { const bool hi = (flane & 16) != 0;
#pragma unroll
              for (int i = 0; i < 4; ++i) { const float x = hi ? v8[i] : v8[4 + i]; const float rr = __shfl_xor(x, 16); v4[i] = (hi ? v8[4 + i] : v8[i]) + rr; } }
            { const bool hi = (flane & 8) != 0;
#pragma unroll
              for (int i = 0; i < 2; ++i) { const float x = hi ? v4[i] : v4[2 + i]; const float rr = __shfl_xor(x, 8); v2[i] = (hi ? v4[2 + i] : v4[i]) + rr; } }
            { const bool hi = (flane & 4) != 0; const float x = hi ? v2[0] : v2[1]; const float rr = __shfl_xor(x, 4); v1 = (hi ? v2[1] : v2[0]) + rr; }
            v1 = red4(v1);
            if ((flane & 3) == 0) BA[(size_t)row * 16 + (flane >> 2)] = v1;
#pragma unroll
            for (int j = 0; j < 4; ++j) cur[j] = nxt[j];
        }
    }
}

using pg8::Unit; using pg8::cvt_pk_bf16;
struct EpiProj {
    static constexpr bool PERM = true;
    unsigned char* ws; bf16_t* gz;
    __device__ __forceinline__ void operator()(const f32x4 (&acc)[2][2][4][2], const Unit& u, const int ui) const {
        const int tid_ = opaque_tid(), lane_ = tid_ & 63, wid_ = tid_ >> 6, wr = wid_ >> 2, wc = wid_ & 3, fr = lane_ & 15, fq = lane_ >> 4;
        bf16_t* base; int ldc, colt;
        if (u.pn < 16) { const int t = u.pn >> 2; base = (bf16_t*)(ws + WS_GQ + (size_t)t * (32 * MiB)); if (t == 3) base = gz; ldc = 1024; colt = (u.pn & 3) * 256; }
        else { const int d = u.pn - 16, t = d / 6; base = (bf16_t*)(ws + WS_DQ + (size_t)t * (48 * MiB)); ldc = 1536; colt = (d % 6) * 256; }
        const int row0 = u.pm * 256 + wr * 64 + fr, col0 = colt + wc * 32 + 8 * fq;
#pragma unroll
        for (int ai = 0; ai < 2; ++ai)
#pragma unroll
            for (int m = 0; m < 4; ++m) { bf16_t* rowp = base + (size_t)(row0 + ai * 128 + m * 16) * ldc + col0;
#pragma unroll
                for (int bj = 0; bj < 2; ++bj) { const f32x4 v0 = acc[ai][bj][m][0], v1 = acc[ai][bj][m][1];
                    u32x4 w; w.x = pk2(v0[0], v0[1]); w.y = pk2(v0[2], v0[3]); w.z = pk2(v1[0], v1[1]); w.w = pk2(v1[2], v1[3]);
                    *(u32x4*)(rowp + bj * 128) = w; } }
    }
};
struct EpiStore {
    static constexpr bool PERM = true;
    bf16_t* O; int ldc;
    __device__ __forceinline__ void operator()(const f32x4 (&acc)[2][2][4][2], const Unit& u, const int ui) const {
        const int tid_ = opaque_tid(), lane_ = tid_ & 63, wid_ = tid_ >> 6, wr = wid_ >> 2, wc = wid_ & 3, fr = lane_ & 15, fq = lane_ >> 4;
        const int row0 = u.pm * 256 + wr * 64 + fr, col0 = u.pn * 256 + wc * 32 + 8 * fq;
#pragma unroll
        for (int ai = 0; ai < 2; ++ai)
#pragma unroll
            for (int m = 0; m < 4; ++m) { bf16_t* rowp = O + (size_t)(row0 + ai * 128 + m * 16) * ldc + col0;
#pragma unroll
                for (int bj = 0; bj < 2; ++bj) { const f32x4 v0 = acc[ai][bj][m][0], v1 = acc[ai][bj][m][1];
                    u32x4 w; w.x = pk2(v0[0], v0[1]); w.y = pk2(v0[2], v0[3]); w.z = pk2(v1[0], v1[1]); w.w = pk2(v1[2], v1[3]);
                    *(u32x4*)(rowp + bj * 128) = w; } }
    }
};
struct EpiGate {
    static constexpr bool PERM = true;
    const bf16_t* UA; const bf16_t* UB; bf16_t* MG;
    __device__ __forceinline__ void operator()(const f32x4 (&acc)[2][2][4][2], const Unit& u, const int ui) const {
        const int tid_ = opaque_tid(), lane_ = tid_ & 63, wid_ = tid_ >> 6, wr = wid_ >> 2, wc = wid_ & 3, fr = lane_ & 15, fq = lane_ >> 4;
        const int row0 = u.pm * 256 + wr * 64 + fr, col0 = u.pn * 128 + wc * 32 + 8 * fq;
#pragma unroll
        for (int ai = 0; ai < 2; ++ai) {
            u32x4 ua[4], ub[4];
#pragma unroll
            for (int m = 0; m < 4; ++m) { const size_t off = (size_t)(row0 + ai * 128 + m * 16) * 1024 + col0; ua[m] = *(const u32x4*)(UA + off); ub[m] = *(const u32x4*)(UB + off); }
#pragma unroll
            for (int m = 0; m < 4; ++m) { const size_t off = (size_t)(row0 + ai * 128 + m * 16) * 1024 + col0;
                float o[8];
#pragma unroll
                for (int n = 0; n < 2; ++n)
#pragma unroll
                    for (int j = 0; j < 4; ++j) { const int q = n * 4 + j; const unsigned wa = ua[m][q >> 1], wb = ub[m][q >> 1];
                        const float fa = (q & 1) ? bfhi(wa) : bflo(wa), fb = (q & 1) ? bfhi(wb) : bflo(wb);
                        o[q] = sigmoidf_(acc[ai][0][m][n][j]) * fa + sigmoidf_(acc[ai][1][m][n][j]) * fb; }
                u32x4 w; w.x = pk2(o[0], o[1]); w.y = pk2(o[2], o[3]); w.z = pk2(o[4], o[5]); w.w = pk2(o[6], o[7]);
                *(u32x4*)(MG + off) = w; }
            asm volatile("" ::: "memory");
        }
    }
};
struct EpiX1 {
    static constexpr bool PERM = false;
    const float* x; const float* mod; float* out;
    __device__ __forceinline__ void operator()(const f32x4 (&acc)[2][2][4][2], const Unit& u, const int ui) const {
        const int tid_ = opaque_tid(), lane_ = tid_ & 63, wid_ = tid_ >> 6, wr = wid_ >> 2, wc = wid_ & 3, fr = lane_ & 15, fq = lane_ >> 4;
        const int row0 = u.pm * 256 + wr * 64 + fr, col0 = u.pn * 256 + wc * 32 + 4 * fq; const int b = u.pm >> 3;
        f32x4 gt[2][2];
#pragma unroll
        for (int bj = 0; bj < 2; ++bj)
#pragma unroll
            for (int n = 0; n < 2; ++n) gt[bj][n] = *(const f32x4*)(mod + b * 6144 + 2048 + col0 + bj * 128 + n * 16);
#pragma unroll
        for (int ai = 0; ai < 2; ++ai) {
            f32x4 xv[4][2][2];
#pragma unroll
            for (int m = 0; m < 4; ++m) { const size_t off = (size_t)(row0 + ai * 128 + m * 16) * 1024 + col0;
#pragma unroll
                for (int bj = 0; bj < 2; ++bj)
#pragma unroll
                    for (int n = 0; n < 2; ++n) xv[m][bj][n] = *(const f32x4*)(x + off + bj * 128 + n * 16); }
#pragma unroll
            for (int m = 0; m < 4; ++m) { const size_t off = (size_t)(row0 + ai * 128 + m * 16) * 1024 + col0;
#pragma unroll
                for (int bj = 0; bj < 2; ++bj)
#pragma unroll
                    for (int n = 0; n < 2; ++n) *(f32x4*)(out + off + bj * 128 + n * 16) = xv[m][bj][n] + gt[bj][n] * acc[ai][bj][m][n]; }
            asm volatile("" ::: "memory");
        }
    }
};
struct MoeTab { const LAS int* tp; const LAS int* cnt; const LAS unsigned short* te; };
struct EpiAct {
    static constexpr bool PERM = true;
    MoeTab tb; const LAS float* wkb; unsigned char* ACT; unsigned char* ACTS;
    __device__ __forceinline__ void operator()(const f32x4 (&acc)[2][2][4][2], const Unit& u, const int ui) const {
        const int tid_ = opaque_tid(), lane_ = tid_ & 63, wid_ = tid_ >> 6, wr = wid_ >> 2, wc = wid_ & 3, fr = lane_ & 15, fq = lane_ >> 4;
        const int e = u.e;
        unsigned char* base = e < 64 ? ACT + (size_t)u.pm * 256 * 256 : ACTS + (size_t)u.mt * 256 * 256;
        const int col0 = u.pn * 128 + wc * 32 + 8 * fq;
        float wk[2][4];
#pragma unroll
        for (int ai = 0; ai < 2; ++ai)
#pragma unroll
            for (int m = 0; m < 4; ++m) wk[ai][m] = wkb[ui * 256 + ai * 128 + wr * 64 + m * 16 + fr] * (1.0f / WGU_SCALE);
#pragma unroll
        for (int ai = 0; ai < 2; ++ai)
#pragma unroll
            for (int m = 0; m < 4; ++m) { const int r = ai * 128 + wr * 64 + m * 16 + fr;
                float o[8];
#pragma unroll
                for (int n = 0; n < 2; ++n)
#pragma unroll
                    for (int j = 0; j < 4; ++j) o[n * 4 + j] = siluf_(acc[ai][0][m][n][j] * (1.0f / WGU_SCALE)) * acc[ai][1][m][n][j] * wk[ai][m];
                int p0 = 0, p1 = 0;
                p0 = __builtin_amdgcn_cvt_pk_fp8_f32(o[0], o[1], p0, false); p0 = __builtin_amdgcn_cvt_pk_fp8_f32(o[2], o[3], p0, true);
                p1 = __builtin_amdgcn_cvt_pk_fp8_f32(o[4], o[5], p1, false); p1 = __builtin_amdgcn_cvt_pk_fp8_f32(o[6], o[7], p1, true);
                u32x2 w; w.x = (unsigned)p0; w.y = (unsigned)p1; *(u32x2*)(base + (size_t)r * 256 + col0) = w; }
    }
};
struct EpiSlot {
    static constexpr bool PERM = true;
    MoeTab tb; const LAS int* pairb; unsigned char* SLOT; bf16_t* SH;
    __device__ __forceinline__ void operator()(const f32x4 (&acc)[2][2][4][2], const Unit& u, const int ui) const {
        const int tid_ = opaque_tid(), lane_ = tid_ & 63, wid_ = tid_ >> 6, wr = wid_ >> 2, wc = wid_ & 3, fr = lane_ & 15, fq = lane_ >> 4;
        const int e = u.e; const int col0 = u.pn * 256 + wc * 32 + 8 * fq;
        if (e == 64) {
#pragma unroll
            for (int ai = 0; ai < 2; ++ai)
#pragma unroll
                for (int m = 0; m < 4; ++m) { bf16_t* rowp = SH + (size_t)(u.mt * 256 + ai * 128 + wr * 64 + m * 16 + fr) * 1024 + col0;
#pragma unroll
                    for (int bj = 0; bj < 2; ++bj) { const f32x4 v0 = acc[ai][bj][m][0], v1 = acc[ai][bj][m][1];
                        u32x4 w; w.x = pk2(v0[0], v0[1]); w.y = pk2(v0[2], v0[3]); w.z = pk2(v1[0], v1[1]); w.w = pk2(v1[2], v1[3]);
                        *(u32x4*)(rowp + bj * 128) = w; } }
            return;
        }
        int pair[2][4];
#pragma unroll
        for (int ai = 0; ai < 2; ++ai)
#pragma unroll
            for (int m = 0; m < 4; ++m) pair[ai][m] = pairb[ui * 256 + ai * 128 + wr * 64 + m * 16 + fr];
#pragma unroll
        for (int ai = 0; ai < 2; ++ai)
#pragma unroll
            for (int m = 0; m < 4; ++m) {
                if (pair[ai][m] >= 0) { unsigned char* rowp = SLOT + (size_t)pair[ai][m] * 1024 + col0;
#pragma unroll
                    for (int bj = 0; bj < 2; ++bj) { const f32x4 v0 = acc[ai][bj][m][0], v1 = acc[ai][bj][m][1];
                        int p0 = 0, p1 = 0;
                        p0 = __builtin_amdgcn_cvt_pk_fp8_f32(v0[0], v0[1], p0, false); p0 = __builtin_amdgcn_cvt_pk_fp8_f32(v0[2], v0[3], p0, true);
                        p1 = __builtin_amdgcn_cvt_pk_fp8_f32(v1[0], v1[1], p1, false); p1 = __builtin_amdgcn_cvt_pk_fp8_f32(v1[2], v1[3], p1, true);
                        u32x2 w; w.x = (unsigned)p0; w.y = (unsigned)p1; *(u32x2*)(rowp + bj * 128) = w; } } }
    }
};
struct G1Order {
    MoeTab tb; int G, c; const int* list; const char* H2; const char* WGU; const char* WSGU;
    __device__ __forceinline__ bool next(int i, Unit& u) const {
        const int NR = tb.tp[64]; const long L = (long)i * G + c; if (L >= (long)(NR + 64) * 2) return false;
        const int tile = (int)(L >> 1), j = (int)(L & 1);
        u.pn = j; u.Ap = H2;
        if (tile < NR) { const int e = tb.te[tile]; u.e = e; u.mt = tile - tb.tp[e]; u.pm = tile; u.Bp = WGU + ((size_t)e * 512 + j * 256) * 1024; }
        else { u.e = 64; u.mt = tile - NR; u.pm = 0; u.Bp = WSGU + (size_t)(j * 256) * 1024; }
        return true;
    }
    __device__ __forceinline__ int a_row(const Unit& u, int r) const {
        int tok;
        if (u.e == 64) tok = u.mt * 256 + r;
        else { const int pos = u.mt * 256 + r; tok = 0; if (pos < tb.cnt[u.e]) tok = list[(size_t)u.e * T + pos] >> 3; }
        return tok;
    }
    __device__ __forceinline__ unsigned a_off(const Unit& u, int r, int K) const { return (unsigned)(a_row(u, r) * K) * 2u; }
    __device__ __forceinline__ void preload(LAS int* tokb, LAS float* wkb, const float* listw) const {
        const int t = opaque_tid(); Unit u;
        for (int i = 0; i < 6 && next(i, u); ++i) if (t < 256) {
            int tok; float w = 1.0f;
            if (u.e == 64) tok = u.mt * 256 + t;
            else { const int pos = u.mt * 256 + t; tok = 0; w = 0.f; if (pos < tb.cnt[u.e]) { tok = list[(size_t)u.e * T + pos] >> 3; w = listw[(size_t)u.e * T + pos]; } }
            tokb[i * 256 + t] = tok; wkb[i * 256 + t] = w; }
        __syncthreads();
    }
};
struct G2Order {
    MoeTab tb; int G, c; const char* ACT; const char* WD; const char* ACTS; const char* WSD;
    __device__ __forceinline__ bool next(int i, Unit& u) const {
        const int NR = tb.tp[64]; const long L = (long)i * G + c; if (L >= (long)(NR + 64) * 4) return false;
        const int tile = (int)(L >> 2), pn = (int)(L & 3);
        u.pn = pn;
        if (tile < NR) { const int e = tb.te[tile];
            u.e = e; u.mt = tile - tb.tp[e]; u.pm = tile; u.Ap = ACT + (size_t)tile * 256 * 256 * 2; u.Bp = WD + ((size_t)e * 1024 + pn * 256) * 256 * 2; }
        else { u.e = 64; u.mt = tile - NR; u.pm = 0; u.Ap = ACTS + (size_t)u.mt * 256 * 256 * 2; u.Bp = WSD + (size_t)(pn * 256) * 256 * 2; }
        return true;
    }
    __device__ __forceinline__ unsigned a_off(const Unit&, int r, int K) const { return (unsigned)(r * K) * 2u; }
    __device__ __forceinline__ void preload(LAS int* pairb, const int* list) const {
        const int t = opaque_tid(); Unit u;
        for (int i = 0; i < 12 && next(i, u); ++i) if (t < 256) {
            int p = -1;
            if (u.e < 64) { const int pos = u.mt * 256 + t; if (pos < tb.cnt[u.e]) p = list[(size_t)u.e * T + pos]; }
            pairb[i * 256 + t] = p; }
        __syncthreads();
    }
};
__device__ __forceinline__ MoeTab build_moetab(Frame& F) {
    const int ftid = opaque_tid();
    LAS int* tp = (LAS int*)(F.lds + MISC_OFF + 1024); LAS int* cnt = (LAS int*)(F.lds + MISC_OFF + 2048); LAS unsigned short* te = (LAS unsigned short*)(F.lds + MISC_OFF + 2304);
    const gu32* gc = (const gu32*)(F.ws + WS_CTL) + CW_CNT;
    __syncthreads();
    if (ftid < 64) { int v = (int)__hip_atomic_load(gc + ftid, RLX_AGENT); if (v > T) v = T; if (v < 0) v = 0; cnt[ftid] = v; }
    __syncthreads();
    if (ftid == 0) { int s = 0; for (int e = 0; e < 64; ++e) { tp[e] = s; s += (cnt[e] + 255) >> 8; } tp[64] = s; }
    __syncthreads();
    if (ftid < 64) { const int t0 = tp[ftid], t1 = tp[ftid + 1]; for (int t = t0; t < t1 && t < 640; ++t) te[t] = (unsigned short)ftid; }
    __syncthreads();
    MoeTab t; t.tp = tp; t.cnt = cnt; t.te = te; return t;
}


typedef short v4i16_t __attribute__((ext_vector_type(4)));
constexpr size_t WS_OG01 = 302 * MiB;
constexpr size_t OUT_OG2 = 48 * MiB;
constexpr size_t WS_LSE = 3 * MiB + 512 * 1024;
__device__ __forceinline__ void p3_attn(Frame& F) {
    const int tid = opaque_tid(), lane = tid & 63, wave = __builtin_amdgcn_readfirstlane(tid >> 6), n = lane & 15, g = lane >> 4;
    const bf16_t* DQ = (const bf16_t*)(F.ws + WS_DQ); const bf16_t* DK = (const bf16_t*)(F.ws + WS_DK); const bf16_t* DV = (const bf16_t*)(F.ws + WS_DV);
    LAS unsigned char* Ks = F.lds; LAS unsigned char* Vs = F.lds + 65536; LAS float* rkS = (LAS float*)(F.lds + 131072); LAS float* gqkS = (LAS float*)(F.lds + 131072 + 1024);
    LAS unsigned char* const lds = F.lds; (void)lds;
    if (tid < 128) gqkS[tid] = inp(I_QNG)[tid] * inp(I_KNG)[tid] * (0.08838834764831845f * 1.4426950408889634f);
    u32x4 kreg[8], vreg[8], qreg[4];
#define ATT_DECODE(u_, b_, h_, dsh_, r_, qb_) const int b_ = (u_) / 192, rem_##b_ = (u_) % 192, h_ = rem_##b_ >> 4, rq_##b_ = rem_##b_ & 15, dsh_ = 2 * (h_ >> 2), r_ = rq_##b_ / (16 >> dsh_), qb_ = rq_##b_ % (16 >> dsh_)
#define ATT_LOADKV(u_) do { ATT_DECODE(u_, lb, lh, ldsh, lr, lqb); \
        _Pragma("unroll") for (int pass = 0; pass < 8; ++pass) { if (lqb == 0 && pass < 4) continue; \
            const int wi = pass * 32 + (tid >> 4), c = tid & 15, m = lqb * 128 - 128 + wi; \
            const size_t t = (size_t)lb * SEQ + (size_t)((m << ldsh) + lr); \
            kreg[pass] = *(const u32x4*)(DK + t * 1536 + lh * 128 + c * 8); vreg[pass] = *(const u32x4*)(DV + t * 1536 + lh * 128 + c * 8); } \
        { const size_t tq_ = (size_t)lb * SEQ + (size_t)(((lqb * 128 + 16 * wave + n) << ldsh) + lr); \
          _Pragma("unroll") for (int ks = 0; ks < 4; ++ks) qreg[ks] = *(const u32x4*)(DQ + tq_ * 1536 + lh * 128 + 32 * ks + 8 * g); } } while (0)
    if (F.blk < BATCH * 12 * 16) { ATT_LOADKV(F.blk); }
#pragma unroll 1
    for (int u = F.blk; u < BATCH * 12 * 16; u += F.G) {
        ATT_DECODE(u, b, h, dsh, r, qb); const int grp = h >> 2, s = h & 3, dil = 1 << dsh, m0 = qb * 128;
        const int rowb = b * SEQ;
        TS_BEGIN();
        __syncthreads();
        const int tid2 = opaque_tid();
#pragma unroll
        for (int pass = 0; pass < 8; ++pass) {
            if (qb == 0 && pass < 4) continue;
            const int wi = pass * 32 + (tid2 >> 4), c = tid2 & 15;
            const u32x4 kv = kreg[pass], vv = vreg[pass];
            float ss = 0.f;
#pragma unroll
            for (int i = 0; i < 4; ++i) { const float a0 = bflo(kv[i]), a1 = bfhi(kv[i]); ss += a0 * a0 + a1 * a1; }
            ss = red16(ss);
            if (c == 0) rkS[wi] = rsqrtf(ss * (1.f / 128.f) + EPS);
            *(LAS u32x4*)(Ks + wi * 256 + ((c ^ (wi & 15)) << 4)) = kv;
            *(LAS u32x4*)(Vs + wi * 256 + ((c ^ ((wi & 7) << 1)) << 4)) = vv;
        }
        TS_END(14);
        bf16x8 qf[4];
        {
            float ss = 0.f;
#pragma unroll
            for (int ks = 0; ks < 4; ++ks)
#pragma unroll
                for (int i = 0; i < 4; ++i) { const float a0 = bflo(qreg[ks][i]), a1 = bfhi(qreg[ks][i]); ss += a0 * a0 + a1 * a1; }
            ss += __shfl_xor(ss, 16); ss += __shfl_xor(ss, 32);
            const float rqs = rsqrtf(ss * (1.f / 128.f) + EPS);
#pragma unroll
            for (int ks = 0; ks < 4; ++ks) { const f32x4 g0 = *(const LAS f32x4*)(gqkS + 32 * ks + 8 * g), g1 = *(const LAS f32x4*)(gqkS + 32 * ks + 8 * g + 4); u32x4 o;
                o[0] = pk2(bflo(qreg[ks][0]) * rqs * g0.x, bfhi(qreg[ks][0]) * rqs * g0.y); o[1] = pk2(bflo(qreg[ks][1]) * rqs * g0.z, bfhi(qreg[ks][1]) * rqs * g0.w);
                o[2] = pk2(bflo(qreg[ks][2]) * rqs * g1.x, bfhi(qreg[ks][2]) * rqs * g1.y); o[3] = pk2(bflo(qreg[ks][3]) * rqs * g1.z, bfhi(qreg[ks][3]) * rqs * g1.w);
                qf[ks] = __builtin_bit_cast(bf16x8, o); }
        }
        TS_END(23);
        __syncthreads();
        if (u + F.G < BATCH * 12 * 16) { ATT_LOADKV(u + F.G); }
        TS_END(15);
        f32x4 st[9];
        float mx = -INFINITY;
#pragma unroll
        for (int j = 0; j < 9; ++j) {
            const int tau = wave + j;
            st[j] = (f32x4){-INFINITY, -INFINITY, -INFINITY, -INFINITY};
            if (qb > 0 || tau >= 8) {
                f32x4 a = {0.f, 0.f, 0.f, 0.f};
                const LAS unsigned char* kp = Ks + (16 * tau + n) * 256;
#pragma unroll
                for (int ks = 0; ks < 4; ++ks) { const bf16x8 kf = *(const LAS bf16x8*)(kp + (((4 * ks + g) ^ n) << 4));
                    a = __builtin_amdgcn_mfma_f32_16x16x32_bf16(kf, qf[ks], a, 0, 0, 0); }
                const f32x4 rk = *(const LAS f32x4*)(rkS + 16 * tau + 4 * g);
                a = a * rk;
                if (j == 0) {
#pragma unroll
                    for (int reg = 0; reg < 4; ++reg) if (4 * g + reg < n) a[reg] = -INFINITY; }
                if (j == 8) {
#pragma unroll
                    for (int reg = 0; reg < 4; ++reg) if (4 * g + reg > n) a[reg] = -INFINITY; }
                st[j] = a;
                mx = fmaxf(mx, fmaxf(fmaxf(a[0], a[1]), fmaxf(a[2], a[3])));
            }
        }
        TS_END(16);
        mx = fmaxf(mx, __shfl_xor(mx, 16)); mx = fmaxf(mx, __shfl_xor(mx, 32));
        float lsum = 0.f;
#pragma unroll
        for (int j = 0; j < 9; ++j)
#pragma unroll
            for (int reg = 0; reg < 4; ++reg) { const float p = __builtin_amdgcn_exp2f(st[j][reg] - mx); st[j][reg] = p; lsum += p; }
        lsum += __shfl_xor(lsum, 16); lsum += __shfl_xor(lsum, 32);
        TS_END(17);
        f32x4 o[8];
#pragma unroll
        for (int dt = 0; dt < 8; ++dt) o[dt] = (f32x4){0.f, 0.f, 0.f, 0.f};
        const int q4 = (lane & 15) >> 2, p4 = lane & 3;
#pragma unroll
        for (int a = 0; a < 5; ++a) {
            const int tA = wave + 2 * a, tB = a < 4 ? tA + 1 : tA;
            if (qb > 0 || tB >= 8) {
                u32x4 pw; pw[0] = pk2(st[2 * a][0], st[2 * a][1]); pw[1] = pk2(st[2 * a][2], st[2 * a][3]);
                if (a < 4) { pw[2] = pk2(st[2 * a + 1][0], st[2 * a + 1][1]); pw[3] = pk2(st[2 * a + 1][2], st[2 * a + 1][3]); } else { pw[2] = 0u; pw[3] = 0u; }
                const bf16x8 pf = __builtin_bit_cast(bf16x8, pw);
                const int tAe = (qb == 0 && tA < 8) ? tB : tA;
                const int row0 = 16 * tAe + 4 * g + q4, row1 = 16 * tB + 4 * g + q4;
#pragma unroll
                for (int dt = 0; dt < 8; ++dt) {
                    const int c = 2 * dt + (p4 >> 1);
                    const v4i16_t v0 = __builtin_amdgcn_ds_read_tr16_b64_v4i16((LAS v4i16_t*)(Vs + row0 * 256 + ((c ^ ((row0 & 7) << 1)) << 4) + 8 * (p4 & 1)));
                    const v4i16_t v1 = __builtin_amdgcn_ds_read_tr16_b64_v4i16((LAS v4i16_t*)(Vs + row1 * 256 + ((c ^ ((row1 & 7) << 1)) << 4) + 8 * (p4 & 1)));
                    const bf16x8 vf = (bf16x8){v0[0], v0[1], v0[2], v0[3], v1[0], v1[1], v1[2], v1[3]};
                    o[dt] = __builtin_amdgcn_mfma_f32_16x16x32_bf16(vf, pf, o[dt], 0, 0, 0);
                }
            }
        }
        TS_END(18);
        const float il = __builtin_amdgcn_rcpf(lsum);
        const int tq = rowb + (m0 + 16 * wave + n) * dil + r;
        bf16_t* OG = grp < 2 ? (bf16_t*)(F.ws + WS_OG01) + (size_t)grp * T * 512 : (bf16_t*)(F.ob + OUT_OG2);
#pragma unroll
        for (int dt = 0; dt < 8; ++dt) { u32x2 w; w.x = pk2(o[dt][0] * il, o[dt][1] * il); w.y = pk2(o[dt][2] * il, o[dt][3] * il);
            *(u32x2*)(OG + (size_t)tq * 512 + s * 128 + 16 * dt + 4 * g) = w; }
        if (g == 0) ((float*)(F.ws + WS_LSE))[((size_t)grp * T + (size_t)tq) * 4 + s] = (mx + __builtin_amdgcn_logf(lsum)) * 0.6931471805599453f;
        TS_END(19);
    }
}
#undef ATT_DECODE
#undef ATT_LOADKV
__device__ __forceinline__ void p3_merge(Frame& F, const int b0, const int nb) {
    const int tid = opaque_tid();
    if (F.blk < b0 || F.blk >= b0 + nb) return;
    const bf16_t* OG0 = (const bf16_t*)(F.ws + WS_OG01); const bf16_t* OG1 = OG0 + (size_t)T * 512; const bf16_t* OG2 = (const bf16_t*)(F.ob + OUT_OG2);
    const float* LSE = (const float*)(F.ws + WS_LSE); bf16_t* YB = (bf16_t*)(F.ws + WS_YB);
    for (size_t it = (size_t)(F.blk - b0) * 512 + tid; it < (size_t)T * 64; it += (size_t)nb * 512) {
        const size_t t = it >> 6; const int ch = (int)(it & 63), s = ch >> 4;
        const float l0 = LSE[t * 4 + s], l1 = LSE[((size_t)T + t) * 4 + s], l2 = LSE[((size_t)2 * T + t) * 4 + s];
        const float m = fmaxf(l0, fmaxf(l1, l2)); const float e0 = __expf(l0 - m), e1 = __expf(l1 - m), e2 = __expf(l2 - m); const float inv = 1.f / (e0 + e1 + e2);
        const float w0 = e0 * inv, w1 = e1 * inv, w2 = e2 * inv;
        const u32x4 a = *(const u32x4*)(OG0 + t * 512 + ch * 8), bq = *(const u32x4*)(OG1 + t * 512 + ch * 8), cq = *(const u32x4*)(OG2 + t * 512 + ch * 8);
        u32x4 o;
#pragma unroll
        for (int i = 0; i < 4; ++i) o[i] = pk2(w0 * bflo(a[i]) + w1 * bflo(bq[i]) + w2 * bflo(cq[i]), w0 * bfhi(a[i]) + w1 * bfhi(bq[i]) + w2 * bfhi(cq[i]));
        *(u32x4*)(YB + t * 512 + ch * 8) = o;
    }
}

constexpr size_t WS_UT = 158 * MiB, WS_WM = 190 * MiB, WS_QD = 222 * MiB, WS_KDT = 254 * MiB, WS_QK = 286 * MiB;
constexpr size_t WS_GT = 1 * MiB + 512 * 1024;
__device__ __forceinline__ unsigned off_b(unsigned row, unsigned ch) { return 256u * row + 16u * (ch ^ (((row & 3) << 2) | ((row >> 2) & 3))); }
__device__ __forceinline__ unsigned rowfrag_b(unsigned lane, unsigned rb, unsigned s) { return off_b((lane & 15) + 16 * rb, 4 * s + (lane >> 4)); }
__device__ __forceinline__ unsigned trfrag_b(unsigned lane, unsigned c, unsigned ks, unsigned t) { const unsigned g = lane >> 4, q = (lane & 15) >> 2, p = lane & 3; return off_b(32 * ks + 8 * g + 4 * t + q, 2 * c + (p >> 1)) + 8 * (p & 1); }
__device__ __forceinline__ bf16x8 tr_pair(LAS unsigned char* a0, LAS unsigned char* a1) {
    const v4i16_t v0 = __builtin_amdgcn_ds_read_tr16_b64_v4i16((LAS v4i16_t*)a0), v1 = __builtin_amdgcn_ds_read_tr16_b64_v4i16((LAS v4i16_t*)a1);
    return (bf16x8){v0[0], v0[1], v0[2], v0[3], v1[0], v1[1], v1[2], v1[3]};
}
constexpr int MST = 144;
__device__ __forceinline__ f32x4 mm64_tile(LAS unsigned char* X, LAS unsigned char* Y, int ti, int tj, int lane) {
    const int n = lane & 15, g = lane >> 4, q = n >> 2, p = lane & 3;
    f32x4 acc = {0.f, 0.f, 0.f, 0.f};
#pragma unroll
    for (int ks = 0; ks < 2; ++ks) {
        const bf16x8 a = *(const LAS bf16x8*)(X + (16 * ti + n) * MST + 16 * (4 * ks + g));
        LAS unsigned char* yb = Y + (32 * ks + 8 * g + q) * MST + 32 * tj + 8 * p;
        const bf16x8 b = tr_pair(yb, yb + 4 * MST);
        acc = __builtin_amdgcn_mfma_f32_16x16x32_bf16(a, b, acc, 0, 0, 0);
    }
    return acc;
}
__device__ __forceinline__ void st_b16(LAS unsigned char* M, int row, int col, float v) { *(LAS unsigned short*)(M + row * MST + col * 2) = (unsigned short)pk2(v, 0.f); }

__device__ __forceinline__ void p3b_gdn_prep(Frame& F) {
    LAS unsigned char* Kn = F.lds; LAS unsigned char* Qn = F.lds + 16384; LAS unsigned char* Vn = F.lds + 32768;
    LAS unsigned char* R0 = F.lds + 49152; LAS unsigned char* R1 = R0 + 9216; LAS unsigned char* R2 = R1 + 9216; LAS unsigned char* R3 = R2 + 9216; LAS unsigned char* R4 = R3 + 9216;
    LAS float* Af = (LAS float*)(F.lds + 95232);
    LAS float* CW = (LAS float*)(F.lds + 111872);
    LAS float* betaS = (LAS float*)(F.lds + 118016); LAS float* gS = betaS + 64; LAS float* gcS = gS + 64;
    const bf16_t* GQ = (const bf16_t*)(F.ws + WS_GQ); const float* BA = (const float*)(F.ws + WS_BA);
    bf16_t* UT = (bf16_t*)(F.ws + WS_UT); bf16_t* WM = (bf16_t*)(F.ws + WS_WM); bf16_t* QD = (bf16_t*)(F.ws + WS_QD); bf16_t* KDT = (bf16_t*)(F.ws + WS_KDT); bf16_t* QK = (bf16_t*)(F.ws + WS_QK);
    float* GT = (float*)(F.ws + WS_GT);
    const float* convw = inp(I_CONVW);
    LAS unsigned char* RAW = F.lds + 49152;
    u32x4 own[3][2], halo; float cwr[3], bar0 = 0.f, bar1 = 0.f;
#define PREP_LOAD(u_) do { const int t_ = opaque_tid(), tr_ = t_ >> 3, cg_ = t_ & 7, h_ = ((u_) >> 5) & 7, nch_ = (u_) & 31; const size_t t0_ = (size_t)((u_) >> 8) * SEQ + 64 * nch_; \
        _Pragma("unroll") for (int tens = 0; tens < 3; ++tens) { const bf16_t* src = GQ + (size_t)tens * T * 1024 + (t0_ + tr_) * 1024 + h_ * 128 + 16 * cg_; own[tens][0] = *(const u32x4*)src; own[tens][1] = *(const u32x4*)(src + 8); } \
        halo = (u32x4){0u, 0u, 0u, 0u}; \
        if (t_ < 144 && nch_ > 0) { const int tens = t_ / 48, rem = t_ % 48; halo = *(const u32x4*)(GQ + (size_t)tens * T * 1024 + (t0_ - 3 + (rem >> 4)) * 1024 + h_ * 128 + (rem & 15) * 8); } \
        _Pragma("unroll") for (int i = 0; i < 3; ++i) { const int ii = t_ + 512 * i; cwr[i] = convw[((ii >> 7) & 3) * 3072 + (ii >> 9) * 1024 + h_ * 128 + (ii & 127)]; } \
        if (cg_ == 0) { bar0 = BA[(t0_ + tr_) * 16 + h_]; bar1 = BA[(t0_ + tr_) * 16 + 8 + h_]; } } while (0)
    LAS unsigned char* const lds = F.lds; (void)lds;
    if (F.blk < 2048) { PREP_LOAD(F.blk); }
#pragma unroll 1
    for (int u = F.blk; u < 2048; u += F.G) {
        const int tid = opaque_tid(), lane = tid & 63, wave = __builtin_amdgcn_readfirstlane(tid >> 6), n = lane & 15, g = lane >> 4;
        const int h = (u >> 5) & 7, nch = u & 31;
        const int tr = tid >> 3, cg = tid & 7;
        TS_BEGIN();
        __syncthreads();
#pragma unroll
        for (int i = 0; i < 3; ++i) CW[tid + 512 * i] = cwr[i];
#pragma unroll
        for (int tens = 0; tens < 3; ++tens) { LAS unsigned char* rp = RAW + (tens * 67 + 3 + tr) * 272 + 32 * cg; *(LAS u32x4*)rp = own[tens][0]; *(LAS u32x4*)(rp + 16) = own[tens][1]; }
        if (tid < 144) { const int tens = tid / 48, rem = tid % 48; *(LAS u32x4*)(RAW + (tens * 67 + (rem >> 4)) * 272 + (rem & 15) * 16) = halo; }
        __syncthreads();
        TS_END(0);
        float qv[16], kv[16];
        {
            float vv[16];
#pragma unroll
            for (int tens = 0; tens < 3; ++tens) {
                float acc[16];
#pragma unroll
                for (int c = 0; c < 16; ++c) acc[c] = 0.f;
#pragma unroll
                for (int j = 0; j < 4; ++j) { const LAS unsigned char* rp = RAW + (tens * 67 + tr + j) * 272 + 32 * cg; const u32x4 x0 = *(const LAS u32x4*)rp, x1 = *(const LAS u32x4*)(rp + 16);
                        const LAS float* w = CW + (tens * 4 + j) * 128 + 16 * cg;
#pragma unroll
                        for (int i = 0; i < 4; ++i) { acc[2 * i] += w[2 * i] * bflo(x0[i]); acc[2 * i + 1] += w[2 * i + 1] * bfhi(x0[i]); acc[8 + 2 * i] += w[8 + 2 * i] * bflo(x1[i]); acc[9 + 2 * i] += w[9 + 2 * i] * bfhi(x1[i]); } }
#pragma unroll
                for (int c = 0; c < 16; ++c) { const float y = siluf_(acc[c]); if (tens == 0) qv[c] = y; else if (tens == 1) kv[c] = y; else vv[c] = y; }
            }
            float sq = 0.f, sk = 0.f;
#pragma unroll
            for (int c = 0; c < 16; ++c) { sq += qv[c] * qv[c]; sk += kv[c] * kv[c]; }
            sq = red8(sq); sk = red8(sk);
            const float rq = rsqrtf(sq + EPS) * 0.08838834764831845f, rk = rsqrtf(sk + EPS);
#pragma unroll
            for (int c = 0; c < 16; ++c) { qv[c] *= rq; kv[c] *= rk; }
#pragma unroll
            for (int hf = 0; hf < 2; ++hf) { u32x4 a, bq, cq;
#pragma unroll
                for (int i = 0; i < 4; ++i) { a[i] = pk2(kv[8 * hf + 2 * i], kv[8 * hf + 2 * i + 1]); bq[i] = pk2(qv[8 * hf + 2 * i], qv[8 * hf + 2 * i + 1]); cq[i] = pk2(vv[8 * hf + 2 * i], vv[8 * hf + 2 * i + 1]); }
                const unsigned o = off_b(tr, 2 * cg + hf);
                *(LAS u32x4*)(Kn + o) = a; *(LAS u32x4*)(Qn + o) = bq; *(LAS u32x4*)(Vn + o) = cq; }
        }
        if (cg == 0) { const float bb = bar0, aa = bar1; const float sp = aa + inp(I_DTB)[h]; const float spl = sp > 20.f ? sp : log1pf(__expf(sp));
            betaS[tr] = sigmoidf_(bb); gS[tr] = -__expf(inp(I_ALOG)[h]) * spl; }
        __syncthreads();
        TS_END(1);
        if (wave == 0) { float v = gS[lane];
#pragma unroll
            for (int d = 1; d < 64; d <<= 1) { const float t = __shfl_up(v, d); if (lane >= d) v += t; }
            gcS[lane] = v; }
        __syncthreads();
        {
            const float eg = __expf(gcS[tr]);
            u32x4 a, bq;
#pragma unroll
            for (int i = 0; i < 4; ++i) { a[i] = pk2(qv[2 * i] * eg, qv[2 * i + 1] * eg); bq[i] = pk2(qv[8 + 2 * i] * eg, qv[9 + 2 * i] * eg); }
            bf16_t* d = QD + (size_t)u * 8192 + (size_t)(((tr >> 4) * 4 + (cg >> 1)) * 64 + (tr & 15)) * 8;
            *(u32x4*)(d + (((2 * cg) & 3) * 16) * 8) = a; *(u32x4*)(d + (((2 * cg + 1) & 3) * 16) * 8) = bq;
        }
        if (u + F.G < 2048) { PREP_LOAD(u + F.G); }
        const float gcl = gcS[63];
        if (tid == 0) GT[u] = __expf(gcl);
        TS_END(2);
#pragma unroll
        for (int rep = 0; rep < 2; ++rep) {
            const int idx = wave + 8 * rep, ti = idx >> 2, tj = idx & 3;
            f32x4 kk = {0.f, 0.f, 0.f, 0.f}, qk = {0.f, 0.f, 0.f, 0.f};
            if (ti >= tj) {
#pragma unroll
                for (int ks = 0; ks < 4; ++ks) { const bf16x8 a = *(const LAS bf16x8*)(Kn + rowfrag_b(lane, ti, ks)), bb = *(const LAS bf16x8*)(Kn + rowfrag_b(lane, tj, ks));
                    kk = __builtin_amdgcn_mfma_f32_16x16x32_bf16(a, bb, kk, 0, 0, 0); }
#pragma unroll
                for (int ks = 0; ks < 4; ++ks) { const bf16x8 a = *(const LAS bf16x8*)(Kn + rowfrag_b(lane, tj, ks)), bb = *(const LAS bf16x8*)(Qn + rowfrag_b(lane, ti, ks));
                    qk = __builtin_amdgcn_mfma_f32_16x16x32_bf16(a, bb, qk, 0, 0, 0); }
            }
            {
                const int j = 16 * tj + n; const float gj = gcS[j]; const f32x4 gi4 = *(const LAS f32x4*)(gcS + 16 * ti + 4 * g), bi4 = *(const LAS f32x4*)(betaS + 16 * ti + 4 * g);
#pragma unroll
                for (int reg = 0; reg < 4; ++reg) { const int i = 16 * ti + 4 * g + reg; float v = 0.f; if (j < i) v = kk[reg] * bi4[reg] * __expf(gi4[reg] - gj);
                    Af[i * 65 + j] = v; st_b16(R0, i, j, ti > tj ? v : 0.f); }
            }
            {
                const int i = 16 * ti + n; const float gi = gcS[i]; const f32x4 gj4 = *(const LAS f32x4*)(gcS + 16 * tj + 4 * g); float o[4];
#pragma unroll
                for (int reg = 0; reg < 4; ++reg) { const int j = 16 * tj + 4 * g + reg; o[reg] = (j <= i) ? qk[reg] * __expf(gi - gj4[reg]) : 0.f; }
                u32x2 w; w.x = pk2(o[0], o[1]); w.y = pk2(o[2], o[3]);
                *(u32x2*)(QK + (size_t)u * 4096 + (size_t)((ti * 2 + (tj >> 1)) * 64 + ((2 * tj + (g >> 1)) & 3) * 16 + n) * 8 + 4 * (g & 1)) = w;
            }
        }
        for (int i = tid; i < 9216 / 4; i += 512) ((LAS unsigned*)R1)[i] = 0u;
        __syncthreads();
        TS_END(3);
        if (tid < 64) { const int bI = tid >> 4, cc = tid & 15; float x[16];
#pragma unroll
            for (int i = 0; i < 16; ++i) { float s = (i == cc) ? 1.f : 0.f;
#pragma unroll
                for (int j = 0; j < 16; ++j) if (j < i) s -= Af[(16 * bI + i) * 65 + 16 * bI + j] * x[j];
                x[i] = s; }
#pragma unroll
            for (int i = 0; i < 16; ++i) st_b16(R1, 16 * bI + i, 16 * bI + cc, x[i]); }
        __syncthreads();
        TS_END(4);
#pragma unroll
        for (int rep = 0; rep < 2; ++rep) { const int idx = wave + 8 * rep, ti = idx >> 2, tj = idx & 3; const f32x4 m = mm64_tile(R1, R0, ti, tj, lane);
#pragma unroll
            for (int reg = 0; reg < 4; ++reg) { const int i = 16 * ti + 4 * g + reg, j = 16 * tj + n; st_b16(R2, i, j, m[reg]); st_b16(R3, i, j, (i == j ? 1.f : 0.f) - m[reg]); } }
        __syncthreads();
#pragma unroll
        for (int rep = 0; rep < 2; ++rep) { const int idx = wave + 8 * rep, ti = idx >> 2, tj = idx & 3; const f32x4 m = mm64_tile(R2, R2, ti, tj, lane);
#pragma unroll
            for (int reg = 0; reg < 4; ++reg) { const int i = 16 * ti + 4 * g + reg, j = 16 * tj + n; st_b16(R4, i, j, (i == j ? 1.f : 0.f) + m[reg]); } }
        __syncthreads();
#pragma unroll
        for (int rep = 0; rep < 2; ++rep) { const int idx = wave + 8 * rep, ti = idx >> 2, tj = idx & 3; const f32x4 m = mm64_tile(R4, R1, ti, tj, lane);
#pragma unroll
            for (int reg = 0; reg < 4; ++reg) { const int i = 16 * ti + 4 * g + reg, j = 16 * tj + n; st_b16(R0, i, j, m[reg]); } }
        __syncthreads();
#pragma unroll
        for (int rep = 0; rep < 2; ++rep) { const int idx = wave + 8 * rep, ti = idx >> 2, tj = idx & 3; const f32x4 m = mm64_tile(R3, R0, ti, tj, lane);
            const int j = 16 * tj + n; const float bj = betaS[j], bw = bj * __expf(gcS[j]);
#pragma unroll
            for (int reg = 0; reg < 4; ++reg) { const int i = 16 * ti + 4 * g + reg; st_b16(R2, i, j, m[reg] * bj); st_b16(R4, i, j, m[reg] * bw); } }
        __syncthreads();
        TS_END(5);
        {
            const int tt = wave >> 1, dvb = 4 * (wave & 1);
#pragma unroll
            for (int k = 0; k < 4; ++k) { const int dvt = dvb + k; f32x4 acc = {0.f, 0.f, 0.f, 0.f};
#pragma unroll
                for (int ks = 0; ks < 2; ++ks) { const bf16x8 a = *(const LAS bf16x8*)(R2 + (16 * tt + n) * MST + 16 * (4 * ks + g));
                    const bf16x8 bb = tr_pair(Vn + trfrag_b(lane, dvt, ks, 0), Vn + trfrag_b(lane, dvt, ks, 1));
                    acc = __builtin_amdgcn_mfma_f32_16x16x32_bf16(a, bb, acc, 0, 0, 0); }
                u32x2 w; w.x = pk2(acc[0], acc[1]); w.y = pk2(acc[2], acc[3]);
                *(u32x2*)(UT + (size_t)u * 8192 + (size_t)((tt * 8 + dvt) * 64 + lane) * 4) = w; }
            const int dkt = wave;
#pragma unroll
            for (int t4 = 0; t4 < 4; ++t4) { f32x4 acc = {0.f, 0.f, 0.f, 0.f};
#pragma unroll
                for (int ks = 0; ks < 2; ++ks) { const bf16x8 a = tr_pair(Kn + trfrag_b(lane, dkt, ks, 0), Kn + trfrag_b(lane, dkt, ks, 1));
                    if (t4 == 0) {
                        const f32x4 e0 = *(const LAS f32x4*)(gcS + 32 * ks + 8 * g), e1 = *(const LAS f32x4*)(gcS + 32 * ks + 8 * g + 4); u32x4 w;
                        w[0] = pk2(bf2f((unsigned short)a[0]) * __expf(gcl - e0.x), bf2f((unsigned short)a[1]) * __expf(gcl - e0.y)); w[1] = pk2(bf2f((unsigned short)a[2]) * __expf(gcl - e0.z), bf2f((unsigned short)a[3]) * __expf(gcl - e0.w));
                        w[2] = pk2(bf2f((unsigned short)a[4]) * __expf(gcl - e1.x), bf2f((unsigned short)a[5]) * __expf(gcl - e1.y)); w[3] = pk2(bf2f((unsigned short)a[6]) * __expf(gcl - e1.z), bf2f((unsigned short)a[7]) * __expf(gcl - e1.w));
                        *(u32x4*)(KDT + (size_t)u * 8192 + (size_t)((dkt * 2 + ks) * 64 + lane) * 8) = w; }
                    const bf16x8 bb = *(const LAS bf16x8*)(R4 + (16 * t4 + n) * MST + 16 * (4 * ks + g));
                    acc = __builtin_amdgcn_mfma_f32_16x16x32_bf16(a, bb, acc, 0, 0, 0); }
                u32x2 w; w.x = pk2(acc[0], acc[1]); w.y = pk2(acc[2], acc[3]);
                *(u32x2*)(WM + (size_t)u * 8192 + (size_t)((t4 * 4 + (dkt >> 1)) * 64 + ((2 * dkt + (g >> 1)) & 3) * 16 + n) * 8 + 4 * (g & 1)) = w; }
        }
        TS_END(6);
    }
}

#undef PREP_LOAD
__device__ __forceinline__ void p4_gdn_scan(Frame& F) {
    if (F.blk >= 64) return;
    const int tid = opaque_tid(), lane = tid & 63, wave = __builtin_amdgcn_readfirstlane(tid >> 6), n = lane & 15, g = lane >> 4;
    const int b = F.blk >> 3, h = F.blk & 7; const size_t u0 = (size_t)F.blk * 32;
    LAS unsigned char* SbT0 = F.lds; LAS unsigned char* VNT = F.lds + 69632; LAS unsigned char* Os0 = F.lds + 88064; LAS float* ngS = (LAS float*)(F.lds + 122880);
    const bf16_t* UT = (const bf16_t*)(F.ws + WS_UT); const bf16_t* WM = (const bf16_t*)(F.ws + WS_WM); const bf16_t* QD = (const bf16_t*)(F.ws + WS_QD);
    const bf16_t* KDT = (const bf16_t*)(F.ws + WS_KDT); const bf16_t* QK = (const bf16_t*)(F.ws + WS_QK); const float* GT = (const float*)(F.ws + WS_GT);
    const bf16_t* GZ = (const bf16_t*)(F.ob + OUT_GZ); bf16_t* YA = (bf16_t*)(F.ws + WS_YA);
    const int tt = wave >> 1, dvb = 4 * (wave & 1);
    const int tok = tid >> 3, seg = tid & 7;
    f32x4 S[8];
#pragma unroll
    for (int i = 0; i < 8; ++i) S[i] = (f32x4){0.f, 0.f, 0.f, 0.f};
    if (tid < 128) ngS[tid] = inp(I_GNG)[tid];
    bf16x8 wfA[4], wfB[4], qdf[4], qkf[2], kdf[2]; u32x2 ufA[4], ufB[4]; u32x4 zc[2], zp[2]; float gtA, gtB;
    const unsigned lo_w = (unsigned)((tt * 4) * 64 + lane) * 16u, lo_u = (unsigned)((tt * 8 + dvb) * 64 + lane) * 8u, lo_qk = (unsigned)((tt * 2) * 64 + lane) * 16u,
                   lo_kd = (unsigned)((wave * 2) * 64 + lane) * 16u, lo_z = (unsigned)(tok * 1024 + h * 128 + 16 * seg) * 2u;
    const char* const pWM = (const char*)(WM + u0 * 8192); const char* const pQD = (const char*)(QD + u0 * 8192); const char* const pUT = (const char*)(UT + u0 * 8192);
    const char* const pKD = (const char*)(KDT + u0 * 8192); const char* const pQK = (const char*)(QK + u0 * 4096); const char* const pGZ = (const char*)(GZ + (size_t)b * SEQ * 1024);
#define LD_SET(X, nn_) do { const size_t c16_ = (size_t)(nn_) * 16384; \
        _Pragma("unroll") for (int ks = 0; ks < 4; ++ks) wf##X[ks] = *(const bf16x8*)(pWM + c16_ + lo_w + 1024 * ks); \
        _Pragma("unroll") for (int k = 0; k < 4; ++k) uf##X[k] = *(const u32x2*)(pUT + c16_ + lo_u + 512 * k); \
        gt##X = GT[u0 + (nn_)]; } while (0)
#define LD_Q(nn_) do { const size_t c16_ = (size_t)(nn_) * 16384, c8_ = (size_t)(nn_) * 8192; \
        _Pragma("unroll") for (int ks = 0; ks < 4; ++ks) qdf[ks] = *(const bf16x8*)(pQD + c16_ + lo_w + 1024 * ks); \
        _Pragma("unroll") for (int ks = 0; ks < 2; ++ks) qkf[ks] = *(const bf16x8*)(pQK + c8_ + lo_qk + 1024 * ks); } while (0)
#define LD_K(nn_) do { const size_t c16_ = (size_t)(nn_) * 16384, cz_ = (size_t)(nn_) * 64 * 2048; \
        _Pragma("unroll") for (int ks = 0; ks < 2; ++ks) kdf[ks] = *(const bf16x8*)(pKD + c16_ + lo_kd + 1024 * ks); \
        zc[0] = *(const u32x4*)(pGZ + cz_ + lo_z); zc[1] = *(const u32x4*)(pGZ + cz_ + lo_z + 16); } while (0)
#define NORM_OUT(OsB, nc_, Z) do { const size_t t = (size_t)b * SEQ + 64 * (nc_) + tok; \
        const u32x4 o0 = *(const LAS u32x4*)((OsB) + tok * 272 + 32 * seg), o1 = *(const LAS u32x4*)((OsB) + tok * 272 + 32 * seg + 16); float o[16]; float ss = 0.f; \
        _Pragma("unroll") for (int i = 0; i < 4; ++i) { o[2 * i] = bflo(o0[i]); o[2 * i + 1] = bfhi(o0[i]); o[8 + 2 * i] = bflo(o1[i]); o[9 + 2 * i] = bfhi(o1[i]); } \
        _Pragma("unroll") for (int i = 0; i < 16; ++i) ss += o[i] * o[i]; \
        ss = red8(ss); \
        const float rstd = rsqrtf(ss * (1.f / 128.f) + EPS); \
        u32x4 y0, y1; \
        _Pragma("unroll") for (int i = 0; i < 4; ++i) { y0[i] = pk2(o[2 * i] * rstd * ngS[16 * seg + 2 * i] * siluf_(bflo(Z[0][i])), o[2 * i + 1] * rstd * ngS[16 * seg + 2 * i + 1] * siluf_(bfhi(Z[0][i]))); \
            y1[i] = pk2(o[8 + 2 * i] * rstd * ngS[16 * seg + 8 + 2 * i] * siluf_(bflo(Z[1][i])), o[9 + 2 * i] * rstd * ngS[16 * seg + 9 + 2 * i] * siluf_(bfhi(Z[1][i]))); } \
        *(u32x4*)(YA + t * 1024 + h * 128 + 16 * seg) = y0; *(u32x4*)(YA + t * 1024 + h * 128 + 16 * seg + 8) = y1; } while (0)
#define CHUNK(X, nc_, P) do { LAS unsigned char* const SbT = SbT0 + (P) * 34816; LAS unsigned char* const OsW = Os0 + (P) * 17408; \
          \
        _Pragma("unroll") for (int dvt = 0; dvt < 8; ++dvt) { u32x2 w; w.x = pk2(S[dvt][0], S[dvt][1]); w.y = pk2(S[dvt][2], S[dvt][3]); \
            *(LAS u32x2*)(SbT + (16 * dvt + n) * 272 + (16 * wave + 4 * g) * 2) = w; } \
        __syncthreads(); \
          \
        if ((nc_) > 0) { NORM_OUT(Os0 + (1 - (P)) * 17408, (nc_) - 1, zp); } \
          \
        { f32x4 acc[4]; \
          _Pragma("unroll") for (int k = 0; k < 4; ++k) acc[k] = (f32x4){0.f, 0.f, 0.f, 0.f}; \
          _Pragma("unroll") for (int ks = 0; ks < 4; ++ks) { bf16x8 bb[4]; \
            _Pragma("unroll") for (int k = 0; k < 4; ++k) bb[k] = *(const LAS bf16x8*)(SbT + (16 * (dvb + k) + n) * 272 + 16 * (4 * ks + g)); \
            _Pragma("unroll") for (int k = 0; k < 4; ++k) acc[k] = __builtin_amdgcn_mfma_f32_16x16x32_bf16(wf##X[ks], bb[k], acc[k], 0, 0, 0); } \
          _Pragma("unroll") for (int k = 0; k < 4; ++k) { u32x2 w; w.x = pk2(bflo(uf##X[k].x) - acc[k][0], bfhi(uf##X[k].x) - acc[k][1]); w.y = pk2(bflo(uf##X[k].y) - acc[k][2], bfhi(uf##X[k].y) - acc[k][3]); \
            *(LAS u32x2*)(VNT + (16 * (dvb + k) + n) * MST + (16 * tt + 4 * g) * 2) = w; } } \
        __syncthreads(); \
          \
        { f32x4 acc[4]; \
          _Pragma("unroll") for (int k = 0; k < 4; ++k) acc[k] = (f32x4){0.f, 0.f, 0.f, 0.f}; \
          _Pragma("unroll") for (int ks = 0; ks < 4; ++ks) { bf16x8 bb[4]; \
            _Pragma("unroll") for (int k = 0; k < 4; ++k) bb[k] = *(const LAS bf16x8*)(SbT + (16 * (dvb + k) + n) * 272 + 16 * (4 * ks + g)); \
            _Pragma("unroll") for (int k = 0; k < 4; ++k) acc[k] = __builtin_amdgcn_mfma_f32_16x16x32_bf16(qdf[ks], bb[k], acc[k], 0, 0, 0); } \
          _Pragma("unroll") for (int ks = 0; ks < 2; ++ks) { bf16x8 bb[4]; \
            _Pragma("unroll") for (int k = 0; k < 4; ++k) bb[k] = *(const LAS bf16x8*)(VNT + (16 * (dvb + k) + n) * MST + 16 * (4 * ks + g)); \
            _Pragma("unroll") for (int k = 0; k < 4; ++k) acc[k] = __builtin_amdgcn_mfma_f32_16x16x32_bf16(qkf[ks], bb[k], acc[k], 0, 0, 0); } \
          _Pragma("unroll") for (int k = 0; k < 4; ++k) _Pragma("unroll") for (int reg = 0; reg < 4; ++reg) \
              *(LAS unsigned short*)(OsW + (16 * tt + 4 * g + reg) * 272 + (16 * (dvb + k) + n) * 2) = (unsigned short)pk2(acc[k][reg], 0.f); } \
        if ((nc_) + 1 < 32) { LD_Q((nc_) + 1); }     \
          \
        _Pragma("unroll") for (int dvt = 0; dvt < 8; ++dvt) S[dvt] = S[dvt] * gt##X; \
        _Pragma("unroll") for (int ks = 0; ks < 2; ++ks) { bf16x8 bb[8]; \
            _Pragma("unroll") for (int dvt = 0; dvt < 8; ++dvt) bb[dvt] = *(const LAS bf16x8*)(VNT + (16 * dvt + n) * MST + 16 * (4 * ks + g)); \
            _Pragma("unroll") for (int dvt = 0; dvt < 8; ++dvt) S[dvt] = __builtin_amdgcn_mfma_f32_16x16x32_bf16(kdf[ks], bb[dvt], S[dvt], 0, 0, 0); } \
        zp[0] = zc[0]; zp[1] = zc[1]; \
        if ((nc_) + 1 < 32) { LD_K((nc_) + 1); } \
    } while (0)
    LAS unsigned char* const lds = F.lds; (void)lds;
    LD_SET(A, 0); LD_Q(0); LD_K(0);
#pragma unroll 1
    for (int nc = 0; nc < 32; nc += 2) {
        LD_SET(B, nc + 1);
        CHUNK(A, nc, 0);
        if (nc + 2 < 32) { LD_SET(A, nc + 2); }
        CHUNK(B, nc + 1, 1);
    }
    __syncthreads();
    NORM_OUT(Os0 + 17408, 31, zp);
#undef LD_SET
#undef LD_Q
#undef LD_K
#undef NORM_OUT
#undef CHUNK
}

struct G2Unit { int e, mt, half; const unsigned char* Ap; const char* Bp; };
__device__ __forceinline__ G2Unit g2_unit(const Frame& F, const MoeTab& tb, int L, int NR) {
    G2Unit u; const int tile = L >> 1; u.half = L & 1;
    if (tile < NR) { u.e = tb.te[tile]; u.mt = tile - tb.tp[u.e]; u.Ap = F.ws + WS_ACT + (size_t)tile * 65536; u.Bp = (const char*)(F.ob + OUT_WD) + ((size_t)u.e * 1024 + u.half * 512) * 256; }
    else { u.e = 64; u.mt = tile - NR; u.Ap = F.ws + WS_ACTS + (size_t)u.mt * 65536; u.Bp = (const char*)(F.ws + WS_WSD) + (size_t)(u.half * 512) * 256; }
    return u;
}
__device__ __forceinline__ void p8b_down(Frame& F, const MoeTab tb, const int xmode = 0) {
    if (xmode == 4) return;
    const int tid = opaque_tid(), lane = tid & 63, wave = __builtin_amdgcn_readfirstlane(tid >> 6), n = lane & 15, g = lane >> 4;
    LAS unsigned char* const Bs = F.lds;
    LAS int* const pairb = (LAS int*)(F.lds + INFO_OFF);
    const int* list = (const int*)(F.ws + WS_LIST);
    unsigned char* SLOT = F.ws + WS_SLOT; unsigned char* SH = F.ws + WS_SH;
    unsigned char* const dump = F.ws + WS_LSE + (size_t)F.blk * 1024 + lane * 16;
    const int NR = tb.tp[64], NU = (NR + 64) * 2;
    const int vblk = (F.G % 8 == 0) ? (F.blk % 8) * (F.G / 8) + F.blk / 8 : F.blk;
    int L = vblk; if (L >= NU) return;
    LAS unsigned char* const lds = F.lds; (void)lds; TS_DECL; TS_BEGIN();
    unsigned voff[2];
    { const int rho = 4 * wave + (lane >> 4), c = (lane & 15) ^ (rho & 15), ct = rho >> 4, gg = (rho >> 2) & 3, reg = rho & 3;
#pragma unroll
      for (int j = 0; j < 2; ++j) voff[j] = (unsigned)((16 * gg + 8 * j + 4 * ct + reg) * 256 + c * 16); }
#define G2_GLDS(src_, q_) __builtin_amdgcn_global_load_lds((const unsigned*)((src_) + (size_t)((q_) >> 1) * 16384 + voff[(q_) & 1]), (LAS unsigned*)(Bs + ((q_) & 7) * 8192 + wave * 1024), 16, 0, 0)
#define G2_PAIR_LD(u_, raw_) do { const int r_ = tid & 255; int idx_ = 0; if ((u_).e < 64) { const int pos_ = (u_).mt * 256 + r_; idx_ = pos_ < tb.cnt[(u_).e] ? (u_).e * T + pos_ : 0; } raw_ = list[idx_]; } while (0)
#define G2_PAIR_FIX(u_, raw_, dst_) do { const int r_ = tid & 255; if ((u_).e < 64) { const int pos_ = (u_).mt * 256 + r_; dst_ = pos_ < tb.cnt[(u_).e] ? raw_ : -1; } else dst_ = (u_).mt * 256 + r_; } while (0)
#define G2_ALOAD(u_, dst_) do { _Pragma("unroll") for (int rt = 0; rt < 2; ++rt) _Pragma("unroll") for (int kp = 0; kp < 4; ++kp) dst_[rt][kp] = *(const u32x4*)((u_).Ap + (size_t)(32 * wave + 16 * rt + n) * 256 + 64 * kp + 16 * g); } while (0)
    G2Unit cur = g2_unit(F, tb, L, NR);
    u32x4 af[2][4]; int pcur;
    { int raw; G2_PAIR_LD(cur, raw); G2_ALOAD(cur, af); G2_PAIR_FIX(cur, raw, pcur); }
    if (tid < 256) pairb[tid] = pcur;
#pragma unroll
    for (int t = 0; t < 6; ++t) G2_GLDS(cur.Bp, t);
#pragma unroll
    for (int rt = 0; rt < 2; ++rt)
#pragma unroll
        for (int kp = 0; kp < 4; ++kp) asm volatile("" : "+v"(af[rt][kp]));
    TS_END(50);
    while (true) {
        const int Ln = L + F.G; const bool hasn = Ln < NU;
        const G2Unit nxt = g2_unit(F, tb, hasn ? Ln : L, NR);
        u32x4 an[2][4]; int pn = -1, prow[2] = {-1, -1};
#pragma unroll
        for (int bp = 0; bp < 8; ++bp) {
            if (hasn && bp >= 5) asm volatile("s_waitcnt vmcnt(19)" ::: "memory"); else asm volatile("s_waitcnt vmcnt(10)" ::: "memory");
            __builtin_amdgcn_s_barrier();
            asm volatile("" ::: "memory");
#pragma unroll
            for (int j = 0; j < 2; ++j) { const int q = 2 * bp + 6 + j;
                if (q < 16) G2_GLDS(cur.Bp, q); else G2_GLDS(nxt.Bp, q - 16); }
            if (bp == 4 && hasn) { G2_ALOAD(nxt, an); G2_PAIR_LD(nxt, pn); }
            if (bp == 0) {
#pragma unroll
                for (int rt = 0; rt < 2; ++rt) prow[rt] = pairb[32 * wave + 16 * rt + n]; }
            f32x4 acc[2][2][2];
#pragma unroll
            for (int j = 0; j < 2; ++j) { const LAS unsigned char* bs = Bs + ((2 * bp + j) & 7) * 8192;
#pragma unroll
                for (int rt = 0; rt < 2; ++rt)
#pragma unroll
                    for (int ct = 0; ct < 2; ++ct) acc[j][rt][ct] = (f32x4){0.f, 0.f, 0.f, 0.f};
#pragma unroll
                for (int kk = 0; kk < 2; ++kk) {
                    const bf16x8 w00 = *(const LAS bf16x8*)(bs + n * 256 + (((8 * kk + g) ^ n) << 4)), w01 = *(const LAS bf16x8*)(bs + n * 256 + (((8 * kk + 4 + g) ^ n) << 4));
                    const bf16x8 w10 = *(const LAS bf16x8*)(bs + (16 + n) * 256 + (((8 * kk + g) ^ n) << 4)), w11 = *(const LAS bf16x8*)(bs + (16 + n) * 256 + (((8 * kk + 4 + g) ^ n) << 4));
#pragma unroll
                    for (int rt = 0; rt < 2; ++rt) { const bf16x8 a0 = __builtin_bit_cast(bf16x8, af[rt][2 * kk]), a1 = __builtin_bit_cast(bf16x8, af[rt][2 * kk + 1]);
                        acc[j][rt][0] = mfma_fp8_k128(w00, w01, a0, a1, acc[j][rt][0]); acc[j][rt][1] = mfma_fp8_k128(w10, w11, a0, a1, acc[j][rt][1]); }
                }
            }
            const int col = cur.half * 512 + 64 * bp + 16 * g; unsigned char* const obase = cur.e < 64 ? SLOT : SH;
#pragma unroll
            for (int rt = 0; rt < 2; ++rt) { const int p = prow[rt];
                constexpr float IS = 1.0f / WD_SCALE; u32x4 w;
#pragma unroll
                for (int j = 0; j < 2; ++j)
#pragma unroll
                    for (int ct = 0; ct < 2; ++ct) { int pk = 0; pk = __builtin_amdgcn_cvt_pk_fp8_f32(acc[j][rt][ct][0] * IS, acc[j][rt][ct][1] * IS, pk, false); pk = __builtin_amdgcn_cvt_pk_fp8_f32(acc[j][rt][ct][2] * IS, acc[j][rt][ct][3] * IS, pk, true); w[2 * j + ct] = (unsigned)pk; }
                *(u32x4*)(p >= 0 ? obase + (size_t)p * 1024 + col : dump) = w; }
        }
        TS_END(51);
        if (!hasn) break;
#pragma unroll
        for (int rt = 0; rt < 2; ++rt)
#pragma unroll
            for (int kp = 0; kp < 4; ++kp) af[rt][kp] = an[rt][kp];
        { int pf; G2_PAIR_FIX(nxt, pn, pf); if (tid < 256) pairb[tid] = pf; }
        cur = nxt; L = Ln;
        TS_END(50);
    }
#undef G2_GLDS
#undef G2_PAIR_LD
#undef G2_PAIR_FIX
#undef G2_ALOAD
}

constexpr size_t WS_WRH = 3 * MiB + 64 * 1024, WS_WRL = 3 * MiB + 192 * 1024;
__device__ __forceinline__ void p1_router_split(Frame& F) {
    const int gid = F.blk * 512 + opaque_tid();
    if (gid < 64 * 128) { const int e = gid >> 7, k0 = (gid & 127) * 8; const float* wr = inp(I_WR);
        u32x4 hi, lo;
#pragma unroll
        for (int i = 0; i < 4; ++i) { const float a = wr[(size_t)(k0 + 2 * i) * 64 + e], b = wr[(size_t)(k0 + 2 * i + 1) * 64 + e];
            const unsigned h = pk2(a, b); hi[i] = h; lo[i] = pk2(a - bflo(h), b - bfhi(h)); }
        *(u32x4*)((bf16_t*)(F.ws + WS_WRH) + (size_t)e * 1024 + k0) = hi; *(u32x4*)((bf16_t*)(F.ws + WS_WRL) + (size_t)e * 1024 + k0) = lo; }
}
__device__ __forceinline__ void p7_route(Frame& F, const bool emit) {
    const int ftid = opaque_tid(), flane = ftid & 63, fwave = __builtin_amdgcn_readfirstlane(ftid >> 6);
    constexpr int RS = 528, LS = 65;
    LAS unsigned char* Hhi = F.lds; LAS unsigned char* Hlo = F.lds + 64 * RS;
    LAS unsigned char* Whi = F.lds + 128 * RS; LAS unsigned char* Wlo = F.lds + 192 * RS;
    LAS float* Ls = (LAS float*)F.lds;
    LAS float* CandS = (LAS float*)(F.lds + 16896);
    LAS int* CandI = (LAS int*)(F.lds + 25088);
    LAS int* hist = (LAS int*)(F.lds + 33280);
    const float* MOD = (const float*)(F.ws + WS_MOD); const float* X = inp(I_X); const bf16_t* Y = (const bf16_t*)(F.ws + WS_Y); unsigned char* H2 = F.ws + WS_H;
    int* LIST = (int*)(F.ws + WS_LIST); float* LISTW = (float*)(F.ws + WS_LISTW); gu32* gcnt = (gu32*)(F.ws + WS_CTL) + CW_CNT;
    const bf16_t* WRH = (const bf16_t*)(F.ws + WS_WRH); const bf16_t* WRL = (const bf16_t*)(F.ws + WS_WRL);
    const int tid = ftid, lane = flane, wave = fwave, n = lane & 15, g = lane >> 4;
    LAS unsigned char* const lds = F.lds; (void)lds;
    for (int grp = F.blk; grp < T / 64; grp += F.G) {
        const int row0 = grp * 64, b = row0 / SEQ;
        TS_BEGIN();
        const float* sh2 = MOD + b * 6144 + 3 * 1024; const float* sc2 = sh2 + 1024;
        float rstd[8];
        f32x4 xx[8][4];
        {
#pragma unroll
          for (int rr = 0; rr < 8; ++rr) { const size_t ro = (size_t)(row0 + 8 * wave + rr) * DM + 4 * lane;
#pragma unroll
              for (int j = 0; j < 4; ++j) xx[rr][j] = *(const f32x4*)(X + ro + 256 * j); }
#pragma unroll
          for (int hb = 0; hb < 4; ++hb) { u32x2 yy[2][4];
#pragma unroll
            for (int rr = 0; rr < 2; ++rr) { const size_t ro = (size_t)(row0 + 8 * wave + 2 * hb + rr) * DM + 4 * lane;
#pragma unroll
                for (int j = 0; j < 4; ++j) yy[rr][j] = *(const u32x2*)(Y + ro + 256 * j); }
#pragma unroll
            for (int rr = 0; rr < 2; ++rr)
#pragma unroll
                for (int j = 0; j < 4; ++j) { const u32x2 y = yy[rr][j]; f32x4 v = xx[2 * hb + rr][j]; const f32x4 g1 = *(const f32x4*)(MOD + b * 6144 + 2048 + 256 * j + 4 * lane);
                    v.x += g1.x * bflo(y.x); v.y += g1.y * bfhi(y.x); v.z += g1.z * bflo(y.y); v.w += g1.w * bfhi(y.y); xx[2 * hb + rr][j] = v; }
            asm volatile("" ::: "memory"); } }
#pragma unroll
        for (int rr = 0; rr < 8; ++rr) { float ss = 0.f;
#pragma unroll
            for (int j = 0; j < 4; ++j) { const f32x4 v = xx[rr][j]; ss += (v.x * v.x + v.y * v.y) + (v.z * v.z + v.w * v.w); }
            rstd[rr] = rsqrtf(wave_sum(ss) * (1.f / DM) + EPS); }
        TS_END(10);
        f32x4 acc0 = {0.f, 0.f, 0.f, 0.f}, acc1 = {0.f, 0.f, 0.f, 0.f};
        const int rt = wave & 3, et = (wave >> 2) * 2;
        u32x4 wnh[4], wnl[4];
#define P7_LOADX(c_) do { \
        _Pragma("unroll") for (int i = 0; i < 4; ++i) { const int e = (tid >> 5) + 16 * i, kc = (tid & 31) * 8; wnh[i] = *(const u32x4*)(WRH + (size_t)e * 1024 + (c_) * 256 + kc); wnl[i] = *(const u32x4*)(WRL + (size_t)e * 1024 + (c_) * 256 + kc); } } while (0)
        P7_LOADX(0);
#pragma unroll
        for (int c = 0; c < 4; ++c) {
            const int tid = opaque_tid(), lane = tid & 63, n = lane & 15, g = lane >> 4;
            const int k = c * 256 + 4 * lane;
            const f32x4 g2 = *(const f32x4*)(inp(I_GFFN) + k), s2 = *(const f32x4*)(sc2 + k) + 1.0f, h2 = *(const f32x4*)(sh2 + k);
#pragma unroll
            for (int rr = 0; rr < 8; ++rr) { const size_t row = (size_t)(row0 + 8 * wave + rr);
                const f32x4 hv = (xx[rr][c] * rstd[rr]) * (g2 * s2) + h2;
                u32x2 hi, lo; hi.x = pk2(hv.x, hv.y); hi.y = pk2(hv.z, hv.w);
                lo.x = pk2(hv.x - bflo(hi.x), hv.y - bfhi(hi.x)); lo.y = pk2(hv.z - bflo(hi.y), hv.w - bfhi(hi.y));
                *(LAS u32x2*)(Hhi + (8 * wave + rr) * RS + 8 * lane) = hi; *(LAS u32x2*)(Hlo + (8 * wave + rr) * RS + 8 * lane) = lo;
                { int w8 = 0; w8 = __builtin_amdgcn_cvt_pk_fp8_f32(hv.x, hv.y, w8, false); w8 = __builtin_amdgcn_cvt_pk_fp8_f32(hv.z, hv.w, w8, true); *(unsigned*)(H2 + row * DM + k) = (unsigned)w8; } }
#pragma unroll
            for (int i = 0; i < 4; ++i) { const int e = (tid >> 5) + 16 * i, kc = (tid & 31) * 16; *(LAS u32x4*)(Whi + e * RS + kc) = wnh[i]; *(LAS u32x4*)(Wlo + e * RS + kc) = wnl[i]; }
            __syncthreads();
            if (c < 3) { P7_LOADX(c + 1); }
#pragma unroll
            for (int ks = 0; ks < 8; ++ks) {
                const bf16x8 ah = *(const LAS bf16x8*)(Hhi + (16 * rt + n) * RS + 64 * ks + 16 * g), al = *(const LAS bf16x8*)(Hlo + (16 * rt + n) * RS + 64 * ks + 16 * g);
                const bf16x8 b0h = *(const LAS bf16x8*)(Whi + (16 * et + n) * RS + 64 * ks + 16 * g), b0l = *(const LAS bf16x8*)(Wlo + (16 * et + n) * RS + 64 * ks + 16 * g);
                const bf16x8 b1h = *(const LAS bf16x8*)(Whi + (16 * et + 16 + n) * RS + 64 * ks + 16 * g), b1l = *(const LAS bf16x8*)(Wlo + (16 * et + 16 + n) * RS + 64 * ks + 16 * g);
                acc0 = __builtin_amdgcn_mfma_f32_16x16x32_bf16(al, b0h, acc0, 0, 0, 0); acc1 = __builtin_amdgcn_mfma_f32_16x16x32_bf16(al, b1h, acc1, 0, 0, 0);
                acc0 = __builtin_amdgcn_mfma_f32_16x16x32_bf16(ah, b0l, acc0, 0, 0, 0); acc1 = __builtin_amdgcn_mfma_f32_16x16x32_bf16(ah, b1l, acc1, 0, 0, 0);
                acc0 = __builtin_amdgcn_mfma_f32_16x16x32_bf16(ah, b0h, acc0, 0, 0, 0); acc1 = __builtin_amdgcn_mfma_f32_16x16x32_bf16(ah, b1h, acc1, 0, 0, 0);
                if (ks & 1) asm volatile("" ::: "memory");
            }
            __syncthreads();
        }
#undef P7_LOADX
#pragma unroll
        for (int reg = 0; reg < 4; ++reg) { const int r = rt * 16 + 4 * g + reg; Ls[r * LS + et * 16 + n] = acc0[reg]; Ls[r * LS + et * 16 + 16 + n] = acc1[reg]; }
        if (tid < 128) hist[tid] = 0;
        __syncthreads();
        TS_END(11);
        {
            const int tid = opaque_tid(), lane = tid & 63;
            const int r = tid >> 3, q = tid & 7;
            float s[8], sel[8];
#pragma unroll
            for (int i = 0; i < 8; ++i) { s[i] = sigmoidf_(Ls[r * LS + q * 8 + i]); sel[i] = s[i] + inp(I_RB)[q * 8 + i]; }
            float m1 = -INFINITY, m2 = -INFINITY;
#pragma unroll
            for (int i = 0; i < 8; ++i) { const float v = sel[i]; if (v > m1) { m2 = m1; m1 = v; } else if (v > m2) m2 = v; }
            const float gs = m1 + m2;
            int rank = 0;
#pragma unroll
            for (int j = 0; j < 8; ++j) { const float o = __shfl(gs, (lane & ~7) + j); rank += ((o > gs) || (o == gs && j < q)) ? 1 : 0; }
            const bool gsel = rank < 4;
            const unsigned long long bal = __ballot(gsel); const unsigned gm = (unsigned)(bal >> (lane & ~7)) & 0xffu;
            const int slot = __builtin_popcount(gm & ((1u << q) - 1u));
            if (gsel) {
#pragma unroll
                for (int i = 0; i < 8; ++i) { CandS[r * 32 + slot * 8 + i] = sel[i]; CandI[r * 32 + slot * 8 + i] = q * 8 + i; } }
            __syncthreads();
            int cn[8];
#pragma unroll
            for (int i = 0; i < 8; ++i) cn[i] = 0;
            for (int j = 0; j < 32; ++j) { const float o = CandS[r * 32 + j]; const int oi = CandI[r * 32 + j];
#pragma unroll
                for (int i = 0; i < 8; ++i) cn[i] += ((o > sel[i]) || (o == sel[i] && oi < q * 8 + i)) ? 1 : 0; }
            float part = 0.f;
#pragma unroll
            for (int i = 0; i < 8; ++i) if (gsel && cn[i] < 8) part += s[i];
            part = red8(part);
            const float inv = 2.5f / part;
            TS_END(12);
            int lp[8];
#pragma unroll
            for (int i = 0; i < 8; ++i) { lp[i] = -1; if (emit && gsel && cn[i] < 8) lp[i] = atomicAdd((int*)(hist + q * 8 + i), 1); }
            __syncthreads();
            if (emit && tid < 64) hist[64 + tid] = (int)__hip_atomic_fetch_add(gcnt + tid, (unsigned)hist[tid], RLX_AGENT);
            __syncthreads();
#pragma unroll
            for (int i = 0; i < 8; ++i) if (lp[i] >= 0) { const int e = q * 8 + i; const size_t li = (size_t)e * T + hist[64 + e] + lp[i]; LIST[li] = (row0 + r) * 8 + cn[i]; LISTW[li] = s[i] * inv; }
            __syncthreads();
            TS_END(13);
        }
    }
}

__device__ __forceinline__ void p9_combine(Frame& F) {
    const int tid = opaque_tid();
    const float* MOD = (const float*)(F.ws + WS_MOD); const unsigned char* SLOT = F.ws + WS_SLOT; const unsigned char* SH = F.ws + WS_SH; float* out = F.out; const float* X = inp(I_X); const bf16_t* Y = (const bf16_t*)(F.ws + WS_Y);
#ifdef PROBE_SEL
#ifndef PROBE_DIV
#define PROBE_DIV 100000.0f
#endif
#ifndef PROBE_Q
#define PROBE_Q 1000
#endif
    const float pscale_ = 1.0f + (float)((__hip_atomic_load(&g_ts[PROBE_SEL], __ATOMIC_RELAXED, __HIP_MEMORY_SCOPE_AGENT) + PROBE_Q / 2) / PROBE_Q * PROBE_Q) / PROBE_DIV;
#endif
    for (size_t it = (size_t)F.blk * 512 + tid; it < (size_t)T * 64; it += (size_t)F.G * 512) {
        const size_t t = it >> 6; const int c0 = (int)(it & 63) * 16; const int b = (int)(t / SEQ);
        u32x4 sl[8];
#pragma unroll
        for (int k = 0; k < 8; ++k) sl[k] = *(const u32x4*)(SLOT + (t * 8 + k) * 1024 + c0);
        const u32x4 s8 = *(const u32x4*)(SH + t * 1024 + c0);
        f32x4 xv[4], gv[4];
#pragma unroll
        for (int i = 0; i < 4; ++i) { xv[i] = *(const f32x4*)(X + t * 1024 + c0 + 4 * i); gv[i] = *(const f32x4*)(MOD + b * 6144 + 5 * 1024 + c0 + 4 * i); }
        { const u32x4 y0 = *(const u32x4*)(Y + t * 1024 + c0), y1 = *(const u32x4*)(Y + t * 1024 + c0 + 8);
#pragma unroll
          for (int i = 0; i < 4; ++i) { const f32x4 g1 = *(const f32x4*)(MOD + b * 6144 + 2048 + c0 + 4 * i); const unsigned w0 = i < 2 ? y0[2 * i] : y1[2 * i - 4], w1 = i < 2 ? y0[2 * i + 1] : y1[2 * i - 3];
            xv[i].x += g1.x * bflo(w0); xv[i].y += g1.y * bfhi(w0); xv[i].z += g1.z * bflo(w1); xv[i].w += g1.w * bfhi(w1); } }
        float acc[16];
#pragma unroll
        for (int i = 0; i < 4; ++i) { const f32x2 lo = __builtin_amdgcn_cvt_pk_f32_fp8((int)s8[i], false), hi = __builtin_amdgcn_cvt_pk_f32_fp8((int)s8[i], true); acc[4 * i] = lo.x; acc[4 * i + 1] = lo.y; acc[4 * i + 2] = hi.x; acc[4 * i + 3] = hi.y; }
#pragma unroll
        for (int k = 0; k < 8; ++k)
#pragma unroll
            for (int i = 0; i < 4; ++i) { const f32x2 lo = __builtin_amdgcn_cvt_pk_f32_fp8((int)sl[k][i], false), hi = __builtin_amdgcn_cvt_pk_f32_fp8((int)sl[k][i], true);
                acc[4 * i] += lo.x; acc[4 * i + 1] += lo.y; acc[4 * i + 2] += hi.x; acc[4 * i + 3] += hi.y; }
#pragma unroll
        for (int i = 0; i < 4; ++i) { f32x4 o; o.x = xv[i].x + gv[i].x * acc[4 * i]; o.y = xv[i].y + gv[i].y * acc[4 * i + 1]; o.z = xv[i].z + gv[i].z * acc[4 * i + 2]; o.w = xv[i].w + gv[i].w * acc[4 * i + 3];
#ifdef PROBE_SEL
            o = o * pscale_;
#endif
            *(f32x4*)(out + t * 1024 + c0 + 4 * i) = o; }
    }
}

struct Args { const float* in[24]; float* out; unsigned char* ws; };
__global__ void __launch_bounds__(512, 2) mega_fwd(Args args) {
    extern __shared__ __attribute__((aligned(16))) unsigned char lds_raw[];
    Frame F;
    F.lds = (LAS unsigned char*)lds_raw;
    F.G = gridDim.x; F.blk = blockIdx.x;
    F.out = args.out; F.ws = args.ws; F.ob = (unsigned char*)args.out;
    volatile LAS unsigned* MISC = (volatile LAS unsigned*)(F.lds + MISC_OFF);
    for (int u = threadIdx.x; u < 64; u += 512) MISC[u] = 0u;
    __syncthreads();
    XcdBarrier bar = xcd_barrier_post((unsigned*)(F.ws + WS_CTL) + CW_BAR, MISC + 8);
#ifdef PROBE_SEL
    int tsi_ = 0;
    volatile LAS unsigned long long* const tsl_ = (volatile LAS unsigned long long*)(F.lds + MISC_OFF + 72);
    if (blockIdx.x == PROBE_BLK && threadIdx.x == 0) { for (int k = 0; k < 64; ++k) g_ts[k] = 0; *tsl_ = __builtin_amdgcn_s_memrealtime(); }
#define GRID_BAR() do { xcd_barrier(bar); if (blockIdx.x == PROBE_BLK && threadIdx.x == 0) { const unsigned long long t_ = __builtin_amdgcn_s_memrealtime(); g_ts[32 + tsi_] += t_ - *tsl_; *tsl_ = t_; } ++tsi_; } while (0)
#else
#define GRID_BAR() xcd_barrier(bar)
#endif
    unsigned char* ws = F.ws;
    const float* MOD = (const float*)(ws + WS_MOD);

#ifndef DUPMASK
#define DUPMASK 0
#endif
#define REP(k) _Pragma("unroll 1") for (int rep_ = 0; rep_ < (((DUPMASK) >> (k)) & 1 ? 2 : 1); ++rep_)
    REP(0) { p0_mod(F); }
    GRID_BAR();
    REP(1) { p1_norm(F); }
    __syncthreads();
    p0_weights(F);
    p1_router_split(F);
    GRID_BAR();
    REP(2) { pg8::DenseOrder S; S.init(T, NPROJ, 1024, F.G, F.blk, ws + WS_H, ws + WS_WIN);
      EpiProj E{ws, (bf16_t*)(F.ob + OUT_GZ)};
      pg8::gemm_phase<EpiProj, pg8::DenseOrder, true, false>(F.lds, 1024, S, E); }
    { const int rem_ = ((T / 256) * (NPROJ / 256)) % F.G; REP(12) { if (rem_ == 0) convert_experts(F, 0, F.G, 1); else convert_experts(F, rem_, F.G - rem_, 1); } }
    GRID_BAR();
    REP(3) { p3_attn(F); }
    GRID_BAR();
    REP(4) { p3b_gdn_prep(F); }
    GRID_BAR();
    { LAS unsigned char* const lds = F.lds; (void)lds; TS_BEGIN(); }
    REP(6) { p4_gdn_scan(F); }
    { LAS unsigned char* const lds = F.lds; (void)lds; if (F.blk < 64) { TS_END(24); } }
    REP(5) { p3_merge(F, 64, F.G - 64); }
    REP(12) { convert_experts(F, 64, F.G - 64, 0); }
    GRID_BAR();
    REP(7) {
    { pg8::DenseOrder S; S.init(T, 1024, 1024, F.G, F.blk, ws + WS_YA, ws + WS_WUPG); EpiStore E{(bf16_t*)(ws + WS_UA), 1024};
      pg8::gemm_phase<EpiStore, pg8::DenseOrder, true, false>(F.lds, 1024, S, E); }
    { pg8::DenseOrder S; S.init(T, 1024, 512, F.G, F.blk, ws + WS_YB, ws + WS_WUPD); EpiStore E{(bf16_t*)(ws + WS_UB), 1024};
      pg8::gemm_phase<EpiStore, pg8::DenseOrder, true, false>(F.lds, 512, S, E); }
    }
    REP(8) { pg8::LocalGateOrder S; S.init(T, 1024, F.G, F.blk, ws + WS_H, ws + WS_WG); EpiGate E{(const bf16_t*)(ws + WS_UA), (const bf16_t*)(ws + WS_UB), (bf16_t*)(ws + WS_MG)};
      pg8::gemm_phase<EpiGate, pg8::LocalGateOrder, true, false>(F.lds, 1024, S, E); }
    GRID_BAR();
    REP(9) { pg8::DenseOrder S; S.init(T, 1024, 1024, F.G, F.blk, ws + WS_MG, ws + WS_WOUT); EpiStore E{(bf16_t*)(ws + WS_Y), 1024};
      pg8::gemm_phase<EpiStore, pg8::DenseOrder, true, false>(F.lds, 1024, S, E); }
    GRID_BAR();
    if ((DUPMASK >> 13) & 1) p7_route(F, false);
    p7_route(F, true);
    GRID_BAR();
    REP(10) { MoeTab tb = build_moetab(F);
      G1Order S{tb, F.G, F.blk, (const int*)(ws + WS_LIST), (const char*)(ws + WS_H), (const char*)(ws + WS_WGU), (const char*)(ws + WS_WSGU)};
      LAS int* tokb = (LAS int*)(F.lds + INFO_OFF); LAS float* wkb = (LAS float*)(F.lds + INFO_OFF + 6144);
      S.preload(tokb, wkb, (const float*)(ws + WS_LISTW));
      EpiAct E{tb, wkb, ws + WS_ACT, ws + WS_ACTS};
      pg8::gemm_phase<EpiAct, G1Order, true, true, true>(F.lds, 512, S, E, tokb); }
    GRID_BAR();
#ifndef P8B_REPS
#define P8B_REPS 1
#endif
#ifndef P8B_XMODE
#define P8B_XMODE 0
#endif
    for (int r8_ = 0; r8_ < P8B_REPS; ++r8_) { REP(11) { MoeTab tb = build_moetab(F); p8b_down(F, tb, r8_ < P8B_REPS - 1 ? P8B_XMODE : 0); }
    GRID_BAR(); }
    if ((DUPMASK >> 14) & 1) { for (int r_ = 0; r_ < 13; ++r_) GRID_BAR(); }
#ifdef PROBE_SEL
    { __threadfence(); }
#endif
    p9_combine(F);
#undef REP
#undef GRID_BAR
}

extern "C" void kernel_launch(void* const* d_in, const int* in_sizes, int n_in, void* d_out, int out_size, void* d_ws, size_t ws_size, hipStream_t stream) {
    static int grid = 0;
    if (grid == 0) {
        if (n_in != 24 || out_size != T * DM || ws_size < WS_END) { fprintf(stderr, "kernel_launch: unexpected shapes / workspace (n_in %d out %d ws %zu, need %zu)\n", n_in, out_size, ws_size, (size_t)WS_END); grid = -1; return; }
        int dev = 0, cus = 0;
        if (hipGetDevice(&dev) != hipSuccess || hipDeviceGetAttribute(&cus, hipDeviceAttributeMultiprocessorCount, dev) != hipSuccess) { grid = -1; return; }
        if (hipFuncSetAttribute((const void*)mega_fwd, hipFuncAttributeMaxDynamicSharedMemorySize, LDS_BYTES) != hipSuccess) { fprintf(stderr, "kernel_launch: hipFuncSetAttribute failed\n"); grid = -1; return; }
        int per_cu = 0;
        if (hipOccupancyMaxActiveBlocksPerMultiprocessor(&per_cu, (const void*)mega_fwd, 512, LDS_BYTES) != hipSuccess || per_cu < 1) fprintf(stderr, "kernel_launch: occupancy query reports %d blocks per CU\n", per_cu);
        (void)hipGetLastError();
        grid = cus;
    }
    if (grid < 0) return;
    if (hipMemsetAsync((char*)d_ws + WS_CTL, 0, CTL_ZERO_BYTES, stream) != hipSuccess) return;
    Args a{};
    for (int i = 0; i < 24; ++i) a.in[i] = (const float*)d_in[i];
    a.out = (float*)d_out; a.ws = (unsigned char*)d_ws;
    hipLaunchKernelGGL(mega_fwd, dim3(grid), dim3(512), LDS_BYTES, stream, a);
}
```

```cpp
#include <hip/hip_runtime.h>
#include <cstdio>
#include <cstdint>

#define LAS __attribute__((address_space(3)))
#define GAS __attribute__((address_space(1)))
typedef unsigned short bf16_t;
typedef short bf16x8 __attribute__((ext_vector_type(8)));
typedef float f32x2 __attribute__((ext_vector_type(2)));
typedef float f32x4 __attribute__((ext_vector_type(4)));
typedef unsigned u32x2 __attribute__((ext_vector_type(2)));
typedef long i64x2 __attribute__((ext_vector_type(2)));
typedef unsigned u32x4 __attribute__((ext_vector_type(4)));

#ifdef PROBE_SEL
#ifndef PROBE_BLK
#define PROBE_BLK 0
#endif
__device__ unsigned long long g_ts[64];
#define TS_SLOT(ldsbase) ((volatile __attribute__((address_space(3))) unsigned*)((ldsbase) + 143424))
#define TS_DECL
#define TS_BEGIN() do { if (blockIdx.x == PROBE_BLK && threadIdx.x == 0) *TS_SLOT(lds) = (unsigned)__builtin_amdgcn_s_memrealtime(); } while (0)
#define TS_END(k) do { if (blockIdx.x == PROBE_BLK && threadIdx.x == 0) { const unsigned t1_ = (unsigned)__builtin_amdgcn_s_memrealtime(); g_ts[k] += (unsigned long long)(t1_ - *TS_SLOT(lds)); *TS_SLOT(lds) = t1_; } } while (0)
#else
#define TS_DECL
#define TS_BEGIN() do {} while (0)
#define TS_END(k) do {} while (0)
#endif

constexpr int BATCH = 8, SEQ = 2048, DM = 1024, T = BATCH * SEQ;
constexpr int IN_W = 10768;
constexpr int NPROJ = 8704;
constexpr int NEXP = 64, DEXP = 256;
constexpr float EPS = 1e-6f;

__device__ __forceinline__ unsigned f2bf(float f) { unsigned u = __builtin_bit_cast(unsigned, f); return (u + 0x7fffu + ((u >> 16) & 1u)) >> 16; }
typedef __bf16 bf16x2_t __attribute__((ext_vector_type(2)));
__device__ __forceinline__ unsigned pk2(float lo, float hi) { const f32x2 v = {lo, hi}; const bf16x2_t b = __builtin_convertvector(v, bf16x2_t); return __builtin_bit_cast(unsigned, b); }
__device__ __forceinline__ float bf2f(unsigned h) { return __builtin_bit_cast(float, h << 16); }
__device__ __forceinline__ float bflo(unsigned w) { return __builtin_bit_cast(float, w << 16); }
__device__ __forceinline__ float bfhi(unsigned w) { return __builtin_bit_cast(float, w & 0xffff0000u); }
__device__ __forceinline__ float sigmoidf_(float x) { return __builtin_amdgcn_rcpf(1.0f + __builtin_amdgcn_exp2f(-1.4426950408889634f * x)); }
__device__ __forceinline__ float siluf_(float x) { return x * __builtin_amdgcn_rcpf(1.0f + __builtin_amdgcn_exp2f(-1.4426950408889634f * x)); }
__device__ __forceinline__ int opaque_tid() { int t = threadIdx.x; asm volatile("" : "+v"(t)); return t; }
template <int CTRL> __device__ __forceinline__ float dppf(float v) { return __builtin_bit_cast(float, __builtin_amdgcn_update_dpp(0, __builtin_bit_cast(int, v), CTRL, 0xF, 0xF, true)); }
__device__ __forceinline__ float red4(float v) { v += dppf<0xB1>(v); v += dppf<0x4E>(v); return v; }
__device__ __forceinline__ float red8(float v) { v = red4(v); v += dppf<0x141>(v); return v; }
__device__ __forceinline__ float red16(float v) { v = red8(v); v += dppf<0x140>(v); return v; }
__device__ __forceinline__ float wave_sum(float v) { v = red16(v); v += __shfl_xor(v, 16); v += __shfl_xor(v, 32); return v; }

typedef int i32x8 __attribute__((ext_vector_type(8)));
__device__ __forceinline__ f32x4 mfma_fp8_k128(bf16x8 a0, bf16x8 a1, bf16x8 b0, bf16x8 b1, f32x4 c) {
    const u32x4 x0 = __builtin_bit_cast(u32x4, a0), x1 = __builtin_bit_cast(u32x4, a1), y0 = __builtin_bit_cast(u32x4, b0), y1 = __builtin_bit_cast(u32x4, b1);
    const i32x8 a = {(int)x0.x, (int)x0.y, (int)x0.z, (int)x0.w, (int)x1.x, (int)x1.y, (int)x1.z, (int)x1.w}, b = {(int)y0.x, (int)y0.y, (int)y0.z, (int)y0.w, (int)y1.x, (int)y1.y, (int)y1.z, (int)y1.w};
    return __builtin_amdgcn_mfma_scale_f32_16x16x128_f8f6f4(a, b, c, 0, 0, 0, 0x7F7F7F7F, 0, 0x7F7F7F7F);
}
namespace pg8 {
#define PG8_LAS __attribute__((address_space(3)))
constexpr int BM = 256, BK = 64, HALF = 128, HTB = HALF * BK * 2, STAGE_BYTES = 8 * HTB, NXCD = 8, WGM = 8;

__host__ __device__ __forceinline__ int lds_byte(int r, int c) { const int st = (r >> 4) * 2 + (c >> 5), rr = r & 15, cc = c & 31, ob = rr * 64 + cc * 2; return st * 1024 + (ob ^ (((ob >> 9) & 1) << 5)); }
__host__ __device__ __forceinline__ void stage_rc(int b, int& R, int& C) { const int st = b / 1024, sb = b % 1024, swz = sb ^ (((sb >> 9) & 1) << 5); R = (st >> 1) * 16 + swz / 64; C = (st & 1) * 32 + (swz % 64) / 2; }
__host__ __device__ __forceinline__ int perm32(int rho) { const int n = rho >> 4, i = rho & 15; return 8 * (i >> 2) + 4 * n + (i & 3); }

struct Unit { int pm, pn; const char* Ap; const char* Bp; int e, mt; };

struct DenseOrder {
    int nM, nN, nwg, G, c; const char* A; const char* Bt; size_t tstep;
    __device__ __forceinline__ void init(int M, int N, int K, int G_, int c_, const void* A_, const void* Bt_) { nM = M / BM; nN = N / BM; nwg = nM * nN; G = G_; c = c_; A = (const char*)A_; Bt = (const char*)Bt_; tstep = (size_t)BM * K * 2; }
    __device__ __forceinline__ bool next(int i, Unit& u) const {
        const long L = (long)i * G + c; if (L >= nwg) return false;
        int wgid = (int)L; { const int q = nwg / NXCD, r = nwg % NXCD, xcd = wgid % NXCD, off = wgid / NXCD; wgid = (xcd < r ? xcd * (q + 1) : r * (q + 1) + (xcd - r) * q) + off; }
        const int nig = WGM * nN, gid = wgid / nig, fm = gid * WGM, gsz = (nM - fm) < WGM ? (nM - fm) : WGM;
        u.pm = fm + ((wgid % nig) % gsz); u.pn = (wgid % nig) / gsz; u.Ap = A + (size_t)u.pm * tstep; u.Bp = Bt + (size_t)u.pn * tstep; u.e = 0; u.mt = 0; return true;
    }
    __device__ __forceinline__ unsigned a_off(const Unit&, int r, int K) const { return (unsigned)(r * K) * 2u; }
};

struct LocalGateOrder {
    DenseOrder D; const char* A; const char* Bt; size_t tstep;
    __device__ __forceinline__ void init(int M, int K, int G_, int c_, const void* A_, const void* Bt_) { D.init(M, 1024, K, G_, c_, A_, Bt_); A = (const char*)A_; Bt = (const char*)Bt_; tstep = (size_t)BM * K * 2; }
    __device__ __forceinline__ bool next(int i, Unit& u) const {
        Unit t; if (!D.next(i >> 1, t)) return false;
        u.pm = t.pm; u.pn = 2 * t.pn + (i & 1); u.Ap = A + (size_t)u.pm * tstep; u.Bp = Bt + (size_t)u.pn * tstep; u.e = 0; u.mt = 0; return true;
    }
    __device__ __forceinline__ unsigned a_off(const Unit&, int r, int K) const { return (unsigned)(r * K) * 2u; }
};

__device__ __forceinline__ unsigned cvt_pk_bf16(float lo, float hi) { unsigned r; asm volatile("v_cvt_pk_bf16_f32 %0, %1, %2" : "=v"(r) : "v"(lo), "v"(hi)); return r; }

template <class Epi, class Sched, bool ALIGN_EPI, bool GATHER, bool FP8 = false>
__device__ __forceinline__ void gemm_phase(PG8_LAS unsigned char* lds, const int K, const Sched& S, const Epi& E, PG8_LAS int* tokb = nullptr) {
    const int tid = opaque_tid(), wid = __builtin_amdgcn_readfirstlane(tid >> 6), lane = tid & 63, wr = wid >> 2, wc = wid & 3, fr = lane & 15, fq = lane >> 4;
    const int nt = K / BK;
    unsigned voffB[2];
#pragma unroll
    for (int i = 0; i < 2; ++i) { int R, C; stage_rc(tid * 16 + i * 8192, R, C); const int Rb = Epi::PERM ? ((R & ~31) + perm32(R & 31)) : R;
        voffB[i] = (unsigned)(Rb * K + C) * 2u; }
    const size_t kstep = (size_t)(BK * 2);
    const size_t hstep = (size_t)HALF * K * 2;
    const unsigned ldsw = (unsigned)wid * 1024u;
    const int aoff = lds_byte(wr * 64 + fr, fq * 8), boff = lds_byte(wc * 32 + fr, fq * 8);
#define PG8_SA(b, h) (((b) * 2 + (h)) * HTB)
#define PG8_SB(b, h) ((4 + (b) * 2 + (h)) * HTB)
#define PG8_GLDS(gptr, bufoff, i_) __builtin_amdgcn_global_load_lds((const unsigned*)(gptr), (PG8_LAS unsigned*)(lds + (bufoff) + ldsw + (i_) * 8192), 16, 0, 0)
#define PG8_STAGE_B(bufoff, gbase) do { _Pragma("unroll") for (int _i = 0; _i < 2; ++_i) PG8_GLDS((const char*)(gbase) + voffB[_i], bufoff, _i); } while (0)
#define PG8_STAGE_A(bufoff, gbase, h) do { _Pragma("unroll") for (int _i = 0; _i < 2; ++_i) PG8_GLDS((const char*)(gbase) + vAc[h][_i], bufoff, _i); } while (0)
#define PG8_STAGE_A2(bufoff, gbase, h) PG8_STAGE_A(bufoff, gbase, h)
#define PG8_NEXT_A() do { const int _t = opaque_tid(); const PG8_LAS int* _tb = tokb + (ui + 1) * 256; _Pragma("unroll") for (int _i = 0; _i < 2; ++_i) { int _R, _C; stage_rc(_t * 16 + _i * 8192, _R, _C); \
        _Pragma("unroll") for (int _h = 0; _h < 2; ++_h) vAc[_h][_i] = (unsigned)(_tb[_h * 128 + _R] * K + _C) * 2u; } } while (0)
#define PG8_CALC_A(u, v) do { const int _t = opaque_tid(); _Pragma("unroll") for (int _i = 0; _i < 2; ++_i) { int _R, _C; stage_rc(_t * 16 + _i * 8192, _R, _C); _Pragma("unroll") for (int _h = 0; _h < 2; ++_h) v[_h][_i] = (GATHER ? (unsigned)(tokb[_h * 128 + _R] * K) * 2u : S.a_off(u, _h * 128 + _R, K)) + (unsigned)_C * 2u; } } while (0)
#define PG8_LDA(dst, b, h) do { _Pragma("unroll") for (int m = 0; m < 4; ++m) _Pragma("unroll") for (int k = 0; k < 2; ++k) dst[m][k] = *(const PG8_LAS bf16x8*)(lds + PG8_SA(b, h) + aoff + m * 2048 + k * 1024); } while (0)
#define PG8_LDB(dst, b, h) do { _Pragma("unroll") for (int n = 0; n < 2; ++n) _Pragma("unroll") for (int k = 0; k < 2; ++k) dst[n][k] = *(const PG8_LAS bf16x8*)(lds + PG8_SB(b, h) + boff + n * 2048 + k * 1024); } while (0)
#define PG8_MMA(ai, bj, At, Bt) do { __builtin_amdgcn_s_setprio(1); _Pragma("unroll") for (int m = 0; m < 4; ++m) _Pragma("unroll") for (int n = 0; n < 2; ++n) _Pragma("unroll") for (int k = 0; k < 2; ++k) { \
        if (FP8) { if (k == 0) acc[ai][bj][m][n] = mfma_fp8_k128(Bt[n][0], Bt[n][1], At[m][0], At[m][1], acc[ai][bj][m][n]); } \
        else acc[ai][bj][m][n] = __builtin_amdgcn_mfma_f32_16x16x32_bf16(Bt[n][k], At[m][k], acc[ai][bj][m][n], 0, 0, 0); } __builtin_amdgcn_s_setprio(0); } while (0)
#define PG8_WAIT_V(n) asm volatile("s_waitcnt vmcnt(" #n ")" ::: "memory")
#define PG8_WAIT_L(n) asm volatile("s_waitcnt lgkmcnt(" #n ")" ::: "memory")
#define PG8_BAR __builtin_amdgcn_s_barrier()
#define PG8_SCHED __builtin_amdgcn_sched_barrier(0)
    Unit cur, nxt; int ui = 0;
    if (!S.next(0, cur)) return;
    f32x4 acc[2][2][4][2];
#pragma unroll
    for (int a = 0; a < 2; ++a)
#pragma unroll
        for (int b = 0; b < 2; ++b)
#pragma unroll
            for (int m = 0; m < 4; ++m)
#pragma unroll
                for (int n = 0; n < 2; ++n) acc[a][b][m][n] = (f32x4){0.f, 0.f, 0.f, 0.f};
    bf16x8 At[4][2], B0[2][2], B1[2][2];
    unsigned vAc[2][2];
    PG8_CALC_A(cur, vAc);
    const char* cA = cur.Ap; const char* cB = cur.Bp;
    PG8_STAGE_B(PG8_SB(0, 0), cB); PG8_STAGE_B(PG8_SB(0, 1), cB + hstep); PG8_STAGE_A(PG8_SA(0, 0), cA, 0); PG8_STAGE_A(PG8_SA(0, 1), cA, 1);
    if (wr == 1) PG8_BAR;
    PG8_WAIT_V(2); PG8_BAR;
    PG8_STAGE_B(PG8_SB(1, 0), cB + kstep); PG8_STAGE_A(PG8_SA(1, 0), cA + kstep, 0); PG8_STAGE_B(PG8_SB(1, 1), cB + hstep + kstep);
    PG8_WAIT_V(6); PG8_BAR;
    TS_DECL; TS_BEGIN();
    for (;;) {
        const bool has_next = S.next(ui + 1, nxt);
        TS_END(22);
        const char* nA = has_next ? nxt.Ap : cA; const char* nB = has_next ? nxt.Bp : cB;
#pragma unroll 1
        for (int t = 0; t < nt; t += 2) {
            const bool last = (t == nt - 2);
            const char* a1 = cA + (size_t)(t + 1) * kstep;
            const char* a2 = last ? nA : cA + (size_t)(t + 2) * kstep; const char* b2 = last ? nB : cB + (size_t)(t + 2) * kstep;
            const char* a3 = a2 + kstep; const char* b3 = b2 + kstep;
            PG8_LDB(B0, 0, 0); PG8_LDB(B1, 0, 1); PG8_SCHED; PG8_LDA(At, 0, 0); PG8_STAGE_A(PG8_SA(1, 1), a1, 1);
            if constexpr (GATHER) { if (last && has_next) { PG8_NEXT_A(); } }
            PG8_WAIT_V(8); PG8_WAIT_L(0); PG8_BAR; PG8_MMA(0, 0, At, B0); PG8_MMA(0, 1, At, B1); PG8_BAR; PG8_SCHED;
            PG8_LDA(At, 0, 1); PG8_STAGE_B(PG8_SB(0, 0), b2); PG8_STAGE_B(PG8_SB(0, 1), b2 + hstep); PG8_STAGE_A2(PG8_SA(0, 0), a2, 0);
            PG8_WAIT_V(8); PG8_WAIT_L(0); PG8_BAR; PG8_MMA(1, 0, At, B0); PG8_MMA(1, 1, At, B1); PG8_BAR; PG8_SCHED;
            PG8_LDB(B0, 1, 0); PG8_LDB(B1, 1, 1); PG8_SCHED; PG8_LDA(At, 1, 0); PG8_STAGE_A2(PG8_SA(0, 1), a2, 1);
            PG8_WAIT_V(8); PG8_WAIT_L(0); PG8_BAR; PG8_MMA(0, 0, At, B0); PG8_MMA(0, 1, At, B1); PG8_BAR; PG8_SCHED;
            PG8_LDA(At, 1, 1); PG8_STAGE_B(PG8_SB(1, 0), b3); PG8_STAGE_B(PG8_SB(1, 1), b3 + hstep); PG8_STAGE_A2(PG8_SA(1, 0), a3, 0);
            PG8_WAIT_V(8); PG8_WAIT_L(0); PG8_BAR; PG8_MMA(1, 0, At, B0); PG8_MMA(1, 1, At, B1); PG8_BAR; PG8_SCHED;
        }
        TS_END(20);
        if constexpr (ALIGN_EPI) { if (wr == 0) PG8_BAR; }
        E(acc, cur, ui);
        TS_END(21);
        if (!has_next) break;
#pragma unroll
        for (int a = 0; a < 2; ++a)
#pragma unroll
            for (int b = 0; b < 2; ++b)
#pragma unroll
                for (int m = 0; m < 4; ++m)
#pragma unroll
                    for (int n = 0; n < 2; ++n) acc[a][b][m][n] = (f32x4){0.f, 0.f, 0.f, 0.f};
        cur = nxt; cA = nA; cB = nB; ++ui;
        if constexpr (ALIGN_EPI) { if (wr == 1) PG8_BAR; }
    }
    PG8_WAIT_V(0);
    if constexpr (!ALIGN_EPI) { if (wr == 0) PG8_BAR; }
    PG8_BAR;
#undef PG8_SA
#undef PG8_SB
#undef PG8_GLDS
#undef PG8_STAGE_A
#undef PG8_STAGE_A2
#undef PG8_NEXT_A
#undef PG8_STAGE_B
#undef PG8_CALC_A
#undef PG8_LDA
#undef PG8_LDB
#undef PG8_MMA
#undef PG8_WAIT_V
#undef PG8_WAIT_L
#undef PG8_BAR
#undef PG8_SCHED
}
}

constexpr size_t MiB = 1u << 20;
constexpr size_t WS_CTL = 0, CTL_ZERO_BYTES = 128 * 1024;
constexpr size_t WS_MOD = 1 * MiB;
constexpr size_t WS_BA = 2 * MiB;
constexpr size_t WS_PW = 3 * MiB;
constexpr size_t WS_WIN = 4 * MiB;
constexpr size_t WS_LIST = 4 * MiB;
constexpr size_t WS_LISTW = 8 * MiB;
constexpr size_t WS_WSGU = 12 * MiB;
constexpr size_t WS_WSD = 13 * MiB;
constexpr size_t WS_WG = 21 * MiB;
constexpr size_t WS_WUPG = 25 * MiB, WS_WUPD = 27 * MiB, WS_WOUT = 28 * MiB;
constexpr size_t WS_H = 30 * MiB;
constexpr size_t WS_GQ = 62 * MiB, WS_GK = 94 * MiB, WS_GV = 126 * MiB;
constexpr size_t WS_YA = 62 * MiB;
constexpr size_t WS_Y = 62 * MiB;
constexpr size_t WS_WGU = 94 * MiB;
constexpr size_t WS_DQ = 158 * MiB, WS_DK = 206 * MiB, WS_DV = 254 * MiB;
constexpr size_t WS_UA = 158 * MiB, WS_UB = 190 * MiB, WS_MG = 222 * MiB;
constexpr size_t WS_ACT = 142 * MiB;
constexpr size_t WS_ACTS = 178 * MiB;
constexpr size_t WS_WD = 126 * MiB;
constexpr size_t WS_SLOT = 198 * MiB;
constexpr size_t WS_SH = 182 * MiB;
constexpr size_t WS_END = 334 * MiB;
constexpr size_t OUT_GZ = 0, OUT_YB = 32 * MiB;

constexpr int CW_BAR = 4096;
constexpr int CW_CNT = 16384;

constexpr int RING_BYTES = 131072;
constexpr int MISC_OFF = 143360;
constexpr int INFO_OFF = 131072;
constexpr int LDS_BYTES = 147456;

typedef GAS unsigned gu32;
#define RLX_AGENT __ATOMIC_RELAXED, __HIP_MEMORY_SCOPE_AGENT

#define XB_TMO      128
#define XB_XCNT(j)  (256  + 64 * (j))
#define XB_XSUB(j)  (1280 + 64 * (j))
#define XB_XGEN(j)  (2304 + 64 * (j))
#define XB_TOP      3328
#define XB_TOPGEN   3392
#define XCD_BAR_WORDS 3456
#define XB_SPIN_CAP (1u << 22)
__device__ __forceinline__ unsigned xb_ld(unsigned* p)              { return __hip_atomic_load(p, __ATOMIC_RELAXED, __HIP_MEMORY_SCOPE_AGENT); }
__device__ __forceinline__ unsigned xb_add(unsigned* p, unsigned v) { return __hip_atomic_fetch_add(p, v, __ATOMIC_RELAXED, __HIP_MEMORY_SCOPE_AGENT); }
__device__ __forceinline__ unsigned xb_xcc_id() { return (unsigned)__builtin_amdgcn_s_getreg((3 << 11) | 20) & 0xFu; }
#define XB_SPIN(cond, bar) do { unsigned _sp = 0; while (cond) { __builtin_amdgcn_s_sleep(1); \
    if ((++_sp & 255u) == 0u) { if (xb_ld(&(bar)[XB_TMO])) break; if (_sp > XB_SPIN_CAP) { atomicAdd(&(bar)[XB_TMO], 1u); break; } } } } while (0)
struct XcdBarrier { unsigned* bar; unsigned x; volatile LAS unsigned* st; };
__device__ __forceinline__ XcdBarrier xcd_barrier_post(unsigned* bar, volatile LAS unsigned* st) {
    XcdBarrier b; b.bar = bar; b.x = xb_xcc_id(); b.st = st;
    if (threadIdx.x == 0) (void)xb_add(&bar[XB_XCNT(b.x)], 1u);
    return b;
}
__device__ __forceinline__ void xcd_barrier_complete(unsigned* bar, unsigned x, unsigned& nloc, unsigned& nx) {
    const unsigned G = gridDim.x * gridDim.y * gridDim.z;
    unsigned sum, cnt, mine, sp = 0u;
    for (;;) {
        sum = 0u; cnt = 0u; mine = 0u;
#pragma unroll
        for (unsigned j = 0; j < 16; ++j) { const unsigned c = xb_ld(&bar[XB_XCNT(j)]); sum += c; cnt += (c > 0u) ? 1u : 0u; mine = (j == x) ? c : mine; }
        if (sum == G) break;
        __builtin_amdgcn_s_sleep(1);
        if ((++sp & 255u) == 0u) { if (xb_ld(&bar[XB_TMO])) break; if (sp > XB_SPIN_CAP) { atomicAdd(&bar[XB_TMO], 1u); break; } }
    }
    nloc = mine > 0u ? mine : 1u; nx = cnt > 0u ? cnt : 1u;
}
__device__ __forceinline__ void xcd_barrier(const XcdBarrier& b) {
    asm volatile("s_waitcnt vmcnt(0)" ::: "memory");
    __syncthreads();
    if (threadIdx.x == 0) {
        unsigned* bar = b.bar;
        __builtin_amdgcn_s_waitcnt(0);
        unsigned nloc = b.st[0], nx = b.st[1];
        if (nloc == 0u) { xcd_barrier_complete(bar, b.x, nloc, nx); b.st[0] = nloc; b.st[1] = nx; }
        const unsigned old = xb_add(&bar[XB_XSUB(b.x)], 1u);
        const unsigned gen = old / nloc;
        if (old + 1u == (gen + 1u) * nloc) {
            __builtin_amdgcn_fence(__ATOMIC_RELEASE, "agent");
            asm volatile("s_waitcnt vmcnt(0)" ::: "memory");
            const unsigned og = xb_add(&bar[XB_TOP], 1u);
            const unsigned tg = og / nx;
            if (og + 1u == (tg + 1u) * nx) xb_add(&bar[XB_TOPGEN], 1u);
            else XB_SPIN(xb_ld(&bar[XB_TOPGEN]) == tg, bar);
            __builtin_amdgcn_fence(__ATOMIC_ACQUIRE, "agent");
            xb_add(&bar[XB_XGEN(b.x)], 1u);
            asm volatile("s_waitcnt vmcnt(0)" ::: "memory");
        } else {
            XB_SPIN(xb_ld(&bar[XB_XGEN(b.x)]) == gen, bar);
            __builtin_amdgcn_fence(__ATOMIC_ACQUIRE, "agent");
            asm volatile("s_waitcnt vmcnt(0)" ::: "memory");
        }
    }
    __syncthreads();
}

struct Frame {
    LAS unsigned char* lds;
    int G, blk;
    float* out; unsigned char* ws; unsigned char* ob;
};
enum { I_X = 0, I_C, I_WADA, I_BADA, I_GMIX, I_WIN, I_CONVW, I_ALOG, I_DTB, I_GNG, I_QNG, I_KNG, I_WUPG, I_WUPD, I_WOUT, I_GFFN, I_WR, I_RB, I_WEG, I_WEU, I_WED, I_WSG, I_WSU, I_WSD };
__device__ __forceinline__ const float* inp(int i) { return ((const float* const __attribute__((address_space(4)))*)__builtin_amdgcn_kernarg_segment_ptr())[i]; }

__device__ __forceinline__ void transpose_item(const float* W, int ldn, int n0s, int k0, bf16_t* WT, int dK, int drow0, LAS float* scr, int lane) {
#pragma unroll 8
    for (int i = 0; i < 32; ++i) { const int kk = 2 * i + (lane >> 5); scr[kk * 33 + (lane & 31)] = W[(size_t)(k0 + kk) * ldn + n0s + (lane & 31)]; }
    asm volatile("s_waitcnt lgkmcnt(0)" ::: "memory");
    const int c = lane & 7;
#pragma unroll
    for (int j = 0; j < 4; ++j) { const int n = (lane >> 3) + 8 * j; const LAS float* s = scr + (8 * c) * 33 + n;
        u32x4 o; o.x = pk2(s[0 * 33], s[1 * 33]); o.y = pk2(s[2 * 33], s[3 * 33]); o.z = pk2(s[4 * 33], s[5 * 33]); o.w = pk2(s[6 * 33], s[7 * 33]);
        *(GAS u32x4*)(WT + (size_t)(drow0 + n) * dK + k0 + 8 * c) = o; }
    asm volatile("s_waitcnt lgkmcnt(0)" ::: "memory");
}

__device__ __forceinline__ void p0_mod(Frame& F) {
    const int ftid = opaque_tid(), flane = ftid & 63, fwave = __builtin_amdgcn_readfirstlane(ftid >> 6);
    LAS float* cs = (LAS float*)(F.lds);
    LAS float* red = (LAS float*)(F.lds + 32768);
    for (int i = ftid; i < 8 * 1024; i += 512) cs[i] = siluf_(inp(I_C)[i]);
    __syncthreads();
    float* MOD = (float*)(F.ws + WS_MOD);
    for (int cb = F.blk; cb < 6144 / 24; cb += F.G) {
        const int col = ftid & 31, kg = ftid >> 5;
        float acc[8];
#pragma unroll
        for (int b = 0; b < 8; ++b) acc[b] = 0.f;
        if (col < 24) {
            const float* wp = inp(I_WADA) + (size_t)kg * 6144 + cb * 24 + col;
#pragma unroll
            for (int i0 = 0; i0 < 64; i0 += 16) {
                float w[16];
#pragma unroll
                for (int i = 0; i < 16; ++i) w[i] = wp[(size_t)(16 * (i0 + i)) * 6144];
#pragma unroll
                for (int i = 0; i < 16; ++i) { const int k = kg + 16 * (i0 + i);
#pragma unroll
                    for (int b = 0; b < 8; ++b) acc[b] += cs[b * 1024 + k] * w[i]; }
            }
        }
#pragma unroll
        for (int b = 0; b < 8; ++b) red[(kg * 8 + b) * 32 + col] = acc[b];
        __syncthreads();
        if (ftid < 256) { const int b = ftid >> 5, cc = ftid & 31;
            if (cc < 24) { float s = inp(I_BADA)[cb * 24 + cc];
                for (int g = 0; g < 16; ++g) s += red[(g * 8 + b) * 32 + cc];
                MOD[b * 6144 + cb * 24 + cc] = s; } }
        __syncthreads();
    }
}
__device__ __forceinline__ void p0_weights(Frame& F) {
    const int ftid = opaque_tid(), flane = ftid & 63, fwave = __builtin_amdgcn_readfirstlane(ftid >> 6);
    LAS float* scr = (LAS float*)(F.lds + 49152 + fwave * 8448);
    const int gw = F.blk * 8 + fwave, NGW = F.G * 8;
    bf16_t* WIN = (bf16_t*)(F.ws + WS_WIN); bf16_t* WG = (bf16_t*)(F.ws + WS_WG);
    bf16_t* WUPG = (bf16_t*)(F.ws + WS_WUPG); bf16_t* WUPD = (bf16_t*)(F.ws + WS_WUPD); bf16_t* WOUT = (bf16_t*)(F.ws + WS_WOUT);
    constexpr int I_IN = 16 * (NPROJ / 32), I_G = 16 * 64, I_UG = 16 * 32, I_UD = 8 * 32, I_O = 16 * 32;
    constexpr int NIT = I_IN + I_G + I_UG + I_UD + I_O;
    for (int it = gw; it < NIT; it += NGW) {
        int r = it;
        if (r < I_IN) { const int kb = r / (NPROJ / 32), nb = r % (NPROJ / 32), n0 = nb * 32; transpose_item(inp(I_WIN), IN_W, n0 + (n0 >= 4096 ? 16 : 0), kb * 64, WIN, 1024, n0, scr, flane); continue; } r -= I_IN;
        if (r < I_G) { const int kb = r / 64, nb = r % 64, p = nb >> 3, hf = (nb >> 2) & 1, i0 = (nb & 3) * 32;
            transpose_item(inp(I_WIN), IN_W, 8720 + hf * 1024 + p * 128 + i0, kb * 64, WG, 1024, p * 256 + hf * 128 + i0, scr, flane); continue; } r -= I_G;
        if (r < I_UG) { const int kb = r / 32, nb = r % 32; transpose_item(inp(I_WUPG), 1024, nb * 32, kb * 64, WUPG, 1024, nb * 32, scr, flane); continue; } r -= I_UG;
        if (r < I_UD) { const int kb = r / 32, nb = r % 32; transpose_item(inp(I_WUPD), 1024, nb * 32, kb * 64, WUPD, 512, nb * 32, scr, flane); continue; } r -= I_UD;
        { const int kb = r / 32, nb = r % 32; transpose_item(inp(I_WOUT), 1024, nb * 32, kb * 64, WOUT, 1024, nb * 32, scr, flane); }
    }
}
__device__ __forceinline__ void tr16_item(const float* src, int ldn, int n0, int k0, bf16_t* d0, bf16_t* d1, bf16_t* d2, bf16_t* d3, int lane) {
    f32x4 v[16];
#pragma unroll
    for (int i = 0; i < 16; ++i) v[i] = *(const f32x4*)(src + (size_t)(k0 + i) * ldn + n0 + 4 * lane);
    u32x4 a0, a1, b0, b1, c0, c1, e0, e1;
#pragma unroll
    for (int i = 0; i < 4; ++i) { a0[i] = pk2(v[2 * i].x, v[2 * i + 1].x); a1[i] = pk2(v[8 + 2 * i].x, v[9 + 2 * i].x); b0[i] = pk2(v[2 * i].y, v[2 * i + 1].y); b1[i] = pk2(v[8 + 2 * i].y, v[9 + 2 * i].y);
        c0[i] = pk2(v[2 * i].z, v[2 * i + 1].z); c1[i] = pk2(v[8 + 2 * i].z, v[9 + 2 * i].z); e0[i] = pk2(v[2 * i].w, v[2 * i + 1].w); e1[i] = pk2(v[8 + 2 * i].w, v[9 + 2 * i].w); }
    *(u32x4*)(d0 + k0) = a0; *(u32x4*)(d0 + k0 + 8) = a1; *(u32x4*)(d1 + k0) = b0; *(u32x4*)(d1 + k0 + 8) = b1;
    *(u32x4*)(d2 + k0) = c0; *(u32x4*)(d2 + k0 + 8) = c1; *(u32x4*)(d3 + k0) = e0; *(u32x4*)(d3 + k0 + 8) = e1;
}
__device__ __forceinline__ void tr16_item_fp8(const float* src, int ldn, int n0, int k0, unsigned char* d0, unsigned char* d1, unsigned char* d2, unsigned char* d3, int lane, float SC) {
    f32x4 v[16];
#pragma unroll
    for (int i = 0; i < 16; ++i) v[i] = *(const f32x4*)(src + (size_t)(k0 + i) * ldn + n0 + 4 * lane) * SC;
    u32x4 a, b, c, e;
#pragma unroll
    for (int j = 0; j < 4; ++j) { int w;
        w = 0; w = __builtin_amdgcn_cvt_pk_fp8_f32(v[4 * j].x, v[4 * j + 1].x, w, false); w = __builtin_amdgcn_cvt_pk_fp8_f32(v[4 * j + 2].x, v[4 * j + 3].x, w, true); a[j] = (unsigned)w;
        w = 0; w = __builtin_amdgcn_cvt_pk_fp8_f32(v[4 * j].y, v[4 * j + 1].y, w, false); w = __builtin_amdgcn_cvt_pk_fp8_f32(v[4 * j + 2].y, v[4 * j + 3].y, w, true); b[j] = (unsigned)w;
        w = 0; w = __builtin_amdgcn_cvt_pk_fp8_f32(v[4 * j].z, v[4 * j + 1].z, w, false); w = __builtin_amdgcn_cvt_pk_fp8_f32(v[4 * j + 2].z, v[4 * j + 3].z, w, true); c[j] = (unsigned)w;
        w = 0; w = __builtin_amdgcn_cvt_pk_fp8_f32(v[4 * j].w, v[4 * j + 1].w, w, false); w = __builtin_amdgcn_cvt_pk_fp8_f32(v[4 * j + 2].w, v[4 * j + 3].w, w, true); e[j] = (unsigned)w; }
    *(u32x4*)(d0 + k0) = a; *(u32x4*)(d1 + k0) = b; *(u32x4*)(d2 + k0) = c; *(u32x4*)(d3 + k0) = e;
}
constexpr float WD_SCALE = 16.0f;
constexpr float WGU_SCALE = 32.0f;
__device__ __forceinline__ void convert_experts(Frame& F, int b0, int nb) {
    const int ftid = opaque_tid(), flane = ftid & 63, fwave = __builtin_amdgcn_readfirstlane(ftid >> 6);
    if (F.blk < b0 || F.blk >= b0 + nb) return;
    const int gw = (F.blk - b0) * 8 + fwave, NGW = nb * 8;
    unsigned char* WGU = F.ws + WS_WGU; unsigned char* WD = F.ws + WS_WD; unsigned char* WSGU = F.ws + WS_WSGU; unsigned char* WSD = F.ws + WS_WSD;
    constexpr int PER_E = 192, NIT = 65 * PER_E;
    LAS unsigned char* const lds = F.lds; (void)lds; TS_BEGIN();
    for (int it = gw; it < NIT; it += NGW) {
        const int e = it / PER_E; const int r = it % PER_E;
        unsigned char* dgu = e < 64 ? WGU + (size_t)e * 512 * 1024 : WSGU; unsigned char* dd = e < 64 ? WD + (size_t)e * 1024 * 256 : WSD;
        if (r < 128) { const int hf = r >> 6, k0 = (r & 63) * 16;
            const float* src = hf ? (e < 64 ? inp(I_WEU) + (size_t)e * 1024 * 256 : inp(I_WSU)) : (e < 64 ? inp(I_WEG) + (size_t)e * 1024 * 256 : inp(I_WSG));
            const int n = 4 * flane; unsigned char* d = dgu + (size_t)((n >> 7) * 256 + hf * 128 + (n & 127)) * 1024;
            tr16_item_fp8(src, 256, 0, k0, d, d + 1024, d + 2048, d + 3072, flane, WGU_SCALE); }
        else { const int q = r - 128, k0 = (q >> 2) * 16, n0 = (q & 3) * 256;
            const float* src = e < 64 ? inp(I_WED) + (size_t)e * 256 * 1024 : inp(I_WSD);
            unsigned char* d = dd + (size_t)(n0 + 4 * flane) * 256;
            tr16_item_fp8(src, 1024, n0, k0, d, d + 256, d + 512, d + 768, flane, WD_SCALE); }
    }
    TS_END(28);
}

__device__ __forceinline__ void p1_norm(Frame& F) {
    const int ftid = opaque_tid(), flane = ftid & 63, fwave = __builtin_amdgcn_readfirstlane(ftid >> 6);
    LAS float* WbT = (LAS float*)(F.lds);
    for (int it = 0; it < 8; ++it) { const int k = (ftid >> 2) + 128 * it, j4 = (ftid & 3) * 4;
        const f32x4 v = *(const f32x4*)(inp(I_WIN) + (size_t)k * IN_W + 4096 + j4);
        WbT[(j4 + 0) * 1024 + k] = v.x; WbT[(j4 + 1) * 1024 + k] = v.y; WbT[(j4 + 2) * 1024 + k] = v.z; WbT[(j4 + 3) * 1024 + k] = v.w; }
    __syncthreads();
    const float* MOD = (const float*)(F.ws + WS_MOD); bf16_t* H = (bf16_t*)(F.ws + WS_H); float* BA = (float*)(F.ws + WS_BA);
    const int gw = F.blk * 8 + fwave, NGW = F.G * 8;
    for (int rg = gw; rg < T / 8; rg += NGW) {
        const int row0 = rg * 8, b = row0 / SEQ;
        const float* sh = MOD + b * 6144; const float* sc = sh + 1024;
        f32x4 gm[4], s1[4], h1[4];
#pragma unroll
        for (int j = 0; j < 4; ++j) { const int k = 4 * flane + 256 * j; gm[j] = *(const f32x4*)(inp(I_GMIX) + k); s1[j] = *(const f32x4*)(sc + k) + 1.0f; h1[j] = *(const f32x4*)(sh + k); gm[j] = gm[j] * s1[j]; }
        f32x4 cur[4], nxt[4];
        { const f32x4* xr = (const f32x4*)(inp(I_X) + (size_t)row0 * DM) + flane;
#pragma unroll
          for (int j = 0; j < 4; ++j) cur[j] = xr[64 * j]; }
#pragma unroll 1
        for (int r = 0; r < 8; ++r) {
            const int row = row0 + r;
            if (r < 7) { const f32x4* xr = (const f32x4*)(inp(I_X) + (size_t)(row + 1) * DM) + flane;
#pragma unroll
                for (int j = 0; j < 4; ++j) nxt[j] = xr[64 * j]; }
            f32x4 v[4]; float ss = 0.f;
#pragma unroll
            for (int j = 0; j < 4; ++j) { v[j] = cur[j]; ss += (v[j].x * v[j].x + v[j].y * v[j].y) + (v[j].z * v[j].z + v[j].w * v[j].w); }
            const float rstd = rsqrtf(wave_sum(ss) * (1.f / DM) + EPS);
#pragma unroll
            for (int j = 0; j < 4; ++j) { const int k = 4 * flane + 256 * j;
                v[j] = (v[j] * rstd) * gm[j] + h1[j];
                u32x2 o; o.x = pk2(v[j].x, v[j].y); o.y = pk2(v[j].z, v[j].w);
                *(u32x2*)(H + (size_t)row * DM + k) = o; }
            float a[16];
#pragma unroll
            for (int jj = 0; jj < 16; ++jj) { float s = 0.f;
#pragma unroll
                for (int j = 0; j < 4; ++j) { const f32x4 w = *(const LAS f32x4*)(WbT + jj * 1024 + 4 * flane + 256 * j); s += (v[j].x * w.x + v[j].y * w.y) + (v[j].z * w.z + v[j].w * w.w); }
                a[jj] = s; if ((jj & 3) == 3) asm volatile("" ::: "memory"); }
            float v8[8], v4[4], v2[2], v1;
            { const bool hi = (flane & 32) != 0;
#pragma unroll
              for (int i = 0; i < 8; ++i) { const float x = hi ? a[i] : a[8 + i]; const float rr = __shfl_xor(x, 32); v8[i] = (hi ? a[8 + i] : a[i]) + rr; } }
            { const bool hi = (flane & 16) != 0;
#pragma unroll
              for (int i = 0; i < 4; ++i) { const float x = hi ? v8[i] : v8[4 + i]; const float rr = __shfl_xor(x, 16); v4[i] = (hi ? v8[4 + i] : v8[i]) + rr; } }
            { const bool hi = (flane & 8) != 0;
#pragma unroll
              for (int i = 0; i < 2; ++i) { const float x = hi ? v4[i] : v4[2 + i]; const float rr = __shfl_xor(x, 8); v2[i] = (hi ? v4[2 + i] : v4[i]) + rr; } }
            { const bool hi = (flane & 4) != 0; const float x = hi ? v2[0] : v2[1]; const float rr = __shfl_xor(x, 4); v1 = (hi ? v2[1] : v2[0]) + rr; }
            v1 = red4(v1);
            if ((flane & 3) == 0) BA[(size_t)row * 16 + (flane >> 2)] = v1;
#pragma unroll
            for (int j = 0; j < 4; ++j) cur[j] = nxt[j];
        }
    }
}

using pg8::Unit; using pg8::cvt_pk_bf16;
struct EpiProj {
    static constexpr bool PERM = true;
    unsigned char* ws; bf16_t* gz;
    __device__ __forceinline__ void operator()(const f32x4 (&acc)[2][2][4][2], const Unit& u, const int ui) const {
        const int tid_ = opaque_tid(), lane_ = tid_ & 63, wid_ = tid_ >> 6, wr = wid_ >> 2, wc = wid_ & 3, fr = lane_ & 15, fq = lane_ >> 4;
        bf16_t* base; int ldc, colt;
        if (u.pn < 16) { const int t = u.pn >> 2; base = (bf16_t*)(ws + WS_GQ + (size_t)t * (32 * MiB)); if (t == 3) base = gz; ldc = 1024; colt = (u.pn & 3) * 256; }
        else { const int d = u.pn - 16, t = d / 6; base = (bf16_t*)(ws + WS_DQ + (size_t)t * (48 * MiB)); ldc = 1536; colt = (d % 6) * 256; }
        const int row0 = u.pm * 256 + wr * 64 + fr, col0 = colt + wc * 32 + 8 * fq;
        if ((u.pn >> 2) == 3) {
#pragma unroll
            for (int ai = 0; ai < 2; ++ai)
#pragma unroll
                for (int m = 0; m < 4; ++m) { bf16_t* rowp = base + (size_t)(row0 + ai * 128 + m * 16) * ldc + col0;
#pragma unroll
                    for (int bj = 0; bj < 2; ++bj) { const f32x4 v0 = acc[ai][bj][m][0], v1 = acc[ai][bj][m][1];
                        u32x4 w; w.x = pk2(siluf_(v0[0]), siluf_(v0[1])); w.y = pk2(siluf_(v0[2]), siluf_(v0[3])); w.z = pk2(siluf_(v1[0]), siluf_(v1[1])); w.w = pk2(siluf_(v1[2]), siluf_(v1[3]));
                        *(u32x4*)(rowp + bj * 128) = w; }
                    asm volatile("" ::: "memory"); }
            return; }
#pragma unroll
        for (int ai = 0; ai < 2; ++ai)
#pragma unroll
            for (int m = 0; m < 4; ++m) { bf16_t* rowp = base + (size_t)(row0 + ai * 128 + m * 16) * ldc + col0;
#pragma unroll
                for (int bj = 0; bj < 2; ++bj) { const f32x4 v0 = acc[ai][bj][m][0], v1 = acc[ai][bj][m][1];
                    u32x4 w; w.x = pk2(v0[0], v0[1]); w.y = pk2(v0[2], v0[3]); w.z = pk2(v1[0], v1[1]); w.w = pk2(v1[2], v1[3]);
                    *(u32x4*)(rowp + bj * 128) = w; } }
    }
};
struct EpiStore {
    static constexpr bool PERM = true;
    bf16_t* O; int ldc;
    __device__ __forceinline__ void operator()(const f32x4 (&acc)[2][2][4][2], const Unit& u, const int ui) const {
        const int tid_ = opaque_tid(), lane_ = tid_ & 63, wid_ = tid_ >> 6, wr = wid_ >> 2, wc = wid_ & 3, fr = lane_ & 15, fq = lane_ >> 4;
        const int row0 = u.pm * 256 + wr * 64 + fr, col0 = u.pn * 256 + wc * 32 + 8 * fq;
#pragma unroll
        for (int ai = 0; ai < 2; ++ai)
#pragma unroll
            for (int m = 0; m < 4; ++m) { bf16_t* rowp = O + (size_t)(row0 + ai * 128 + m * 16) * ldc + col0;
#pragma unroll
                for (int bj = 0; bj < 2; ++bj) { const f32x4 v0 = acc[ai][bj][m][0], v1 = acc[ai][bj][m][1];
                    u32x4 w; w.x = pk2(v0[0], v0[1]); w.y = pk2(v0[2], v0[3]); w.z = pk2(v1[0], v1[1]); w.w = pk2(v1[2], v1[3]);
                    *(u32x4*)(rowp + bj * 128) = w; } }
    }
};
struct EpiGate {
    static constexpr bool PERM = true;
    const bf16_t* UA; const bf16_t* UB; bf16_t* MG;
    __device__ __forceinline__ void operator()(const f32x4 (&acc)[2][2][4][2], const Unit& u, const int ui) const {
        const int tid_ = opaque_tid(), lane_ = tid_ & 63, wid_ = tid_ >> 6, wr = wid_ >> 2, wc = wid_ & 3, fr = lane_ & 15, fq = lane_ >> 4;
        const int row0 = u.pm * 256 + wr * 64 + fr, col0 = u.pn * 128 + wc * 32 + 8 * fq;
#pragma unroll
        for (int ai = 0; ai < 2; ++ai) {
            u32x4 ua[4], ub[4];
#pragma unroll
            for (int m = 0; m < 4; ++m) { const size_t off = (size_t)(row0 + ai * 128 + m * 16) * 1024 + col0; ua[m] = *(const u32x4*)(UA + off); ub[m] = *(const u32x4*)(UB + off); }
#pragma unroll
            for (int m = 0; m < 4; ++m) { const size_t off = (size_t)(row0 + ai * 128 + m * 16) * 1024 + col0;
                float o[8];
#pragma unroll
                for (int n = 0; n < 2; ++n)
#pragma unroll
                    for (int j = 0; j < 4; ++j) { const int q = n * 4 + j; const unsigned wa = ua[m][q >> 1], wb = ub[m][q >> 1];
                        const float fa = (q & 1) ? bfhi(wa) : bflo(wa), fb = (q & 1) ? bfhi(wb) : bflo(wb);
                        o[q] = sigmoidf_(acc[ai][0][m][n][j]) * fa + sigmoidf_(acc[ai][1][m][n][j]) * fb; }
                u32x4 w; w.x = pk2(o[0], o[1]); w.y = pk2(o[2], o[3]); w.z = pk2(o[4], o[5]); w.w = pk2(o[6], o[7]);
                *(u32x4*)(MG + off) = w; }
            asm volatile("" ::: "memory");
        }
    }
};
struct EpiX1 {
    static constexpr bool PERM = false;
    const float* x; const float* mod; float* out;
    __device__ __forceinline__ void operator()(const f32x4 (&acc)[2][2][4][2], const Unit& u, const int ui) const {
        const int tid_ = opaque_tid(), lane_ = tid_ & 63, wid_ = tid_ >> 6, wr = wid_ >> 2, wc = wid_ & 3, fr = lane_ & 15, fq = lane_ >> 4;
        const int row0 = u.pm * 256 + wr * 64 + fr, col0 = u.pn * 256 + wc * 32 + 4 * fq; const int b = u.pm >> 3;
        f32x4 gt[2][2];
#pragma unroll
        for (int bj = 0; bj < 2; ++bj)
#pragma unroll
            for (int n = 0; n < 2; ++n) gt[bj][n] = *(const f32x4*)(mod + b * 6144 + 2048 + col0 + bj * 128 + n * 16);
#pragma unroll
        for (int ai = 0; ai < 2; ++ai) {
            f32x4 xv[4][2][2];
#pragma unroll
            for (int m = 0; m < 4; ++m) { const size_t off = (size_t)(row0 + ai * 128 + m * 16) * 1024 + col0;
#pragma unroll
                for (int bj = 0; bj < 2; ++bj)
#pragma unroll
                    for (int n = 0; n < 2; ++n) xv[m][bj][n] = *(const f32x4*)(x + off + bj * 128 + n * 16); }
#pragma unroll
            for (int m = 0; m < 4; ++m) { const size_t off = (size_t)(row0 + ai * 128 + m * 16) * 1024 + col0;
#pragma unroll
                for (int bj = 0; bj < 2; ++bj)
#pragma unroll
                    for (int n = 0; n < 2; ++n) *(f32x4*)(out + off + bj * 128 + n * 16) = xv[m][bj][n] + gt[bj][n] * acc[ai][bj][m][n]; }
            asm volatile("" ::: "memory");
        }
    }
};
struct MoeTab { const LAS int* tp; const LAS int* cnt; const LAS unsigned short* te; };
struct EpiAct {
    static constexpr bool PERM = true;
    MoeTab tb; const LAS float* wkb; unsigned char* ACT; unsigned char* ACTS;
    __device__ __forceinline__ void operator()(const f32x4 (&acc)[2][2][4][2], const Unit& u, const int ui) const {
        const int tid_ = opaque_tid(), lane_ = tid_ & 63, wid_ = tid_ >> 6, wr = wid_ >> 2, wc = wid_ & 3, fr = lane_ & 15, fq = lane_ >> 4;
        const int e = u.e;
        unsigned char* base = e < 64 ? ACT + (size_t)u.pm * 256 * 256 : ACTS + (size_t)u.mt * 256 * 256;
        const int col0 = u.pn * 128 + wc * 32 + 8 * fq;
        float wk[2][4];
#pragma unroll
        for (int ai = 0; ai < 2; ++ai)
#pragma unroll
            for (int m = 0; m < 4; ++m) wk[ai][m] = wkb[ui * 256 + ai * 128 + wr * 64 + m * 16 + fr] * (1.0f / WGU_SCALE);
#pragma unroll
        for (int ai = 0; ai < 2; ++ai)
#pragma unroll
            for (int m = 0; m < 4; ++m) { const int r = ai * 128 + wr * 64 + m * 16 + fr;
                float o[8];
#pragma unroll
                for (int n = 0; n < 2; ++n)
#pragma unroll
                    for (int j = 0; j < 4; ++j) o[n * 4 + j] = siluf_(acc[ai][0][m][n][j] * (1.0f / WGU_SCALE)) * acc[ai][1][m][n][j] * wk[ai][m];
                int p0 = 0, p1 = 0;
                p0 = __builtin_amdgcn_cvt_pk_fp8_f32(o[0], o[1], p0, false); p0 = __builtin_amdgcn_cvt_pk_fp8_f32(o[2], o[3], p0, true);
                p1 = __builtin_amdgcn_cvt_pk_fp8_f32(o[4], o[5], p1, false); p1 = __builtin_amdgcn_cvt_pk_fp8_f32(o[6], o[7], p1, true);
                u32x2 w; w.x = (unsigned)p0; w.y = (unsigned)p1; *(u32x2*)(base + (size_t)r * 256 + col0) = w; }
    }
};
struct EpiSlot {
    static constexpr bool PERM = true;
    MoeTab tb; const LAS int* pairb; unsigned char* SLOT; bf16_t* SH;
    __device__ __forceinline__ void operator()(const f32x4 (&acc)[2][2][4][2], const Unit& u, const int ui) const {
        const int tid_ = opaque_tid(), lane_ = tid_ & 63, wid_ = tid_ >> 6, wr = wid_ >> 2, wc = wid_ & 3, fr = lane_ & 15, fq = lane_ >> 4;
        const int e = u.e; const int col0 = u.pn * 256 + wc * 32 + 8 * fq;
        if (e == 64) {
#pragma unroll
            for (int ai = 0; ai < 2; ++ai)
#pragma unroll
                for (int m = 0; m < 4; ++m) { bf16_t* rowp = SH + (size_t)(u.mt * 256 + ai * 128 + wr * 64 + m * 16 + fr) * 1024 + col0;
#pragma unroll
                    for (int bj = 0; bj < 2; ++bj) { const f32x4 v0 = acc[ai][bj][m][0], v1 = acc[ai][bj][m][1];
                        u32x4 w; w.x = pk2(v0[0], v0[1]); w.y = pk2(v0[2], v0[3]); w.z = pk2(v1[0], v1[1]); w.w = pk2(v1[2], v1[3]);
                        *(u32x4*)(rowp + bj * 128) = w; } }
            return;
        }
        int pair[2][4];
#pragma unroll
        for (int ai = 0; ai < 2; ++ai)
#pragma unroll
            for (int m = 0; m < 4; ++m) pair[ai][m] = pairb[ui * 256 + ai * 128 + wr * 64 + m * 16 + fr];
#pragma unroll
        for (int ai = 0; ai < 2; ++ai)
#pragma unroll
            for (int m = 0; m < 4; ++m) {
                if (pair[ai][m] >= 0) { unsigned char* rowp = SLOT + (size_t)pair[ai][m] * 1024 + col0;
#pragma unroll
                    for (int bj = 0; bj < 2; ++bj) { const f32x4 v0 = acc[ai][bj][m][0], v1 = acc[ai][bj][m][1];
                        int p0 = 0, p1 = 0;
                        p0 = __builtin_amdgcn_cvt_pk_fp8_f32(v0[0], v0[1], p0, false); p0 = __builtin_amdgcn_cvt_pk_fp8_f32(v0[2], v0[3], p0, true);
                        p1 = __builtin_amdgcn_cvt_pk_fp8_f32(v1[0], v1[1], p1, false); p1 = __builtin_amdgcn_cvt_pk_fp8_f32(v1[2], v1[3], p1, true);
                        u32x2 w; w.x = (unsigned)p0; w.y = (unsigned)p1; *(u32x2*)(rowp + bj * 128) = w; } } }
    }
};
struct G1Order {
    MoeTab tb; int G, c; const int* list; const char* H2; const char* WGU; const char* WSGU;
    __device__ __forceinline__ bool next(int i, Unit& u) const {
        const int NR = tb.tp[64]; const long L = (long)i * G + c; if (L >= (long)(NR + 64) * 2) return false;
        const int tile = (int)(L >> 1), j = (int)(L & 1);
        u.pn = j; u.Ap = H2;
        if (tile < NR) { const int e = tb.te[tile]; u.e = e; u.mt = tile - tb.tp[e]; u.pm = tile; u.Bp = WGU + ((size_t)e * 512 + j * 256) * 1024; }
        else { u.e = 64; u.mt = tile - NR; u.pm = 0; u.Bp = WSGU + (size_t)(j * 256) * 1024; }
        return true;
    }
    __device__ __forceinline__ int a_row(const Unit& u, int r) const {
        int tok;
        if (u.e == 64) tok = u.mt * 256 + r;
        else { const int pos = u.mt * 256 + r; tok = 0; if (pos < tb.cnt[u.e]) tok = list[(size_t)u.e * T + pos] >> 3; }
        return tok;
    }
    __device__ __forceinline__ unsigned a_off(const Unit& u, int r, int K) const { return (unsigned)(a_row(u, r) * K) * 2u; }
    __device__ __forceinline__ void preload(LAS int* tokb, LAS float* wkb, const float* listw) const {
        const int t = opaque_tid(); Unit u;
        for (int i = 0; i < 6 && next(i, u); ++i) if (t < 256) {
            int tok; float w = 1.0f;
            if (u.e == 64) tok = u.mt * 256 + t;
            else { const int pos = u.mt * 256 + t; tok = 0; w = 0.f; if (pos < tb.cnt[u.e]) { tok = list[(size_t)u.e * T + pos] >> 3; w = listw[(size_t)u.e * T + pos]; } }
            tokb[i * 256 + t] = tok; wkb[i * 256 + t] = w; }
        __syncthreads();
    }
};
struct G2Order {
    MoeTab tb; int G, c; const char* ACT; const char* WD; const char* ACTS; const char* WSD;
    __device__ __forceinline__ bool next(int i, Unit& u) const {
        const int NR = tb.tp[64]; const long L = (long)i * G + c; if (L >= (long)(NR + 64) * 4) return false;
        const int tile = (int)(L >> 2), pn = (int)(L & 3);
        u.pn = pn;
        if (tile < NR) { const int e = tb.te[tile];
            u.e = e; u.mt = tile - tb.tp[e]; u.pm = tile; u.Ap = ACT + (size_t)tile * 256 * 256 * 2; u.Bp = WD + ((size_t)e * 1024 + pn * 256) * 256 * 2; }
        else { u.e = 64; u.mt = tile - NR; u.pm = 0; u.Ap = ACTS + (size_t)u.mt * 256 * 256 * 2; u.Bp = WSD + (size_t)(pn * 256) * 256 * 2; }
        return true;
    }
    __device__ __forceinline__ unsigned a_off(const Unit&, int r, int K) const { return (unsigned)(r * K) * 2u; }
    __device__ __forceinline__ void preload(LAS int* pairb, const int* list) const {
        const int t = opaque_tid(); Unit u;
        for (int i = 0; i < 12 && next(i, u); ++i) if (t < 256) {
            int p = -1;
            if (u.e < 64) { const int pos = u.mt * 256 + t; if (pos < tb.cnt[u.e]) p = list[(size_t)u.e * T + pos]; }
            pairb[i * 256 + t] = p; }
        __syncthreads();
    }
};
__device__ __forceinline__ MoeTab build_moetab(Frame& F) {
    const int ftid = opaque_tid();
    LAS int* tp = (LAS int*)(F.lds + MISC_OFF + 1024); LAS int* cnt = (LAS int*)(F.lds + MISC_OFF + 2048); LAS unsigned short* te = (LAS unsigned short*)(F.lds + MISC_OFF + 2304);
    const gu32* gc = (const gu32*)(F.ws + WS_CTL) + CW_CNT;
    __syncthreads();
    if (ftid < 64) { int v = (int)__hip_atomic_load(gc + ftid, RLX_AGENT); if (v > T) v = T; if (v < 0) v = 0; cnt[ftid] = v; }
    __syncthreads();
    if (ftid == 0) { int s = 0; for (int e = 0; e < 64; ++e) { tp[e] = s; s += (cnt[e] + 255) >> 8; } tp[64] = s; }
    __syncthreads();
    if (ftid < 64) { const int t0 = tp[ftid], t1 = tp[ftid + 1]; for (int t = t0; t < t1 && t < 640; ++t) te[t] = (unsigned short)ftid; }
    __syncthreads();
    MoeTab t; t.tp = tp; t.cnt = cnt; t.te = te; return t;
}


typedef short v4i16_t __attribute__((ext_vector_type(4)));
constexpr size_t WS_OG01 = 302 * MiB;
constexpr size_t OUT_OG2 = 48 * MiB;
constexpr size_t WS_LSE = 3 * MiB + 512 * 1024;
__device__ __forceinline__ void p3_attn(Frame& F) {
    const int tid = opaque_tid(), lane = tid & 63, wave = __builtin_amdgcn_readfirstlane(tid >> 6), n = lane & 15, g = lane >> 4;
    const bf16_t* DQ = (const bf16_t*)(F.ws + WS_DQ); const bf16_t* DK = (const bf16_t*)(F.ws + WS_DK); const bf16_t* DV = (const bf16_t*)(F.ws + WS_DV);
    LAS unsigned char* Ks = F.lds; LAS unsigned char* Vs = F.lds + 65536; LAS float* rkS = (LAS float*)(F.lds + 131072); LAS float* gqkS = (LAS float*)(F.lds + 131072 + 1024);
    LAS unsigned char* const lds = F.lds; (void)lds;
    if (tid < 128) gqkS[tid] = inp(I_QNG)[tid] * inp(I_KNG)[tid] * (0.08838834764831845f * 1.4426950408889634f);
    u32x4 kreg[8], vreg[8], qreg[4];
#define ATT_DECODE(u_, b_, h_, dsh_, r_, qb_) const int b_ = (u_) / 192, rem_##b_ = (u_) % 192, h_ = rem_##b_ >> 4, rq_##b_ = rem_##b_ & 15, dsh_ = 2 * (h_ >> 2), r_ = rq_##b_ / (16 >> dsh_), qb_ = rq_##b_ % (16 >> dsh_)
#define ATT_LOADKV(u_) do { ATT_DECODE(u_, lb, lh, ldsh, lr, lqb); \
        _Pragma("unroll") for (int pass = 0; pass < 8; ++pass) { if (lqb == 0 && pass < 4) continue; \
            const int wi = pass * 32 + (tid >> 4), c = tid & 15, m = lqb * 128 - 128 + wi; \
            const size_t t = (size_t)lb * SEQ + (size_t)((m << ldsh) + lr); \
            kreg[pass] = *(const u32x4*)(DK + t * 1536 + lh * 128 + c * 8); vreg[pass] = *(const u32x4*)(DV + t * 1536 + lh * 128 + c * 8); } \
        { const size_t tq_ = (size_t)lb * SEQ + (size_t)(((lqb * 128 + 16 * wave + n) << ldsh) + lr); \
          _Pragma("unroll") for (int ks = 0; ks < 4; ++ks) qreg[ks] = *(const u32x4*)(DQ + tq_ * 1536 + lh * 128 + 32 * ks + 8 * g); } } while (0)
    if (F.blk < BATCH * 12 * 16) { ATT_LOADKV(F.blk); }
#pragma unroll 1
    for (int u = F.blk; u < BATCH * 12 * 16; u += F.G) {
        ATT_DECODE(u, b, h, dsh, r, qb); const int grp = h >> 2, s = h & 3, dil = 1 << dsh, m0 = qb * 128;
        const int rowb = b * SEQ;
        TS_BEGIN();
        __syncthreads();
        const int tid2 = opaque_tid();
#pragma unroll
        for (int pass = 0; pass < 8; ++pass) {
            if (qb == 0 && pass < 4) continue;
            const int wi = pass * 32 + (tid2 >> 4), c = tid2 & 15;
            const u32x4 kv = kreg[pass], vv = vreg[pass];
            float ss = 0.f;
#pragma unroll
            for (int i = 0; i < 4; ++i) { const float a0 = bflo(kv[i]), a1 = bfhi(kv[i]); ss += a0 * a0 + a1 * a1; }
            ss = red16(ss);
            if (c == 0) rkS[wi] = rsqrtf(ss * (1.f / 128.f) + EPS);
            *(LAS u32x4*)(Ks + wi * 256 + ((c ^ (wi & 15)) << 4)) = kv;
            *(LAS u32x4*)(Vs + wi * 256 + ((c ^ ((wi & 7) << 1)) << 4)) = vv;
        }
        TS_END(14);
        bf16x8 qf[4];
        {
            float ss = 0.f;
#pragma unroll
            for (int ks = 0; ks < 4; ++ks)
#pragma unroll
                for (int i = 0; i < 4; ++i) { const float a0 = bflo(qreg[ks][i]), a1 = bfhi(qreg[ks][i]); ss += a0 * a0 + a1 * a1; }
            ss += __shfl_xor(ss, 16); ss += __shfl_xor(ss, 32);
            const float rqs = rsqrtf(ss * (1.f / 128.f) + EPS);
#pragma unroll
            for (int ks = 0; ks < 4; ++ks) { const f32x4 g0 = *(const LAS f32x4*)(gqkS + 32 * ks + 8 * g), g1 = *(const LAS f32x4*)(gqkS + 32 * ks + 8 * g + 4); u32x4 o;
                o[0] = pk2(bflo(qreg[ks][0]) * rqs * g0.x, bfhi(qreg[ks][0]) * rqs * g0.y); o[1] = pk2(bflo(qreg[ks][1]) * rqs * g0.z, bfhi(qreg[ks][1]) * rqs * g0.w);
                o[2] = pk2(bflo(qreg[ks][2]) * rqs * g1.x, bfhi(qreg[ks][2]) * rqs * g1.y); o[3] = pk2(bflo(qreg[ks][3]) * rqs * g1.z, bfhi(qreg[ks][3]) * rqs * g1.w);
                qf[ks] = __builtin_bit_cast(bf16x8, o); }
        }
        TS_END(23);
        __syncthreads();
        if (u + F.G < BATCH * 12 * 16) { ATT_LOADKV(u + F.G); }
        TS_END(15);
        f32x4 st[9];
        float mx = -INFINITY;
#pragma unroll
        for (int j = 0; j < 9; ++j) {
            const int tau = wave + j;
            st[j] = (f32x4){-INFINITY, -INFINITY, -INFINITY, -INFINITY};
            if (qb > 0 || tau >= 8) {
                f32x4 a = {0.f, 0.f, 0.f, 0.f};
                const LAS unsigned char* kp = Ks + (16 * tau + n) * 256;
#pragma unroll
                for (int ks = 0; ks < 4; ++ks) { const bf16x8 kf = *(const LAS bf16x8*)(kp + (((4 * ks + g) ^ n) << 4));
                    a = __builtin_amdgcn_mfma_f32_16x16x32_bf16(kf, qf[ks], a, 0, 0, 0); }
                const f32x4 rk = *(const LAS f32x4*)(rkS + 16 * tau + 4 * g);
                a = a * rk;
                if (j == 0) {
#pragma unroll
                    for (int reg = 0; reg < 4; ++reg) if (4 * g + reg < n) a[reg] = -INFINITY; }
                if (j == 8) {
#pragma unroll
                    for (int reg = 0; reg < 4; ++reg) if (4 * g + reg > n) a[reg] = -INFINITY; }
                st[j] = a;
                mx = fmaxf(mx, fmaxf(fmaxf(a[0], a[1]), fmaxf(a[2], a[3])));
            }
        }
        TS_END(16);
        mx = fmaxf(mx, __shfl_xor(mx, 16)); mx = fmaxf(mx, __shfl_xor(mx, 32));
        float lsum = 0.f;
#pragma unroll
        for (int j = 0; j < 9; ++j)
#pragma unroll
            for (int reg = 0; reg < 4; ++reg) { const float p = __builtin_amdgcn_exp2f(st[j][reg] - mx); st[j][reg] = p; lsum += p; }
        lsum += __shfl_xor(lsum, 16); lsum += __shfl_xor(lsum, 32);
        TS_END(17);
        f32x4 o[8];
#pragma unroll
        for (int dt = 0; dt < 8; ++dt) o[dt] = (f32x4){0.f, 0.f, 0.f, 0.f};
        const int q4 = (lane & 15) >> 2, p4 = lane & 3;
#pragma unroll
        for (int a = 0; a < 5; ++a) {
            const int tA = wave + 2 * a, tB = a < 4 ? tA + 1 : tA;
            if (qb > 0 || tB >= 8) {
                u32x4 pw; pw[0] = pk2(st[2 * a][0], st[2 * a][1]); pw[1] = pk2(st[2 * a][2], st[2 * a][3]);
                if (a < 4) { pw[2] = pk2(st[2 * a + 1][0], st[2 * a + 1][1]); pw[3] = pk2(st[2 * a + 1][2], st[2 * a + 1][3]); } else { pw[2] = 0u; pw[3] = 0u; }
                const bf16x8 pf = __builtin_bit_cast(bf16x8, pw);
                const int tAe = (qb == 0 && tA < 8) ? tB : tA;
                const int row0 = 16 * tAe + 4 * g + q4, row1 = 16 * tB + 4 * g + q4;
#pragma unroll
                for (int dt = 0; dt < 8; ++dt) {
                    const int c = 2 * dt + (p4 >> 1);
                    const v4i16_t v0 = __builtin_amdgcn_ds_read_tr16_b64_v4i16((LAS v4i16_t*)(Vs + row0 * 256 + ((c ^ ((row0 & 7) << 1)) << 4) + 8 * (p4 & 1)));
                    const v4i16_t v1 = __builtin_amdgcn_ds_read_tr16_b64_v4i16((LAS v4i16_t*)(Vs + row1 * 256 + ((c ^ ((row1 & 7) << 1)) << 4) + 8 * (p4 & 1)));
                    const bf16x8 vf = (bf16x8){v0[0], v0[1], v0[2], v0[3], v1[0], v1[1], v1[2], v1[3]};
                    o[dt] = __builtin_amdgcn_mfma_f32_16x16x32_bf16(vf, pf, o[dt], 0, 0, 0);
                }
            }
        }
        TS_END(18);
        const float il = __builtin_amdgcn_rcpf(lsum);
        const int tq = rowb + (m0 + 16 * wave + n) * dil + r;
        bf16_t* OG = grp < 2 ? (bf16_t*)(F.ws + WS_OG01) + (size_t)grp * T * 512 : (bf16_t*)(F.ob + OUT_OG2);
#pragma unroll
        for (int dt = 0; dt < 8; ++dt) { u32x2 w; w.x = pk2(o[dt][0] * il, o[dt][1] * il); w.y = pk2(o[dt][2] * il, o[dt][3] * il);
            *(u32x2*)(OG + (size_t)tq * 512 + s * 128 + 16 * dt + 4 * g) = w; }
        if (g == 0) ((float*)(F.ws + WS_LSE))[((size_t)grp * T + (size_t)tq) * 4 + s] = (mx + __builtin_amdgcn_logf(lsum)) * 0.6931471805599453f;
        TS_END(19);
    }
}
#undef ATT_DECODE
#undef ATT_LOADKV
__device__ __forceinline__ void p3_merge(Frame& F, const int b0, const int nb) {
    const int tid = opaque_tid();
    if (F.blk < b0 || F.blk >= b0 + nb) return;
    const bf16_t* OG0 = (const bf16_t*)(F.ws + WS_OG01); const bf16_t* OG1 = OG0 + (size_t)T * 512; const bf16_t* OG2 = (const bf16_t*)(F.ob + OUT_OG2);
    const float* LSE = (const float*)(F.ws + WS_LSE); bf16_t* YB = (bf16_t*)(F.ob + OUT_YB);
    for (size_t it = (size_t)(F.blk - b0) * 512 + tid; it < (size_t)T * 64; it += (size_t)nb * 512) {
        const size_t t = it >> 6; const int ch = (int)(it & 63), s = ch >> 4;
        const float l0 = LSE[t * 4 + s], l1 = LSE[((size_t)T + t) * 4 + s], l2 = LSE[((size_t)2 * T + t) * 4 + s];
        const float m = fmaxf(l0, fmaxf(l1, l2)); const float e0 = __expf(l0 - m), e1 = __expf(l1 - m), e2 = __expf(l2 - m); const float inv = 1.f / (e0 + e1 + e2);
        const float w0 = e0 * inv, w1 = e1 * inv, w2 = e2 * inv;
        const u32x4 a = *(const u32x4*)(OG0 + t * 512 + ch * 8), bq = *(const u32x4*)(OG1 + t * 512 + ch * 8), cq = *(const u32x4*)(OG2 + t * 512 + ch * 8);
        u32x4 o;
#pragma unroll
        for (int i = 0; i < 4; ++i) o[i] = pk2(w0 * bflo(a[i]) + w1 * bflo(bq[i]) + w2 * bflo(cq[i]), w0 * bfhi(a[i]) + w1 * bfhi(bq[i]) + w2 * bfhi(cq[i]));
        *(u32x4*)(YB + t * 512 + ch * 8) = o;
    }
}

constexpr size_t WS_UT = 158 * MiB, WS_WM = 190 * MiB, WS_QD = 222 * MiB, WS_KDT = 254 * MiB, WS_QK = 286 * MiB;
constexpr size_t WS_GT = 1 * MiB + 512 * 1024;
__device__ __forceinline__ unsigned off_b(unsigned row, unsigned ch) { return 256u * row + 16u * (ch ^ (((row & 3) << 2) | ((row >> 2) & 3))); }
__device__ __forceinline__ unsigned rowfrag_b(unsigned lane, unsigned rb, unsigned s) { return off_b((lane & 15) + 16 * rb, 4 * s + (lane >> 4)); }
__device__ __forceinline__ unsigned trfrag_b(unsigned lane, unsigned c, unsigned ks, unsigned t) { const unsigned g = lane >> 4, q = (lane & 15) >> 2, p = lane & 3; return off_b(32 * ks + 8 * g + 4 * t + q, 2 * c + (p >> 1)) + 8 * (p & 1); }
__device__ __forceinline__ bf16x8 tr_pair(LAS unsigned char* a0, LAS unsigned char* a1) {
    const v4i16_t v0 = __builtin_amdgcn_ds_read_tr16_b64_v4i16((LAS v4i16_t*)a0), v1 = __builtin_amdgcn_ds_read_tr16_b64_v4i16((LAS v4i16_t*)a1);
    return (bf16x8){v0[0], v0[1], v0[2], v0[3], v1[0], v1[1], v1[2], v1[3]};
}
constexpr int MST = 144;
__device__ __forceinline__ f32x4 mm64_tile(LAS unsigned char* X, LAS unsigned char* Y, int ti, int tj, int lane) {
    const int n = lane & 15, g = lane >> 4, q = n >> 2, p = lane & 3;
    f32x4 acc = {0.f, 0.f, 0.f, 0.f};
#pragma unroll
    for (int ks = 0; ks < 2; ++ks) {
        const bf16x8 a = *(const LAS bf16x8*)(X + (16 * ti + n) * MST + 16 * (4 * ks + g));
        LAS unsigned char* yb = Y + (32 * ks + 8 * g + q) * MST + 32 * tj + 8 * p;
        const bf16x8 b = tr_pair(yb, yb + 4 * MST);
        acc = __builtin_amdgcn_mfma_f32_16x16x32_bf16(a, b, acc, 0, 0, 0);
    }
    return acc;
}
__device__ __forceinline__ void st_b16(LAS unsigned char* M, int row, int col, float v) { *(LAS unsigned short*)(M + row * MST + col * 2) = (unsigned short)pk2(v, 0.f); }

__device__ __forceinline__ void p3b_gdn_prep(Frame& F) {
    LAS unsigned char* Kn = F.lds; LAS unsigned char* Qn = F.lds + 16384; LAS unsigned char* Vn = F.lds + 32768;
    LAS unsigned char* R0 = F.lds + 49152; LAS unsigned char* R1 = R0 + 9216; LAS unsigned char* R2 = R1 + 9216; LAS unsigned char* R3 = R2 + 9216; LAS unsigned char* R4 = R3 + 9216;
    LAS float* Af = (LAS float*)(F.lds + 95232);
    LAS float* CW = (LAS float*)(F.lds + 111872);
    LAS float* betaS = (LAS float*)(F.lds + 118016); LAS float* gS = betaS + 64; LAS float* gcS = gS + 64;
    const bf16_t* GQ = (const bf16_t*)(F.ws + WS_GQ); const float* BA = (const float*)(F.ws + WS_BA);
    bf16_t* UT = (bf16_t*)(F.ws + WS_UT); bf16_t* WM = (bf16_t*)(F.ws + WS_WM); bf16_t* QD = (bf16_t*)(F.ws + WS_QD); bf16_t* KDT = (bf16_t*)(F.ws + WS_KDT); bf16_t* QK = (bf16_t*)(F.ws + WS_QK);
    float* GT = (float*)(F.ws + WS_GT);
    const float* convw = inp(I_CONVW);
    LAS unsigned char* RAW = F.lds + 49152;
    u32x4 own[3][2], halo; float cwr[3], bar0 = 0.f, bar1 = 0.f;
#define PREP_LOAD(u_) do { const int t_ = opaque_tid(), tr_ = t_ >> 3, cg_ = t_ & 7, h_ = ((u_) >> 5) & 7, nch_ = (u_) & 31; const size_t t0_ = (size_t)((u_) >> 8) * SEQ + 64 * nch_; \
        _Pragma("unroll") for (int tens = 0; tens < 3; ++tens) { const bf16_t* src = GQ + (size_t)tens * T * 1024 + (t0_ + tr_) * 1024 + h_ * 128 + 16 * cg_; own[tens][0] = *(const u32x4*)src; own[tens][1] = *(const u32x4*)(src + 8); } \
        halo = (u32x4){0u, 0u, 0u, 0u}; \
        if (t_ < 144 && nch_ > 0) { const int tens = t_ / 48, rem = t_ % 48; halo = *(const u32x4*)(GQ + (size_t)tens * T * 1024 + (t0_ - 3 + (rem >> 4)) * 1024 + h_ * 128 + (rem & 15) * 8); } \
        _Pragma("unroll") for (int i = 0; i < 3; ++i) { const int ii = t_ + 512 * i; cwr[i] = convw[((ii >> 7) & 3) * 3072 + (ii >> 9) * 1024 + h_ * 128 + (ii & 127)]; } \
        if (cg_ == 0) { bar0 = BA[(t0_ + tr_) * 16 + h_]; bar1 = BA[(t0_ + tr_) * 16 + 8 + h_]; } } while (0)
    LAS unsigned char* const lds = F.lds; (void)lds;
    if (F.blk < 2048) { PREP_LOAD(F.blk); }
#pragma unroll 1
    for (int u = F.blk; u < 2048; u += F.G) {
        const int tid = opaque_tid(), lane = tid & 63, wave = __builtin_amdgcn_readfirstlane(tid >> 6), n = lane & 15, g = lane >> 4;
        const int h = (u >> 5) & 7, nch = u & 31;
        const int tr = tid >> 3, cg = tid & 7;
        TS_BEGIN();
        __syncthreads();
#pragma unroll
        for (int i = 0; i < 3; ++i) CW[tid + 512 * i] = cwr[i];
#pragma unroll
        for (int tens = 0; tens < 3; ++tens) { LAS unsigned char* rp = RAW + (tens * 67 + 3 + tr) * 272 + 32 * cg; *(LAS u32x4*)rp = own[tens][0]; *(LAS u32x4*)(rp + 16) = own[tens][1]; }
        if (tid < 144) { const int tens = tid / 48, rem = tid % 48; *(LAS u32x4*)(RAW + (tens * 67 + (rem >> 4)) * 272 + (rem & 15) * 16) = halo; }
        __syncthreads();
        TS_END(0);
        float qv[16], kv[16];
        {
            float vv[16];
#pragma unroll
            for (int tens = 0; tens < 3; ++tens) {
                float acc[16];
#pragma unroll
                for (int c = 0; c < 16; ++c) acc[c] = 0.f;
#pragma unroll
                for (int j = 0; j < 4; ++j) { const LAS unsigned char* rp = RAW + (tens * 67 + tr + j) * 272 + 32 * cg; const u32x4 x0 = *(const LAS u32x4*)rp, x1 = *(const LAS u32x4*)(rp + 16);
                        const LAS float* w = CW + (tens * 4 + j) * 128 + 16 * cg;
#pragma unroll
                        for (int i = 0; i < 4; ++i) { acc[2 * i] += w[2 * i] * bflo(x0[i]); acc[2 * i + 1] += w[2 * i + 1] * bfhi(x0[i]); acc[8 + 2 * i] += w[8 + 2 * i] * bflo(x1[i]); acc[9 + 2 * i] += w[9 + 2 * i] * bfhi(x1[i]); } }
#pragma unroll
                for (int c = 0; c < 16; ++c) { const float y = siluf_(acc[c]); if (tens == 0) qv[c] = y; else if (tens == 1) kv[c] = y; else vv[c] = y; }
            }
            float sq = 0.f, sk = 0.f;
#pragma unroll
            for (int c = 0; c < 16; ++c) { sq += qv[c] * qv[c]; sk += kv[c] * kv[c]; }
            sq = red8(sq); sk = red8(sk);
            const float rq = rsqrtf(sq + EPS) * 0.08838834764831845f, rk = rsqrtf(sk + EPS);
#pragma unroll
            for (int c = 0; c < 16; ++c) { qv[c] *= rq; kv[c] *= rk; }
#pragma unroll
            for (int hf = 0; hf < 2; ++hf) { u32x4 a, bq, cq;
#pragma unroll
                for (int i = 0; i < 4; ++i) { a[i] = pk2(kv[8 * hf + 2 * i], kv[8 * hf + 2 * i + 1]); bq[i] = pk2(qv[8 * hf + 2 * i], qv[8 * hf + 2 * i + 1]); cq[i] = pk2(vv[8 * hf + 2 * i], vv[8 * hf + 2 * i + 1]); }
                const unsigned o = off_b(tr, 2 * cg + hf);
                *(LAS u32x4*)(Kn + o) = a; *(LAS u32x4*)(Qn + o) = bq; *(LAS u32x4*)(Vn + o) = cq; }
        }
        if (cg == 0) { const float bb = bar0, aa = bar1; const float sp = aa + inp(I_DTB)[h]; const float spl = sp > 20.f ? sp : log1pf(__expf(sp));
            betaS[tr] = sigmoidf_(bb); gS[tr] = -__expf(inp(I_ALOG)[h]) * spl; }
        __syncthreads();
        TS_END(1);
        if (wave == 0) { float v = gS[lane];
#pragma unroll
            for (int d = 1; d < 64; d <<= 1) { const float t = __shfl_up(v, d); if (lane >= d) v += t; }
            gcS[lane] = v; }
        __syncthreads();
        {
            const float eg = __expf(gcS[tr]);
            u32x4 a, bq;
#pragma unroll
            for (int i = 0; i < 4; ++i) { a[i] = pk2(qv[2 * i] * eg, qv[2 * i + 1] * eg); bq[i] = pk2(qv[8 + 2 * i] * eg, qv[9 + 2 * i] * eg); }
            bf16_t* d = QD + (size_t)u * 8192 + (size_t)(((tr >> 4) * 4 + (cg >> 1)) * 64 + (tr & 15)) * 8;
            *(u32x4*)(d + (((2 * cg) & 3) * 16) * 8) = a; *(u32x4*)(d + (((2 * cg + 1) & 3) * 16) * 8) = bq;
        }
        if (u + F.G < 2048) { PREP_LOAD(u + F.G); }
        const float gcl = gcS[63];
        if (tid == 0) GT[u] = __expf(gcl);
        TS_END(2);
#pragma unroll
        for (int rep = 0; rep < 2; ++rep) {
            const int idx = wave + 8 * rep, ti = idx >> 2, tj = idx & 3;
            f32x4 kk = {0.f, 0.f, 0.f, 0.f}, qk = {0.f, 0.f, 0.f, 0.f};
            if (ti >= tj) {
#pragma unroll
                for (int ks = 0; ks < 4; ++ks) { const bf16x8 a = *(const LAS bf16x8*)(Kn + rowfrag_b(lane, ti, ks)), bb = *(const LAS bf16x8*)(Kn + rowfrag_b(lane, tj, ks));
                    kk = __builtin_amdgcn_mfma_f32_16x16x32_bf16(a, bb, kk, 0, 0, 0); }
#pragma unroll
                for (int ks = 0; ks < 4; ++ks) { const bf16x8 a = *(const LAS bf16x8*)(Kn + rowfrag_b(lane, tj, ks)), bb = *(const LAS bf16x8*)(Qn + rowfrag_b(lane, ti, ks));
                    qk = __builtin_amdgcn_mfma_f32_16x16x32_bf16(a, bb, qk, 0, 0, 0); }
            }
            {
                const int j = 16 * tj + n; const float gj = gcS[j]; const f32x4 gi4 = *(const LAS f32x4*)(gcS + 16 * ti + 4 * g), bi4 = *(const LAS f32x4*)(betaS + 16 * ti + 4 * g);
#pragma unroll
                for (int reg = 0; reg < 4; ++reg) { const int i = 16 * ti + 4 * g + reg; float v = 0.f; if (j < i) v = kk[reg] * bi4[reg] * __expf(gi4[reg] - gj);
                    Af[i * 65 + j] = v; st_b16(R0, i, j, ti > tj ? v : 0.f); }
            }
            {
                const int i = 16 * ti + n; const float gi = gcS[i]; const f32x4 gj4 = *(const LAS f32x4*)(gcS + 16 * tj + 4 * g); float o[4];
#pragma unroll
                for (int reg = 0; reg < 4; ++reg) { const int j = 16 * tj + 4 * g + reg; o[reg] = (j <= i) ? qk[reg] * __expf(gi - gj4[reg]) : 0.f; }
                u32x2 w; w.x = pk2(o[0], o[1]); w.y = pk2(o[2], o[3]);
                *(u32x2*)(QK + (size_t)u * 4096 + (size_t)((ti * 2 + (tj >> 1)) * 64 + ((2 * tj + (g >> 1)) & 3) * 16 + n) * 8 + 4 * (g & 1)) = w;
            }
        }
        for (int i = tid; i < 9216 / 4; i += 512) ((LAS unsigned*)R1)[i] = 0u;
        __syncthreads();
        TS_END(3);
        if (tid < 64) { const int bI = tid >> 4, cc = tid & 15; float x[16];
#pragma unroll
            for (int i = 0; i < 16; ++i) { float s = (i == cc) ? 1.f : 0.f;
#pragma unroll
                for (int j = 0; j < 16; ++j) if (j < i) s -= Af[(16 * bI + i) * 65 + 16 * bI + j] * x[j];
                x[i] = s; }
#pragma unroll
            for (int i = 0; i < 16; ++i) st_b16(R1, 16 * bI + i, 16 * bI + cc, x[i]); }
        __syncthreads();
        TS_END(4);
#pragma unroll
        for (int rep = 0; rep < 2; ++rep) { const int idx = wave + 8 * rep, ti = idx >> 2, tj = idx & 3; const f32x4 m = mm64_tile(R1, R0, ti, tj, lane);
#pragma unroll
            for (int reg = 0; reg < 4; ++reg) { const int i = 16 * ti + 4 * g + reg, j = 16 * tj + n; st_b16(R2, i, j, m[reg]); st_b16(R3, i, j, (i == j ? 1.f : 0.f) - m[reg]); } }
        __syncthreads();
#pragma unroll
        for (int rep = 0; rep < 2; ++rep) { const int idx = wave + 8 * rep, ti = idx >> 2, tj = idx & 3; const f32x4 m = mm64_tile(R2, R2, ti, tj, lane);
#pragma unroll
            for (int reg = 0; reg < 4; ++reg) { const int i = 16 * ti + 4 * g + reg, j = 16 * tj + n; st_b16(R4, i, j, (i == j ? 1.f : 0.f) + m[reg]); } }
        __syncthreads();
#pragma unroll
        for (int rep = 0; rep < 2; ++rep) { const int idx = wave + 8 * rep, ti = idx >> 2, tj = idx & 3; const f32x4 m = mm64_tile(R4, R1, ti, tj, lane);
#pragma unroll
            for (int reg = 0; reg < 4; ++reg) { const int i = 16 * ti + 4 * g + reg, j = 16 * tj + n; st_b16(R0, i, j, m[reg]); } }
        __syncthreads();
#pragma unroll
        for (int rep = 0; rep < 2; ++rep) { const int idx = wave + 8 * rep, ti = idx >> 2, tj = idx & 3; const f32x4 m = mm64_tile(R3, R0, ti, tj, lane);
            const int j = 16 * tj + n; const float bj = betaS[j], bw = bj * __expf(gcS[j]);
#pragma unroll
            for (int reg = 0; reg < 4; ++reg) { const int i = 16 * ti + 4 * g + reg; st_b16(R2, i, j, m[reg] * bj); st_b16(R4, i, j, m[reg] * bw); } }
        __syncthreads();
        TS_END(5);
        {
            const int tt = wave >> 1, dvb = 4 * (wave & 1);
#pragma unroll
            for (int k = 0; k < 4; ++k) { const int dvt = dvb + k; f32x4 acc = {0.f, 0.f, 0.f, 0.f};
#pragma unroll
                for (int ks = 0; ks < 2; ++ks) { const bf16x8 a = *(const LAS bf16x8*)(R2 + (16 * tt + n) * MST + 16 * (4 * ks + g));
                    const bf16x8 bb = tr_pair(Vn + trfrag_b(lane, dvt, ks, 0), Vn + trfrag_b(lane, dvt, ks, 1));
                    acc = __builtin_amdgcn_mfma_f32_16x16x32_bf16(a, bb, acc, 0, 0, 0); }
                u32x2 w; w.x = pk2(acc[0], acc[1]); w.y = pk2(acc[2], acc[3]);
                *(u32x2*)(UT + (size_t)u * 8192 + (size_t)((tt * 8 + dvt) * 64 + lane) * 4) = w; }
            const int dkt = wave;
#pragma unroll
            for (int t4 = 0; t4 < 4; ++t4) { f32x4 acc = {0.f, 0.f, 0.f, 0.f};
#pragma unroll
                for (int ks = 0; ks < 2; ++ks) { const bf16x8 a = tr_pair(Kn + trfrag_b(lane, dkt, ks, 0), Kn + trfrag_b(lane, dkt, ks, 1));
                    if (t4 == 0) {
                        const f32x4 e0 = *(const LAS f32x4*)(gcS + 32 * ks + 8 * g), e1 = *(const LAS f32x4*)(gcS + 32 * ks + 8 * g + 4); u32x4 w;
                        w[0] = pk2(bf2f((unsigned short)a[0]) * __expf(gcl - e0.x), bf2f((unsigned short)a[1]) * __expf(gcl - e0.y)); w[1] = pk2(bf2f((unsigned short)a[2]) * __expf(gcl - e0.z), bf2f((unsigned short)a[3]) * __expf(gcl - e0.w));
                        w[2] = pk2(bf2f((unsigned short)a[4]) * __expf(gcl - e1.x), bf2f((unsigned short)a[5]) * __expf(gcl - e1.y)); w[3] = pk2(bf2f((unsigned short)a[6]) * __expf(gcl - e1.z), bf2f((unsigned short)a[7]) * __expf(gcl - e1.w));
                        *(u32x4*)(KDT + (size_t)u * 8192 + (size_t)((dkt * 2 + ks) * 64 + lane) * 8) = w; }
                    const bf16x8 bb = *(const LAS bf16x8*)(R4 + (16 * t4 + n) * MST + 16 * (4 * ks + g));
                    acc = __builtin_amdgcn_mfma_f32_16x16x32_bf16(a, bb, acc, 0, 0, 0); }
                u32x2 w; w.x = pk2(acc[0], acc[1]); w.y = pk2(acc[2], acc[3]);
                *(u32x2*)(WM + (size_t)u * 8192 + (size_t)((t4 * 4 + (dkt >> 1)) * 64 + ((2 * dkt + (g >> 1)) & 3) * 16 + n) * 8 + 4 * (g & 1)) = w; }
        }
        TS_END(6);
    }
}

#undef PREP_LOAD
__device__ __forceinline__ void p4_gdn_scan(Frame& F) {
    if (F.blk >= 64) return;
    const int tid = opaque_tid(), lane = tid & 63, wave = __builtin_amdgcn_readfirstlane(tid >> 6), n = lane & 15, g = lane >> 4;
    const int b = F.blk >> 3, h = F.blk & 7; const size_t u0 = (size_t)F.blk * 32;
    LAS unsigned char* SbT0 = F.lds; LAS unsigned char* VNT = F.lds + 69632; LAS unsigned char* Os0 = F.lds + 88064; LAS float* ngS = (LAS float*)(F.lds + 122880);
    const bf16_t* UT = (const bf16_t*)(F.ws + WS_UT); const bf16_t* WM = (const bf16_t*)(F.ws + WS_WM); const bf16_t* QD = (const bf16_t*)(F.ws + WS_QD);
    const bf16_t* KDT = (const bf16_t*)(F.ws + WS_KDT); const bf16_t* QK = (const bf16_t*)(F.ws + WS_QK); const float* GT = (const float*)(F.ws + WS_GT);
    const bf16_t* GZ = (const bf16_t*)(F.ob + OUT_GZ); bf16_t* YA = (bf16_t*)(F.ws + WS_YA);
    const int tt = wave >> 1, dvb = 4 * (wave & 1);
    const int tok = tid >> 3, seg = tid & 7;
    f32x4 S[8];
#pragma unroll
    for (int i = 0; i < 8; ++i) S[i] = (f32x4){0.f, 0.f, 0.f, 0.f};
    if (tid < 128) ngS[tid] = inp(I_GNG)[tid];
    bf16x8 wfA[4], wfB[4], qdf[4], qkf[2], kdf[2]; u32x2 ufA[4], ufB[4]; u32x4 zc[2], zp[2]; float gtA, gtB;
    const unsigned lo_w = (unsigned)((tt * 4) * 64 + lane) * 16u, lo_u = (unsigned)((tt * 8 + dvb) * 64 + lane) * 8u, lo_qk = (unsigned)((tt * 2) * 64 + lane) * 16u,
                   lo_kd = (unsigned)((wave * 2) * 64 + lane) * 16u, lo_z = (unsigned)(tok * 1024 + h * 128 + 16 * seg) * 2u;
    const char* const pWM = (const char*)(WM + u0 * 8192); const char* const pQD = (const char*)(QD + u0 * 8192); const char* const pUT = (const char*)(UT + u0 * 8192);
    const char* const pKD = (const char*)(KDT + u0 * 8192); const char* const pQK = (const char*)(QK + u0 * 4096); const char* const pGZ = (const char*)(GZ + (size_t)b * SEQ * 1024);
#define LD_SET(X, nn_) do { const unsigned c16_ = (unsigned)(nn_) * 16384u; \
        _Pragma("unroll") for (int ks = 0; ks < 4; ++ks) wf##X[ks] = *(const bf16x8*)(pWM + (c16_ + lo_w + 1024u * ks)); \
        _Pragma("unroll") for (int k = 0; k < 4; ++k) uf##X[k] = *(const u32x2*)(pUT + (c16_ + lo_u + 512u * k)); \
        gt##X = GT[u0 + (nn_)]; } while (0)
#define LD_Q(nn_) do { const unsigned c16_ = (unsigned)(nn_) * 16384u, c8_ = (unsigned)(nn_) * 8192u; \
        _Pragma("unroll") for (int ks = 0; ks < 4; ++ks) qdf[ks] = *(const bf16x8*)(pQD + (c16_ + lo_w + 1024u * ks)); \
        _Pragma("unroll") for (int ks = 0; ks < 2; ++ks) qkf[ks] = *(const bf16x8*)(pQK + (c8_ + lo_qk + 1024u * ks)); } while (0)
#define LD_K(nn_) do { const unsigned c16_ = (unsigned)(nn_) * 16384u, cz_ = (unsigned)(nn_) * 131072u; \
        _Pragma("unroll") for (int ks = 0; ks < 2; ++ks) kdf[ks] = *(const bf16x8*)(pKD + (c16_ + lo_kd + 1024u * ks)); \
        zc[0] = *(const u32x4*)(pGZ + (cz_ + lo_z)); zc[1] = *(const u32x4*)(pGZ + (cz_ + lo_z + 16u)); } while (0)
#define NORM_OUT(OsB, nc_, Z) do { const size_t t = (size_t)b * SEQ + 64 * (nc_) + tok; \
        const u32x4 o0 = *(const LAS u32x4*)((OsB) + tok * 272 + 32 * seg), o1 = *(const LAS u32x4*)((OsB) + tok * 272 + 32 * seg + 16); float o[16]; float ss = 0.f; \
        _Pragma("unroll") for (int i = 0; i < 4; ++i) { o[2 * i] = bflo(o0[i]); o[2 * i + 1] = bfhi(o0[i]); o[8 + 2 * i] = bflo(o1[i]); o[9 + 2 * i] = bfhi(o1[i]); } \
        _Pragma("unroll") for (int i = 0; i < 16; ++i) ss += o[i] * o[i]; \
        ss = red8(ss); \
        const float rstd = rsqrtf(ss * (1.f / 128.f) + EPS); \
        u32x4 y0, y1; \
        _Pragma("unroll") for (int i = 0; i < 4; ++i) { y0[i] = pk2(o[2 * i] * rstd * ngS[16 * seg + 2 * i] * bflo(Z[0][i]), o[2 * i + 1] * rstd * ngS[16 * seg + 2 * i + 1] * bfhi(Z[0][i])); \
            y1[i] = pk2(o[8 + 2 * i] * rstd * ngS[16 * seg + 8 + 2 * i] * bflo(Z[1][i]), o[9 + 2 * i] * rstd * ngS[16 * seg + 9 + 2 * i] * bfhi(Z[1][i])); } \
        *(u32x4*)(YA + t * 1024 + h * 128 + 16 * seg) = y0; *(u32x4*)(YA + t * 1024 + h * 128 + 16 * seg + 8) = y1; } while (0)
#define CHUNK(X, nc_, P) do { LAS unsigned char* const SbT = SbT0 + (P) * 34816; LAS unsigned char* const OsW = Os0 + (P) * 17408; \
          \
        _Pragma("unroll") for (int dvt = 0; dvt < 8; ++dvt) { u32x2 w; w.x = pk2(S[dvt][0], S[dvt][1]); w.y = pk2(S[dvt][2], S[dvt][3]); \
            *(LAS u32x2*)(SbT + (16 * dvt + n) * 272 + (16 * wave + 4 * g) * 2) = w; } \
        __syncthreads(); \
          \
        if ((nc_) > 0) { NORM_OUT(Os0 + (1 - (P)) * 17408, (nc_) - 1, zp); } \
          \
        { f32x4 acc[4]; \
          _Pragma("unroll") for (int k = 0; k < 4; ++k) acc[k] = (f32x4){0.f, 0.f, 0.f, 0.f}; \
          _Pragma("unroll") for (int ks = 0; ks < 4; ++ks) { bf16x8 bb[4]; \
            _Pragma("unroll") for (int k = 0; k < 4; ++k) bb[k] = *(const LAS bf16x8*)(SbT + (16 * (dvb + k) + n) * 272 + 16 * (4 * ks + g)); \
            _Pragma("unroll") for (int k = 0; k < 4; ++k) acc[k] = __builtin_amdgcn_mfma_f32_16x16x32_bf16(wf##X[ks], bb[k], acc[k], 0, 0, 0); } \
          _Pragma("unroll") for (int k = 0; k < 4; ++k) { u32x2 w; w.x = pk2(bflo(uf##X[k].x) - acc[k][0], bfhi(uf##X[k].x) - acc[k][1]); w.y = pk2(bflo(uf##X[k].y) - acc[k][2], bfhi(uf##X[k].y) - acc[k][3]); \
            *(LAS u32x2*)(VNT + (16 * (dvb + k) + n) * MST + (16 * tt + 4 * g) * 2) = w; } } \
        __syncthreads(); \
          \
        { f32x4 acc[4]; \
          _Pragma("unroll") for (int k = 0; k < 4; ++k) acc[k] = (f32x4){0.f, 0.f, 0.f, 0.f}; \
          _Pragma("unroll") for (int ks = 0; ks < 4; ++ks) { bf16x8 bb[4]; \
            _Pragma("unroll") for (int k = 0; k < 4; ++k) bb[k] = *(const LAS bf16x8*)(SbT + (16 * (dvb + k) + n) * 272 + 16 * (4 * ks + g)); \
            _Pragma("unroll") for (int k = 0; k < 4; ++k) acc[k] = __builtin_amdgcn_mfma_f32_16x16x32_bf16(qdf[ks], bb[k], acc[k], 0, 0, 0); } \
          _Pragma("unroll") for (int ks = 0; ks < 2; ++ks) { bf16x8 bb[4]; \
            _Pragma("unroll") for (int k = 0; k < 4; ++k) bb[k] = *(const LAS bf16x8*)(VNT + (16 * (dvb + k) + n) * MST + 16 * (4 * ks + g)); \
            _Pragma("unroll") for (int k = 0; k < 4; ++k) acc[k] = __builtin_amdgcn_mfma_f32_16x16x32_bf16(qkf[ks], bb[k], acc[k], 0, 0, 0); } \
          _Pragma("unroll") for (int k = 0; k < 4; ++k) _Pragma("unroll") for (int reg = 0; reg < 4; ++reg) \
              *(LAS unsigned short*)(OsW + (16 * tt + 4 * g + reg) * 272 + (16 * (dvb + k) + n) * 2) = (unsigned short)pk2(acc[k][reg], 0.f); } \
        if ((nc_) + 1 < 32) { LD_Q((nc_) + 1); }     \
          \
        _Pragma("unroll") for (int dvt = 0; dvt < 8; ++dvt) S[dvt] = S[dvt] * gt##X; \
        _Pragma("unroll") for (int ks = 0; ks < 2; ++ks) { bf16x8 bb[8]; \
            _Pragma("unroll") for (int dvt = 0; dvt < 8; ++dvt) bb[dvt] = *(const LAS bf16x8*)(VNT + (16 * dvt + n) * MST + 16 * (4 * ks + g)); \
            _Pragma("unroll") for (int dvt = 0; dvt < 8; ++dvt) S[dvt] = __builtin_amdgcn_mfma_f32_16x16x32_bf16(kdf[ks], bb[dvt], S[dvt], 0, 0, 0); } \
        zp[0] = zc[0]; zp[1] = zc[1]; \
        if ((nc_) + 1 < 32) { LD_K((nc_) + 1); } \
    } while (0)
    LAS unsigned char* const lds = F.lds; (void)lds;
    LD_SET(A, 0); LD_Q(0); LD_K(0);
#pragma unroll 1
    for (int nc = 0; nc < 32; nc += 2) {
        LD_SET(B, nc + 1);
        CHUNK(A, nc, 0);
        if (nc + 2 < 32) { LD_SET(A, nc + 2); }
        CHUNK(B, nc + 1, 1);
    }
    __syncthreads();
    NORM_OUT(Os0 + 17408, 31, zp);
#undef LD_SET
#undef LD_Q
#undef LD_K
#undef NORM_OUT
#undef CHUNK
}

struct G2Unit { int e, mt, half; const unsigned char* Ap; const char* Bp; };
__device__ __forceinline__ G2Unit g2_unit(const Frame& F, const MoeTab& tb, int L, int NR) {
    G2Unit u; const int tile = L >> 1; u.half = L & 1;
    if (tile < NR) { u.e = tb.te[tile]; u.mt = tile - tb.tp[u.e]; u.Ap = F.ws + WS_ACT + (size_t)tile * 65536; u.Bp = (const char*)(F.ws + WS_WD) + ((size_t)u.e * 1024 + u.half * 512) * 256; }
    else { u.e = 64; u.mt = tile - NR; u.Ap = F.ws + WS_ACTS + (size_t)u.mt * 65536; u.Bp = (const char*)(F.ws + WS_WSD) + (size_t)(u.half * 512) * 256; }
    return u;
}
__device__ __forceinline__ void p8b_down(Frame& F, const MoeTab tb, const int xmode = 0) {
    if (xmode == 4) return;
    const int tid = opaque_tid(), lane = tid & 63, wave = __builtin_amdgcn_readfirstlane(tid >> 6), n = lane & 15, g = lane >> 4;
    LAS unsigned char* const Bs = F.lds;
    LAS int* const pairb = (LAS int*)(F.lds + INFO_OFF);
    const int* list = (const int*)(F.ws + WS_LIST);
    unsigned char* SLOT = F.ws + WS_SLOT; unsigned char* SH = F.ws + WS_SH;
    unsigned char* const dump = F.ws + WS_LSE + (size_t)F.blk * 1024 + lane * 16;
    const int NR = tb.tp[64], NU = (NR + 64) * 2;
    const int vblk = (F.G % 8 == 0) ? (F.blk % 8) * (F.G / 8) + F.blk / 8 : F.blk;
    int L = vblk; if (L >= NU) return;
    LAS unsigned char* const lds = F.lds; (void)lds; TS_DECL; TS_BEGIN();
    unsigned voff[2];
    { const int rho = 4 * wave + (lane >> 4), c = (lane & 15) ^ (rho & 15), ct = rho >> 4, gg = (rho >> 2) & 3, reg = rho & 3;
#pragma unroll
      for (int j = 0; j < 2; ++j) voff[j] = (unsigned)((16 * gg + 8 * j + 4 * ct + reg) * 256 + c * 16); }
#define G2_GLDS(src_, q_) __builtin_amdgcn_global_load_lds((const unsigned*)((src_) + (size_t)((q_) >> 1) * 16384 + voff[(q_) & 1]), (LAS unsigned*)(Bs + ((q_) & 7) * 8192 + wave * 1024), 16, 0, 0)
#define G2_PAIR_LD(u_, raw_) do { const int r_ = tid & 255; int idx_ = 0; if ((u_).e < 64) { const int pos_ = (u_).mt * 256 + r_; idx_ = pos_ < tb.cnt[(u_).e] ? (u_).e * T + pos_ : 0; } raw_ = list[idx_]; } while (0)
#define G2_PAIR_FIX(u_, raw_, dst_) do { const int r_ = tid & 255; if ((u_).e < 64) { const int pos_ = (u_).mt * 256 + r_; dst_ = pos_ < tb.cnt[(u_).e] ? raw_ : -1; } else dst_ = (u_).mt * 256 + r_; } while (0)
#define G2_ALOAD(u_, dst_) do { _Pragma("unroll") for (int rt = 0; rt < 2; ++rt) _Pragma("unroll") for (int kp = 0; kp < 4; ++kp) dst_[rt][kp] = *(const u32x4*)((u_).Ap + (size_t)(32 * wave + 16 * rt + n) * 256 + 64 * kp + 16 * g); } while (0)
    G2Unit cur = g2_unit(F, tb, L, NR);
    u32x4 af[2][4]; int pcur;
    { int raw; G2_PAIR_LD(cur, raw); G2_ALOAD(cur, af); G2_PAIR_FIX(cur, raw, pcur); }
    if (tid < 256) pairb[tid] = pcur;
#pragma unroll
    for (int t = 0; t < 6; ++t) G2_GLDS(cur.Bp, t);
#pragma unroll
    for (int rt = 0; rt < 2; ++rt)
#pragma unroll
        for (int kp = 0; kp < 4; ++kp) asm volatile("" : "+v"(af[rt][kp]));
    TS_END(50);
    while (true) {
        const int Ln = L + F.G; const bool hasn = Ln < NU;
        const G2Unit nxt = g2_unit(F, tb, hasn ? Ln : L, NR);
        u32x4 an[2][4]; int pn = -1, prow[2] = {-1, -1};
#pragma unroll
        for (int bp = 0; bp < 8; ++bp) {
            if (hasn && bp >= 5) asm volatile("s_waitcnt vmcnt(19)" ::: "memory"); else asm volatile("s_waitcnt vmcnt(10)" ::: "memory");
            __builtin_amdgcn_s_barrier();
            asm volatile("" ::: "memory");
#pragma unroll
            for (int j = 0; j < 2; ++j) { const int q = 2 * bp + 6 + j;
                if (q < 16) G2_GLDS(cur.Bp, q); else G2_GLDS(nxt.Bp, q - 16); }
            if (bp == 4 && hasn) { G2_ALOAD(nxt, an); G2_PAIR_LD(nxt, pn); }
            if (bp == 0) {
#pragma unroll
                for (int rt = 0; rt < 2; ++rt) prow[rt] = pairb[32 * wave + 16 * rt + n]; }
            f32x4 acc[2][2][2];
#pragma unroll
            for (int j = 0; j < 2; ++j) { const LAS unsigned char* bs = Bs + ((2 * bp + j) & 7) * 8192;
#pragma unroll
                for (int rt = 0; rt < 2; ++rt)
#pragma unroll
                    for (int ct = 0; ct < 2; ++ct) acc[j][rt][ct] = (f32x4){0.f, 0.f, 0.f, 0.f};
#pragma unroll
                for (int kk = 0; kk < 2; ++kk) {
                    const bf16x8 w00 = *(const LAS bf16x8*)(bs + n * 256 + (((8 * kk + g) ^ n) << 4)), w01 = *(const LAS bf16x8*)(bs + n * 256 + (((8 * kk + 4 + g) ^ n) << 4));
                    const bf16x8 w10 = *(const LAS bf16x8*)(bs + (16 + n) * 256 + (((8 * kk + g) ^ n) << 4)), w11 = *(const LAS bf16x8*)(bs + (16 + n) * 256 + (((8 * kk + 4 + g) ^ n) << 4));
#pragma unroll
                    for (int rt = 0; rt < 2; ++rt) { const bf16x8 a0 = __builtin_bit_cast(bf16x8, af[rt][2 * kk]), a1 = __builtin_bit_cast(bf16x8, af[rt][2 * kk + 1]);
                        acc[j][rt][0] = mfma_fp8_k128(w00, w01, a0, a1, acc[j][rt][0]); acc[j][rt][1] = mfma_fp8_k128(w10, w11, a0, a1, acc[j][rt][1]); }
                }
            }
            const int col = cur.half * 512 + 64 * bp + 16 * g; unsigned char* const obase = cur.e < 64 ? SLOT : SH;
#pragma unroll
            for (int rt = 0; rt < 2; ++rt) { const int p = prow[rt];
                constexpr float IS = 1.0f / WD_SCALE; u32x4 w;
#pragma unroll
                for (int j = 0; j < 2; ++j)
#pragma unroll
                    for (int ct = 0; ct < 2; ++ct) { int pk = 0; pk = __builtin_amdgcn_cvt_pk_fp8_f32(acc[j][rt][ct][0] * IS, acc[j][rt][ct][1] * IS, pk, false); pk = __builtin_amdgcn_cvt_pk_fp8_f32(acc[j][rt][ct][2] * IS, acc[j][rt][ct][3] * IS, pk, true); w[2 * j + ct] = (unsigned)pk; }
                *(u32x4*)(p >= 0 ? obase + (size_t)p * 1024 + col : dump) = w; }
        }
        TS_END(51);
        if (!hasn) break;
#pragma unroll
        for (int rt = 0; rt < 2; ++rt)
#pragma unroll
            for (int kp = 0; kp < 4; ++kp) af[rt][kp] = an[rt][kp];
        { int pf; G2_PAIR_FIX(nxt, pn, pf); if (tid < 256) pairb[tid] = pf; }
        cur = nxt; L = Ln;
        TS_END(50);
    }
#undef G2_GLDS
#undef G2_PAIR_LD
#undef G2_PAIR_FIX
#undef G2_ALOAD
}

constexpr size_t WS_WRH = 3 * MiB + 64 * 1024, WS_WRL = 3 * MiB + 192 * 1024;
__device__ __forceinline__ void p1_router_split(Frame& F) {
    const int gid = F.blk * 512 + opaque_tid();
    if (gid < 64 * 128) { const int e = gid >> 7, k0 = (gid & 127) * 8; const float* wr = inp(I_WR);
        u32x4 hi, lo;
#pragma unroll
        for (int i = 0; i < 4; ++i) { const float a = wr[(size_t)(k0 + 2 * i) * 64 + e], b = wr[(size_t)(k0 + 2 * i + 1) * 64 + e];
            const unsigned h = pk2(a, b); hi[i] = h; lo[i] = pk2(a - bflo(h), b - bfhi(h)); }
        *(u32x4*)((bf16_t*)(F.ws + WS_WRH) + (size_t)e * 1024 + k0) = hi; *(u32x4*)((bf16_t*)(F.ws + WS_WRL) + (size_t)e * 1024 + k0) = lo; }
}
__device__ __forceinline__ void p7_route(Frame& F, const bool emit) {
    const int ftid = opaque_tid(), flane = ftid & 63, fwave = __builtin_amdgcn_readfirstlane(ftid >> 6);
    constexpr int RS = 528, LS = 65;
    LAS unsigned char* Hhi = F.lds; LAS unsigned char* Hlo = F.lds + 64 * RS;
    LAS unsigned char* Whi = F.lds + 128 * RS; LAS unsigned char* Wlo = F.lds + 192 * RS;
    LAS float* Ls = (LAS float*)F.lds;
    LAS float* CandS = (LAS float*)(F.lds + 16896);
    LAS int* CandI = (LAS int*)(F.lds + 25088);
    LAS int* hist = (LAS int*)(F.lds + 33280);
    const float* MOD = (const float*)(F.ws + WS_MOD); const float* X = inp(I_X); const bf16_t* Y = (const bf16_t*)(F.ws + WS_Y); unsigned char* H2 = F.ws + WS_H;
    int* LIST = (int*)(F.ws + WS_LIST); float* LISTW = (float*)(F.ws + WS_LISTW); gu32* gcnt = (gu32*)(F.ws + WS_CTL) + CW_CNT;
    const bf16_t* WRH = (const bf16_t*)(F.ws + WS_WRH); const bf16_t* WRL = (const bf16_t*)(F.ws + WS_WRL);
    const int tid = ftid, lane = flane, wave = fwave, n = lane & 15, g = lane >> 4;
    LAS unsigned char* const lds = F.lds; (void)lds;
    for (int grp = F.blk; grp < T / 64; grp += F.G) {
        const int row0 = grp * 64, b = row0 / SEQ;
        TS_BEGIN();
        const float* sh2 = MOD + b * 6144 + 3 * 1024; const float* sc2 = sh2 + 1024;
        float rstd[8];
        f32x4 xx[8][4];
        {
#pragma unroll
          for (int rr = 0; rr < 8; ++rr) { const size_t ro = (size_t)(row0 + 8 * wave + rr) * DM + 4 * lane;
#pragma unroll
              for (int j = 0; j < 4; ++j) xx[rr][j] = *(const f32x4*)(X + ro + 256 * j); }
#pragma unroll
          for (int hb = 0; hb < 4; ++hb) { u32x2 yy[2][4];
#pragma unroll
            for (int rr = 0; rr < 2; ++rr) { const size_t ro = (size_t)(row0 + 8 * wave + 2 * hb + rr) * DM + 4 * lane;
#pragma unroll
                for (int j = 0; j < 4; ++j) yy[rr][j] = *(const u32x2*)(Y + ro + 256 * j); }
#pragma unroll
            for (int rr = 0; rr < 2; ++rr)
#pragma unroll
                for (int j = 0; j < 4; ++j) { const u32x2 y = yy[rr][j]; f32x4 v = xx[2 * hb + rr][j]; const f32x4 g1 = *(const f32x4*)(MOD + b * 6144 + 2048 + 256 * j + 4 * lane);
                    v.x += g1.x * bflo(y.x); v.y += g1.y * bfhi(y.x); v.z += g1.z * bflo(y.y); v.w += g1.w * bfhi(y.y); xx[2 * hb + rr][j] = v; }
            asm volatile("" ::: "memory"); } }
#pragma unroll
        for (int rr = 0; rr < 8; ++rr) { float ss = 0.f;
#pragma unroll
            for (int j = 0; j < 4; ++j) { const f32x4 v = xx[rr][j]; ss += (v.x * v.x + v.y * v.y) + (v.z * v.z + v.w * v.w); }
            rstd[rr] = rsqrtf(wave_sum(ss) * (1.f / DM) + EPS); }
        TS_END(10);
        f32x4 acc0 = {0.f, 0.f, 0.f, 0.f}, acc1 = {0.f, 0.f, 0.f, 0.f};
        const int rt = wave & 3, et = (wave >> 2) * 2;
        u32x4 wnh[4], wnl[4];
#define P7_LOADX(c_) do { \
        _Pragma("unroll") for (int i = 0; i < 4; ++i) { const int e = (tid >> 5) + 16 * i, kc = (tid & 31) * 8; wnh[i] = *(const u32x4*)(WRH + (size_t)e * 1024 + (c_) * 256 + kc); wnl[i] = *(const u32x4*)(WRL + (size_t)e * 1024 + (c_) * 256 + kc); } } while (0)
        P7_LOADX(0);
#pragma unroll
        for (int c = 0; c < 4; ++c) {
            const int tid = opaque_tid(), lane = tid & 63, n = lane & 15, g = lane >> 4;
            const int k = c * 256 + 4 * lane;
            const f32x4 g2 = *(const f32x4*)(inp(I_GFFN) + k), s2 = *(const f32x4*)(sc2 + k) + 1.0f, h2 = *(const f32x4*)(sh2 + k);
#pragma unroll
            for (int rr = 0; rr < 8; ++rr) { const size_t row = (size_t)(row0 + 8 * wave + rr);
                const f32x4 hv = (xx[rr][c] * rstd[rr]) * (g2 * s2) + h2;
                u32x2 hi, lo; hi.x = pk2(hv.x, hv.y); hi.y = pk2(hv.z, hv.w);
                lo.x = pk2(hv.x - bflo(hi.x), hv.y - bfhi(hi.x)); lo.y = pk2(hv.z - bflo(hi.y), hv.w - bfhi(hi.y));
                *(LAS u32x2*)(Hhi + (8 * wave + rr) * RS + 8 * lane) = hi; *(LAS u32x2*)(Hlo + (8 * wave + rr) * RS + 8 * lane) = lo;
                { int w8 = 0; w8 = __builtin_amdgcn_cvt_pk_fp8_f32(hv.x, hv.y, w8, false); w8 = __builtin_amdgcn_cvt_pk_fp8_f32(hv.z, hv.w, w8, true); *(unsigned*)(H2 + row * DM + k) = (unsigned)w8; } }
#pragma unroll
            for (int i = 0; i < 4; ++i) { const int e = (tid >> 5) + 16 * i, kc = (tid & 31) * 16; *(LAS u32x4*)(Whi + e * RS + kc) = wnh[i]; *(LAS u32x4*)(Wlo + e * RS + kc) = wnl[i]; }
            __syncthreads();
            if (c < 3) { P7_LOADX(c + 1); }
#pragma unroll
            for (int ks = 0; ks < 8; ++ks) {
                const bf16x8 ah = *(const LAS bf16x8*)(Hhi + (16 * rt + n) * RS + 64 * ks + 16 * g), al = *(const LAS bf16x8*)(Hlo + (16 * rt + n) * RS + 64 * ks + 16 * g);
                const bf16x8 b0h = *(const LAS bf16x8*)(Whi + (16 * et + n) * RS + 64 * ks + 16 * g), b0l = *(const LAS bf16x8*)(Wlo + (16 * et + n) * RS + 64 * ks + 16 * g);
                const bf16x8 b1h = *(const LAS bf16x8*)(Whi + (16 * et + 16 + n) * RS + 64 * ks + 16 * g), b1l = *(const LAS bf16x8*)(Wlo + (16 * et + 16 + n) * RS + 64 * ks + 16 * g);
                acc0 = __builtin_amdgcn_mfma_f32_16x16x32_bf16(al, b0h, acc0, 0, 0, 0); acc1 = __builtin_amdgcn_mfma_f32_16x16x32_bf16(al, b1h, acc1, 0, 0, 0);
                acc0 = __builtin_amdgcn_mfma_f32_16x16x32_bf16(ah, b0l, acc0, 0, 0, 0); acc1 = __builtin_amdgcn_mfma_f32_16x16x32_bf16(ah, b1l, acc1, 0, 0, 0);
                acc0 = __builtin_amdgcn_mfma_f32_16x16x32_bf16(ah, b0h, acc0, 0, 0, 0); acc1 = __builtin_amdgcn_mfma_f32_16x16x32_bf16(ah, b1h, acc1, 0, 0, 0);
                if (ks & 1) asm volatile("" ::: "memory");
            }
            __syncthreads();
        }
#undef P7_LOADX
#pragma unroll
        for (int reg = 0; reg < 4; ++reg) { const int r = rt * 16 + 4 * g + reg; Ls[r * LS + et * 16 + n] = acc0[reg]; Ls[r * LS + et * 16 + 16 + n] = acc1[reg]; }
        if (tid < 128) hist[tid] = 0;
        __syncthreads();
        TS_END(11);
        {
            const int tid = opaque_tid(), lane = tid & 63;
            const int r = tid >> 3, q = tid & 7;
            float s[8], sel[8];
#pragma unroll
            for (int i = 0; i < 8; ++i) { s[i] = sigmoidf_(Ls[r * LS + q * 8 + i]); sel[i] = s[i] + inp(I_RB)[q * 8 + i]; }
            float m1 = -INFINITY, m2 = -INFINITY;
#pragma unroll
            for (int i = 0; i < 8; ++i) { const float v = sel[i]; if (v > m1) { m2 = m1; m1 = v; } else if (v > m2) m2 = v; }
            const float gs = m1 + m2;
            int rank = 0;
#pragma unroll
            for (int j = 0; j < 8; ++j) { const float o = __shfl(gs, (lane & ~7) + j); rank += ((o > gs) || (o == gs && j < q)) ? 1 : 0; }
            const bool gsel = rank < 4;
            const unsigned long long bal = __ballot(gsel); const unsigned gm = (unsigned)(bal >> (lane & ~7)) & 0xffu;
            const int slot = __builtin_popcount(gm & ((1u << q) - 1u));
            if (gsel) {
#pragma unroll
                for (int i = 0; i < 8; ++i) { CandS[r * 32 + slot * 8 + i] = sel[i]; CandI[r * 32 + slot * 8 + i] = q * 8 + i; } }
            __syncthreads();
            int cn[8];
#pragma unroll
            for (int i = 0; i < 8; ++i) cn[i] = 0;
            for (int j = 0; j < 32; ++j) { const float o = CandS[r * 32 + j]; const int oi = CandI[r * 32 + j];
#pragma unroll
                for (int i = 0; i < 8; ++i) cn[i] += ((o > sel[i]) || (o == sel[i] && oi < q * 8 + i)) ? 1 : 0; }
            float part = 0.f;
#pragma unroll
            for (int i = 0; i < 8; ++i) if (gsel && cn[i] < 8) part += s[i];
            part = red8(part);
            const float inv = 2.5f / part;
            TS_END(12);
            int lp[8];
#pragma unroll
            for (int i = 0; i < 8; ++i) { lp[i] = -1; if (emit && gsel && cn[i] < 8) lp[i] = atomicAdd((int*)(hist + q * 8 + i), 1); }
            __syncthreads();
            if (emit && tid < 64) hist[64 + tid] = (int)__hip_atomic_fetch_add(gcnt + tid, (unsigned)hist[tid], RLX_AGENT);
            __syncthreads();
#pragma unroll
            for (int i = 0; i < 8; ++i) if (lp[i] >= 0) { const int e = q * 8 + i; const size_t li = (size_t)e * T + hist[64 + e] + lp[i]; LIST[li] = (row0 + r) * 8 + cn[i]; LISTW[li] = s[i] * inv; }
            __syncthreads();
            TS_END(13);
        }
    }
}

__device__ __forceinline__ void p9_combine(Frame& F) {
    const int tid = opaque_tid();
    const float* MOD = (const float*)(F.ws + WS_MOD); const unsigned char* SLOT = F.ws + WS_SLOT; const unsigned char* SH = F.ws + WS_SH; float* out = F.out; const float* X = inp(I_X); const bf16_t* Y = (const bf16_t*)(F.ws + WS_Y);
#ifdef PROBE_SEL
#ifndef PROBE_DIV
#define PROBE_DIV 100000.0f
#endif
#ifndef PROBE_Q
#define PROBE_Q 1000
#endif
    const float pscale_ = 1.0f + (float)((__hip_atomic_load(&g_ts[PROBE_SEL], __ATOMIC_RELAXED, __HIP_MEMORY_SCOPE_AGENT) + PROBE_Q / 2) / PROBE_Q * PROBE_Q) / PROBE_DIV;
#endif
    for (size_t it = (size_t)F.blk * 512 + tid; it < (size_t)T * 64; it += (size_t)F.G * 512) {
        const size_t t = it >> 6; const int c0 = (int)(it & 63) * 16; const int b = (int)(t / SEQ);
        u32x4 sl[8];
#pragma unroll
        for (int k = 0; k < 8; ++k) sl[k] = *(const u32x4*)(SLOT + (t * 8 + k) * 1024 + c0);
        const u32x4 s8 = *(const u32x4*)(SH + t * 1024 + c0);
        f32x4 xv[4], gv[4];
#pragma unroll
        for (int i = 0; i < 4; ++i) { xv[i] = *(const f32x4*)(X + t * 1024 + c0 + 4 * i); gv[i] = *(const f32x4*)(MOD + b * 6144 + 5 * 1024 + c0 + 4 * i); }
        { const u32x4 y0 = *(const u32x4*)(Y + t * 1024 + c0), y1 = *(const u32x4*)(Y + t * 1024 + c0 + 8);
#pragma unroll
          for (int i = 0; i < 4; ++i) { const f32x4 g1 = *(const f32x4*)(MOD + b * 6144 + 2048 + c0 + 4 * i); const unsigned w0 = i < 2 ? y0[2 * i] : y1[2 * i - 4], w1 = i < 2 ? y0[2 * i + 1] : y1[2 * i - 3];
            xv[i].x += g1.x * bflo(w0); xv[i].y += g1.y * bfhi(w0); xv[i].z += g1.z * bflo(w1); xv[i].w += g1.w * bfhi(w1); } }
        float acc[16];
#pragma unroll
        for (int i = 0; i < 4; ++i) { const f32x2 lo = __builtin_amdgcn_cvt_pk_f32_fp8((int)s8[i], false), hi = __builtin_amdgcn_cvt_pk_f32_fp8((int)s8[i], true); acc[4 * i] = lo.x; acc[4 * i + 1] = lo.y; acc[4 * i + 2] = hi.x; acc[4 * i + 3] = hi.y; }
#pragma unroll
        for (int k = 0; k < 8; ++k)
#pragma unroll
            for (int i = 0; i < 4; ++i) { const f32x2 lo = __builtin_amdgcn_cvt_pk_f32_fp8((int)sl[k][i], false), hi = __builtin_amdgcn_cvt_pk_f32_fp8((int)sl[k][i], true);
                acc[4 * i] += lo.x; acc[4 * i + 1] += lo.y; acc[4 * i + 2] += hi.x; acc[4 * i + 3] += hi.y; }
#pragma unroll
        for (int i = 0; i < 4; ++i) { f32x4 o; o.x = xv[i].x + gv[i].x * acc[4 * i]; o.y = xv[i].y + gv[i].y * acc[4 * i + 1]; o.z = xv[i].z + gv[i].z * acc[4 * i + 2]; o.w = xv[i].w + gv[i].w * acc[4 * i + 3];
#ifdef PROBE_SEL
            o = o * pscale_;
#endif
            *(f32x4*)(out + t * 1024 + c0 + 4 * i) = o; }
    }
}

struct Args { const float* in[24]; float* out; unsigned char* ws; };
__global__ void __launch_bounds__(512, 2) mega_fwd(Args args) {
    extern __shared__ __attribute__((aligned(16))) unsigned char lds_raw[];
    Frame F;
    F.lds = (LAS unsigned char*)lds_raw;
    F.G = gridDim.x; F.blk = blockIdx.x;
    F.out = args.out; F.ws = args.ws; F.ob = (unsigned char*)args.out;
    volatile LAS unsigned* MISC = (volatile LAS unsigned*)(F.lds + MISC_OFF);
    for (int u = threadIdx.x; u < 64; u += 512) MISC[u] = 0u;
    __syncthreads();
    XcdBarrier bar = xcd_barrier_post((unsigned*)(F.ws + WS_CTL) + CW_BAR, MISC + 8);
#ifdef PROBE_SEL
    int tsi_ = 0;
    volatile LAS unsigned long long* const tsl_ = (volatile LAS unsigned long long*)(F.lds + MISC_OFF + 72);
    if (blockIdx.x == PROBE_BLK && threadIdx.x == 0) { for (int k = 0; k < 64; ++k) g_ts[k] = 0; *tsl_ = __builtin_amdgcn_s_memrealtime(); }
#define GRID_BAR() do { xcd_barrier(bar); if (blockIdx.x == PROBE_BLK && threadIdx.x == 0) { const unsigned long long t_ = __builtin_amdgcn_s_memrealtime(); g_ts[32 + tsi_] += t_ - *tsl_; *tsl_ = t_; } ++tsi_; } while (0)
#else
#define GRID_BAR() xcd_barrier(bar)
#endif
    unsigned char* ws = F.ws;
    const float* MOD = (const float*)(ws + WS_MOD);

#ifndef DUPMASK
#define DUPMASK 0
#endif
#define REP(k) _Pragma("unroll 1") for (int rep_ = 0; rep_ < (((DUPMASK) >> (k)) & 1 ? 2 : 1); ++rep_)
    REP(0) { p0_mod(F); }
    GRID_BAR();
    REP(1) { p1_norm(F); }
    __syncthreads();
    p0_weights(F);
    p1_router_split(F);
    GRID_BAR();
    REP(2) { pg8::DenseOrder S; S.init(T, NPROJ, 1024, F.G, F.blk, ws + WS_H, ws + WS_WIN);
      EpiProj E{ws, (bf16_t*)(F.ob + OUT_GZ)};
      pg8::gemm_phase<EpiProj, pg8::DenseOrder, true, false>(F.lds, 1024, S, E); }
    GRID_BAR();
    REP(3) { p3_attn(F); }
    GRID_BAR();
    REP(4) { p3b_gdn_prep(F); }
    GRID_BAR();
    { LAS unsigned char* const lds = F.lds; (void)lds; TS_BEGIN(); }
    REP(6) { p4_gdn_scan(F); }
    { LAS unsigned char* const lds = F.lds; (void)lds; if (F.blk < 64) { TS_END(24); } }
    REP(5) { p3_merge(F, 64, F.G - 64); }
    REP(12) { convert_experts(F, 64, F.G - 64); }
    GRID_BAR();
    REP(7) {
    { pg8::DenseOrder S; S.init(T, 1024, 1024, F.G, F.blk, ws + WS_YA, ws + WS_WUPG); EpiStore E{(bf16_t*)(ws + WS_UA), 1024};
      pg8::gemm_phase<EpiStore, pg8::DenseOrder, true, false>(F.lds, 1024, S, E); }
    { pg8::DenseOrder S; S.init(T, 1024, 512, F.G, F.blk, F.ob + OUT_YB, ws + WS_WUPD); EpiStore E{(bf16_t*)(ws + WS_UB), 1024};
      pg8::gemm_phase<EpiStore, pg8::DenseOrder, true, false>(F.lds, 512, S, E); }
    }
    REP(8) { pg8::LocalGateOrder S; S.init(T, 1024, F.G, F.blk, ws + WS_H, ws + WS_WG); EpiGate E{(const bf16_t*)(ws + WS_UA), (const bf16_t*)(ws + WS_UB), (bf16_t*)(ws + WS_MG)};
      pg8::gemm_phase<EpiGate, pg8::LocalGateOrder, true, false>(F.lds, 1024, S, E); }
    GRID_BAR();
    REP(9) { pg8::DenseOrder S; S.init(T, 1024, 1024, F.G, F.blk, ws + WS_MG, ws + WS_WOUT); EpiStore E{(bf16_t*)(ws + WS_Y), 1024};
      pg8::gemm_phase<EpiStore, pg8::DenseOrder, true, false>(F.lds, 1024, S, E); }
    GRID_BAR();
    if ((DUPMASK >> 13) & 1) p7_route(F, false);
    p7_route(F, true);
    GRID_BAR();
    REP(10) { MoeTab tb = build_moetab(F);
      G1Order S{tb, F.G, F.blk, (const int*)(ws + WS_LIST), (const char*)(ws + WS_H), (const char*)(ws + WS_WGU), (const char*)(ws + WS_WSGU)};
      LAS int* tokb = (LAS int*)(F.lds + INFO_OFF); LAS float* wkb = (LAS float*)(F.lds + INFO_OFF + 6144);
      S.preload(tokb, wkb, (const float*)(ws + WS_LISTW));
      EpiAct E{tb, wkb, ws + WS_ACT, ws + WS_ACTS};
      pg8::gemm_phase<EpiAct, G1Order, true, true, true>(F.lds, 512, S, E, tokb); }
    GRID_BAR();
#ifndef P8B_REPS
#define P8B_REPS 1
#endif
#ifndef P8B_XMODE
#define P8B_XMODE 0
#endif
    for (int r8_ = 0; r8_ < P8B_REPS; ++r8_) { REP(11) { MoeTab tb = build_moetab(F); p8b_down(F, tb, r8_ < P8B_REPS - 1 ? P8B_XMODE : 0); }
    GRID_BAR(); }
    if ((DUPMASK >> 14) & 1) { for (int r_ = 0; r_ < 13; ++r_) GRID_BAR(); }
#ifdef PROBE_SEL
    { __threadfence(); }
#endif
    p9_combine(F);
#undef REP
#undef GRID_BAR
}

extern "C" void kernel_launch(void* const* d_in, const int* in_sizes, int n_in, void* d_out, int out_size, void* d_ws, size_t ws_size, hipStream_t stream) {
    static int grid = 0;
    if (grid == 0) {
        if (n_in != 24 || out_size != T * DM || ws_size < WS_END) { fprintf(stderr, "kernel_launch: unexpected shapes / workspace (n_in %d out %d ws %zu, need %zu)\n", n_in, out_size, ws_size, (size_t)WS_END); grid = -1; return; }
        int dev = 0, cus = 0;
        if (hipGetDevice(&dev) != hipSuccess || hipDeviceGetAttribute(&cus, hipDeviceAttributeMultiprocessorCount, dev) != hipSuccess) { grid = -1; return; }
        if (hipFuncSetAttribute((const void*)mega_fwd, hipFuncAttributeMaxDynamicSharedMemorySize, LDS_BYTES) != hipSuccess) { fprintf(stderr, "kernel_launch: hipFuncSetAttribute failed\n"); grid = -1; return; }
        int per_cu = 0;
        if (hipOccupancyMaxActiveBlocksPerMultiprocessor(&per_cu, (const void*)mega_fwd, 512, LDS_BYTES) != hipSuccess || per_cu < 1) fprintf(stderr, "kernel_launch: occupancy query reports %d blocks per CU\n", per_cu);
        (void)hipGetLastError();
        grid = cus;
    }
    if (grid < 0) return;
    if (hipMemsetAsync((char*)d_ws + WS_CTL, 0, CTL_ZERO_BYTES, stream) != hipSuccess) return;
    Args a{};
    for (int i = 0; i < 24; ++i) a.in[i] = (const float*)d_in[i];
    a.out = (float*)d_out; a.ws = (unsigned char*)d_ws;
    hipLaunchKernelGGL(mega_fwd, dim3(grid), dim3(512), LDS_BYTES, stream, a);
}
```

```cpp
#include <hip/hip_runtime.h>
#include <cstdio>
#include <cstdint>

#define LAS __attribute__((address_space(3)))
#define GAS __attribute__((address_space(1)))
typedef unsigned short bf16_t;
typedef short bf16x8 __attribute__((ext_vector_type(8)));
typedef float f32x2 __attribute__((ext_vector_type(2)));
typedef float f32x4 __attribute__((ext_vector_type(4)));
typedef unsigned u32x2 __attribute__((ext_vector_type(2)));
typedef long i64x2 __attribute__((ext_vector_type(2)));
typedef unsigned u32x4 __attribute__((ext_vector_type(4)));

#ifdef PROBE_SEL
#ifndef PROBE_BLK
#define PROBE_BLK 0
#endif
__device__ unsigned long long g_ts[64];
#define TS_SLOT(ldsbase) ((volatile __attribute__((address_space(3))) unsigned*)((ldsbase) + 143424))
#define TS_DECL
#define TS_BEGIN() do { if (blockIdx.x == PROBE_BLK && threadIdx.x == 0) *TS_SLOT(lds) = (unsigned)__builtin_amdgcn_s_memrealtime(); } while (0)
#define TS_END(k) do { if (blockIdx.x == PROBE_BLK && threadIdx.x == 0) { const unsigned t1_ = (unsigned)__builtin_amdgcn_s_memrealtime(); g_ts[k] += (unsigned long long)(t1_ - *TS_SLOT(lds)); *TS_SLOT(lds) = t1_; } } while (0)
#else
#define TS_DECL
#define TS_BEGIN() do {} while (0)
#define TS_END(k) do {} while (0)
#endif

constexpr int BATCH = 8, SEQ = 2048, DM = 1024, T = BATCH * SEQ;
constexpr int IN_W = 10768;
constexpr int NPROJ = 8704;
constexpr int NEXP = 64, DEXP = 256;
constexpr float EPS = 1e-6f;

__device__ __forceinline__ unsigned f2bf(float f) { unsigned u = __builtin_bit_cast(unsigned, f); return (u + 0x7fffu + ((u >> 16) & 1u)) >> 16; }
typedef __bf16 bf16x2_t __attribute__((ext_vector_type(2)));
__device__ __forceinline__ unsigned pk2(float lo, float hi) { const f32x2 v = {lo, hi}; const bf16x2_t b = __builtin_convertvector(v, bf16x2_t); return __builtin_bit_cast(unsigned, b); }
__device__ __forceinline__ float bf2f(unsigned h) { return __builtin_bit_cast(float, h << 16); }
__device__ __forceinline__ float bflo(unsigned w) { return __builtin_bit_cast(float, w << 16); }
__device__ __forceinline__ float bfhi(unsigned w) { return __builtin_bit_cast(float, w & 0xffff0000u); }
__device__ __forceinline__ float sigmoidf_(float x) { return __builtin_amdgcn_rcpf(1.0f + __builtin_amdgcn_exp2f(-1.4426950408889634f * x)); }
__device__ __forceinline__ float siluf_(float x) { return x * __builtin_amdgcn_rcpf(1.0f + __builtin_amdgcn_exp2f(-1.4426950408889634f * x)); }
__device__ __forceinline__ int opaque_tid() { int t = threadIdx.x; asm volatile("" : "+v"(t)); return t; }
template <int CTRL> __device__ __forceinline__ float dppf(float v) { return __builtin_bit_cast(float, __builtin_amdgcn_update_dpp(0, __builtin_bit_cast(int, v), CTRL, 0xF, 0xF, true)); }
__device__ __forceinline__ float red4(float v) { v += dppf<0xB1>(v); v += dppf<0x4E>(v); return v; }
__device__ __forceinline__ float red8(float v) { v = red4(v); v += dppf<0x141>(v); return v; }
__device__ __forceinline__ float red16(float v) { v = red8(v); v += dppf<0x140>(v); return v; }
__device__ __forceinline__ float wave_sum(float v) { v = red16(v); v += __shfl_xor(v, 16); v += __shfl_xor(v, 32); return v; }

typedef int i32x8 __attribute__((ext_vector_type(8)));
__device__ __forceinline__ f32x4 mfma_fp8_k128(bf16x8 a0, bf16x8 a1, bf16x8 b0, bf16x8 b1, f32x4 c) {
    const u32x4 x0 = __builtin_bit_cast(u32x4, a0), x1 = __builtin_bit_cast(u32x4, a1), y0 = __builtin_bit_cast(u32x4, b0), y1 = __builtin_bit_cast(u32x4, b1);
    const i32x8 a = {(int)x0.x, (int)x0.y, (int)x0.z, (int)x0.w, (int)x1.x, (int)x1.y, (int)x1.z, (int)x1.w}, b = {(int)y0.x, (int)y0.y, (int)y0.z, (int)y0.w, (int)y1.x, (int)y1.y, (int)y1.z, (int)y1.w};
    return __builtin_amdgcn_mfma_scale_f32_16x16x128_f8f6f4(a, b, c, 0, 0, 0, 0x7F7F7F7F, 0, 0x7F7F7F7F);
}
__device__ __forceinline__ __amdgpu_buffer_rsrc_t wt_rsrc(void* base, unsigned bytes) { return __builtin_amdgcn_make_buffer_rsrc(base, (short)0, (int)bytes, 0x00020000); }
__device__ __forceinline__ void st16_wt(__amdgpu_buffer_rsrc_t r, unsigned off, u32x4 v) { __builtin_amdgcn_raw_buffer_store_b128(v, r, off, 0, 16); }
namespace pg8 {
#define PG8_LAS __attribute__((address_space(3)))
constexpr int BM = 256, BK = 64, HALF = 128, HTB = HALF * BK * 2, STAGE_BYTES = 8 * HTB, NXCD = 8, WGM = 8;

__host__ __device__ __forceinline__ int lds_byte(int r, int c) { const int st = (r >> 4) * 2 + (c >> 5), rr = r & 15, cc = c & 31, ob = rr * 64 + cc * 2; return st * 1024 + (ob ^ (((ob >> 9) & 1) << 5)); }
__host__ __device__ __forceinline__ void stage_rc(int b, int& R, int& C) { const int st = b / 1024, sb = b % 1024, swz = sb ^ (((sb >> 9) & 1) << 5); R = (st >> 1) * 16 + swz / 64; C = (st & 1) * 32 + (swz % 64) / 2; }
__host__ __device__ __forceinline__ int perm32(int rho) { const int n = rho >> 4, i = rho & 15; return 8 * (i >> 2) + 4 * n + (i & 3); }

struct Unit { int pm, pn; const char* Ap; const char* Bp; int e, mt; };

struct DenseOrder {
    int nM, nN, nwg, G, c; const char* A; const char* Bt; size_t tstep;
    __device__ __forceinline__ void init(int M, int N, int K, int G_, int c_, const void* A_, const void* Bt_) { nM = M / BM; nN = N / BM; nwg = nM * nN; G = G_; c = c_; A = (const char*)A_; Bt = (const char*)Bt_; tstep = (size_t)BM * K * 2; }
    __device__ __forceinline__ bool next(int i, Unit& u) const {
        const long L = (long)i * G + c; if (L >= nwg) return false;
        int wgid = (int)L; { const int q = nwg / NXCD, r = nwg % NXCD, xcd = wgid % NXCD, off = wgid / NXCD; wgid = (xcd < r ? xcd * (q + 1) : r * (q + 1) + (xcd - r) * q) + off; }
        const int nig = WGM * nN, gid = wgid / nig, fm = gid * WGM, gsz = (nM - fm) < WGM ? (nM - fm) : WGM;
        u.pm = fm + ((wgid % nig) % gsz); u.pn = (wgid % nig) / gsz; u.Ap = A + (size_t)u.pm * tstep; u.Bp = Bt + (size_t)u.pn * tstep; u.e = 0; u.mt = 0; return true;
    }
    __device__ __forceinline__ unsigned a_off(const Unit&, int r, int K) const { return (unsigned)(r * K) * 2u; }
};

struct LocalGateOrder {
    DenseOrder D; const char* A; const char* Bt; size_t tstep;
    __device__ __forceinline__ void init(int M, int K, int G_, int c_, const void* A_, const void* Bt_) { D.init(M, 1024, K, G_, c_, A_, Bt_); A = (const char*)A_; Bt = (const char*)Bt_; tstep = (size_t)BM * K * 2; }
    __device__ __forceinline__ bool next(int i, Unit& u) const {
        Unit t; if (!D.next(i >> 1, t)) return false;
        u.pm = t.pm; u.pn = 2 * t.pn + (i & 1); u.Ap = A + (size_t)u.pm * tstep; u.Bp = Bt + (size_t)u.pn * tstep; u.e = 0; u.mt = 0; return true;
    }
    __device__ __forceinline__ unsigned a_off(const Unit&, int r, int K) const { return (unsigned)(r * K) * 2u; }
};

__device__ __forceinline__ unsigned cvt_pk_bf16(float lo, float hi) { unsigned r; asm volatile("v_cvt_pk_bf16_f32 %0, %1, %2" : "=v"(r) : "v"(lo), "v"(hi)); return r; }

template <class Epi, class Sched, bool ALIGN_EPI, bool GATHER, bool FP8 = false>
__device__ __forceinline__ void gemm_phase(PG8_LAS unsigned char* lds, const int K, const Sched& S, const Epi& E, PG8_LAS int* tokb = nullptr) {
    const int tid = opaque_tid(), wid = __builtin_amdgcn_readfirstlane(tid >> 6), lane = tid & 63, wr = wid >> 2, wc = wid & 3, fr = lane & 15, fq = lane >> 4;
    const int nt = K / BK;
    unsigned voffB[2];
#pragma unroll
    for (int i = 0; i < 2; ++i) { int R, C; stage_rc(tid * 16 + i * 8192, R, C); const int Rb = Epi::PERM ? ((R & ~31) + perm32(R & 31)) : R;
        voffB[i] = (unsigned)(Rb * K + C) * 2u; }
    const size_t kstep = (size_t)(BK * 2);
    const size_t hstep = (size_t)HALF * K * 2;
    const unsigned ldsw = (unsigned)wid * 1024u;
    const int aoff = lds_byte(wr * 64 + fr, fq * 8), boff = lds_byte(wc * 32 + fr, fq * 8);
#define PG8_SA(b, h) (((b) * 2 + (h)) * HTB)
#define PG8_SB(b, h) ((4 + (b) * 2 + (h)) * HTB)
#define PG8_GLDS(gptr, bufoff, i_) __builtin_amdgcn_global_load_lds((const unsigned*)(gptr), (PG8_LAS unsigned*)(lds + (bufoff) + ldsw + (i_) * 8192), 16, 0, 0)
#define PG8_STAGE_B(bufoff, gbase) do { _Pragma("unroll") for (int _i = 0; _i < 2; ++_i) PG8_GLDS((const char*)(gbase) + voffB[_i], bufoff, _i); } while (0)
#define PG8_STAGE_A(bufoff, gbase, h) do { _Pragma("unroll") for (int _i = 0; _i < 2; ++_i) PG8_GLDS((const char*)(gbase) + vAc[h][_i], bufoff, _i); } while (0)
#define PG8_STAGE_A2(bufoff, gbase, h) PG8_STAGE_A(bufoff, gbase, h)
#define PG8_NEXT_A() do { const int _t = opaque_tid(); const PG8_LAS int* _tb = tokb + (ui + 1) * 256; _Pragma("unroll") for (int _i = 0; _i < 2; ++_i) { int _R, _C; stage_rc(_t * 16 + _i * 8192, _R, _C); \
        _Pragma("unroll") for (int _h = 0; _h < 2; ++_h) vAc[_h][_i] = (unsigned)(_tb[_h * 128 + _R] * K + _C) * 2u; } } while (0)
#define PG8_CALC_A(u, v) do { const int _t = opaque_tid(); _Pragma("unroll") for (int _i = 0; _i < 2; ++_i) { int _R, _C; stage_rc(_t * 16 + _i * 8192, _R, _C); _Pragma("unroll") for (int _h = 0; _h < 2; ++_h) v[_h][_i] = (GATHER ? (unsigned)(tokb[_h * 128 + _R] * K) * 2u : S.a_off(u, _h * 128 + _R, K)) + (unsigned)_C * 2u; } } while (0)
#define PG8_LDA(dst, b, h) do { _Pragma("unroll") for (int m = 0; m < 4; ++m) _Pragma("unroll") for (int k = 0; k < 2; ++k) dst[m][k] = *(const PG8_LAS bf16x8*)(lds + PG8_SA(b, h) + aoff + m * 2048 + k * 1024); } while (0)
#define PG8_LDB(dst, b, h) do { _Pragma("unroll") for (int n = 0; n < 2; ++n) _Pragma("unroll") for (int k = 0; k < 2; ++k) dst[n][k] = *(const PG8_LAS bf16x8*)(lds + PG8_SB(b, h) + boff + n * 2048 + k * 1024); } while (0)
#define PG8_MMA(ai, bj, At, Bt) do { __builtin_amdgcn_s_setprio(1); _Pragma("unroll") for (int m = 0; m < 4; ++m) _Pragma("unroll") for (int n = 0; n < 2; ++n) _Pragma("unroll") for (int k = 0; k < 2; ++k) { \
        if (FP8) { if (k == 0) acc[ai][bj][m][n] = mfma_fp8_k128(Bt[n][0], Bt[n][1], At[m][0], At[m][1], acc[ai][bj][m][n]); } \
        else acc[ai][bj][m][n] = __builtin_amdgcn_mfma_f32_16x16x32_bf16(Bt[n][k], At[m][k], acc[ai][bj][m][n], 0, 0, 0); } __builtin_amdgcn_s_setprio(0); } while (0)
#define PG8_WAIT_V(n) asm volatile("s_waitcnt vmcnt(" #n ")" ::: "memory")
#define PG8_WAIT_L(n) asm volatile("s_waitcnt lgkmcnt(" #n ")" ::: "memory")
#define PG8_BAR __builtin_amdgcn_s_barrier()
#define PG8_SCHED __builtin_amdgcn_sched_barrier(0)
    Unit cur, nxt; int ui = 0;
    if (!S.next(0, cur)) return;
    f32x4 acc[2][2][4][2];
#pragma unroll
    for (int a = 0; a < 2; ++a)
#pragma unroll
        for (int b = 0; b < 2; ++b)
#pragma unroll
            for (int m = 0; m < 4; ++m)
#pragma unroll
                for (int n = 0; n < 2; ++n) acc[a][b][m][n] = (f32x4){0.f, 0.f, 0.f, 0.f};
    bf16x8 At[4][2], B0[2][2], B1[2][2];
    unsigned vAc[2][2];
    PG8_CALC_A(cur, vAc);
    const char* cA = cur.Ap; const char* cB = cur.Bp;
    PG8_STAGE_B(PG8_SB(0, 0), cB); PG8_STAGE_B(PG8_SB(0, 1), cB + hstep); PG8_STAGE_A(PG8_SA(0, 0), cA, 0); PG8_STAGE_A(PG8_SA(0, 1), cA, 1);
    if (wr == 1) PG8_BAR;
    PG8_WAIT_V(2); PG8_BAR;
    PG8_STAGE_B(PG8_SB(1, 0), cB + kstep); PG8_STAGE_A(PG8_SA(1, 0), cA + kstep, 0); PG8_STAGE_B(PG8_SB(1, 1), cB + hstep + kstep);
    PG8_WAIT_V(6); PG8_BAR;
    TS_DECL; TS_BEGIN();
    for (;;) {
        const bool has_next = S.next(ui + 1, nxt);
        TS_END(22);
        const char* nA = has_next ? nxt.Ap : cA; const char* nB = has_next ? nxt.Bp : cB;
#pragma unroll 1
        for (int t = 0; t < nt; t += 2) {
            const bool last = (t == nt - 2);
            const char* a1 = cA + (size_t)(t + 1) * kstep;
            const char* a2 = last ? nA : cA + (size_t)(t + 2) * kstep; const char* b2 = last ? nB : cB + (size_t)(t + 2) * kstep;
            const char* a3 = a2 + kstep; const char* b3 = b2 + kstep;
            PG8_LDB(B0, 0, 0); PG8_LDB(B1, 0, 1); PG8_SCHED; PG8_LDA(At, 0, 0); PG8_STAGE_A(PG8_SA(1, 1), a1, 1);
            if constexpr (GATHER) { if (last && has_next) { PG8_NEXT_A(); } }
            PG8_WAIT_V(8); PG8_WAIT_L(0); PG8_BAR; PG8_MMA(0, 0, At, B0); PG8_MMA(0, 1, At, B1); PG8_BAR; PG8_SCHED;
            PG8_LDA(At, 0, 1); PG8_STAGE_B(PG8_SB(0, 0), b2); PG8_STAGE_B(PG8_SB(0, 1), b2 + hstep); PG8_STAGE_A2(PG8_SA(0, 0), a2, 0);
            PG8_WAIT_V(8); PG8_WAIT_L(0); PG8_BAR; PG8_MMA(1, 0, At, B0); PG8_MMA(1, 1, At, B1); PG8_BAR; PG8_SCHED;
            PG8_LDB(B0, 1, 0); PG8_LDB(B1, 1, 1); PG8_SCHED; PG8_LDA(At, 1, 0); PG8_STAGE_A2(PG8_SA(0, 1), a2, 1);
            PG8_WAIT_V(8); PG8_WAIT_L(0); PG8_BAR; PG8_MMA(0, 0, At, B0); PG8_MMA(0, 1, At, B1); PG8_BAR; PG8_SCHED;
            PG8_LDA(At, 1, 1); PG8_STAGE_B(PG8_SB(1, 0), b3); PG8_STAGE_B(PG8_SB(1, 1), b3 + hstep); PG8_STAGE_A2(PG8_SA(1, 0), a3, 0);
            PG8_WAIT_V(8); PG8_WAIT_L(0); PG8_BAR; PG8_MMA(1, 0, At, B0); PG8_MMA(1, 1, At, B1); PG8_BAR; PG8_SCHED;
        }
        TS_END(20);
        if constexpr (ALIGN_EPI) { if (wr == 0) PG8_BAR; }
        E(acc, cur, ui);
        TS_END(21);
        if (!has_next) break;
#pragma unroll
        for (int a = 0; a < 2; ++a)
#pragma unroll
            for (int b = 0; b < 2; ++b)
#pragma unroll
                for (int m = 0; m < 4; ++m)
#pragma unroll
                    for (int n = 0; n < 2; ++n) acc[a][b][m][n] = (f32x4){0.f, 0.f, 0.f, 0.f};
        cur = nxt; cA = nA; cB = nB; ++ui;
        if constexpr (ALIGN_EPI) { if (wr == 1) PG8_BAR; }
    }
    PG8_WAIT_V(0);
    if constexpr (!ALIGN_EPI) { if (wr == 0) PG8_BAR; }
    PG8_BAR;
#undef PG8_SA
#undef PG8_SB
#undef PG8_GLDS
#undef PG8_STAGE_A
#undef PG8_STAGE_A2
#undef PG8_NEXT_A
#undef PG8_STAGE_B
#undef PG8_CALC_A
#undef PG8_LDA
#undef PG8_LDB
#undef PG8_MMA
#undef PG8_WAIT_V
#undef PG8_WAIT_L
#undef PG8_BAR
#undef PG8_SCHED
}
}

constexpr size_t MiB = 1u << 20;
constexpr size_t WS_CTL = 0, CTL_ZERO_BYTES = 128 * 1024;
constexpr size_t WS_MOD = 1 * MiB;
constexpr size_t WS_BA = 2 * MiB;
constexpr size_t WS_PW = 3 * MiB;
constexpr size_t WS_WIN = 4 * MiB;
constexpr size_t WS_LIST = 4 * MiB;
constexpr size_t WS_LISTW = 8 * MiB;
constexpr size_t WS_WSGU = 12 * MiB;
constexpr size_t WS_WSD = 13 * MiB;
constexpr size_t WS_WG = 21 * MiB;
constexpr size_t WS_WUPG = 25 * MiB, WS_WUPD = 27 * MiB, WS_WOUT = 28 * MiB;
constexpr size_t WS_H = 30 * MiB;
constexpr size_t WS_GQ = 62 * MiB, WS_GK = 94 * MiB, WS_GV = 126 * MiB;
constexpr size_t WS_YA = 62 * MiB;
constexpr size_t WS_Y = 62 * MiB;
constexpr size_t WS_WGU = 94 * MiB;
constexpr size_t WS_DQ = 158 * MiB, WS_DK = 206 * MiB, WS_DV = 254 * MiB;
constexpr size_t WS_UA = 158 * MiB, WS_UB = 190 * MiB, WS_MG = 222 * MiB;
constexpr size_t WS_ACT = 142 * MiB;
constexpr size_t WS_ACTS = 178 * MiB;
constexpr size_t WS_WD = 126 * MiB;
constexpr size_t WS_SLOT = 198 * MiB;
constexpr size_t WS_SH = 182 * MiB;
constexpr size_t WS_END = 334 * MiB;
constexpr size_t OUT_GZ = 0, OUT_H8 = 32 * MiB;
constexpr size_t WS_YB = 142 * MiB;

constexpr int CW_BAR = 4096;
constexpr int CW_CNT = 16384;

constexpr int RING_BYTES = 131072;
constexpr int MISC_OFF = 143360;
constexpr int INFO_OFF = 131072;
constexpr int LDS_BYTES = 147456;

typedef GAS unsigned gu32;
#define RLX_AGENT __ATOMIC_RELAXED, __HIP_MEMORY_SCOPE_AGENT

#define XB_TMO      128
#define XB_XCNT(j)  (256  + 64 * (j))
#define XB_XSUB(j)  (1280 + 64 * (j))
#define XB_XGEN(j)  (2304 + 64 * (j))
#define XB_TOP      3328
#define XB_TOPGEN   3392
#define XCD_BAR_WORDS 3456
#define XB_SPIN_CAP (1u << 22)
__device__ __forceinline__ unsigned xb_ld(unsigned* p)              { return __hip_atomic_load(p, __ATOMIC_RELAXED, __HIP_MEMORY_SCOPE_AGENT); }
__device__ __forceinline__ unsigned xb_add(unsigned* p, unsigned v) { return __hip_atomic_fetch_add(p, v, __ATOMIC_RELAXED, __HIP_MEMORY_SCOPE_AGENT); }
__device__ __forceinline__ unsigned xb_xcc_id() { return (unsigned)__builtin_amdgcn_s_getreg((3 << 11) | 20) & 0xFu; }
#define XB_SPIN(cond, bar) do { unsigned _sp = 0; while (cond) { __builtin_amdgcn_s_sleep(1); \
    if ((++_sp & 255u) == 0u) { if (xb_ld(&(bar)[XB_TMO])) break; if (_sp > XB_SPIN_CAP) { atomicAdd(&(bar)[XB_TMO], 1u); break; } } } } while (0)
struct XcdBarrier { unsigned* bar; unsigned x; volatile LAS unsigned* st; };
__device__ __forceinline__ XcdBarrier xcd_barrier_post(unsigned* bar, volatile LAS unsigned* st) {
    XcdBarrier b; b.bar = bar; b.x = xb_xcc_id(); b.st = st;
    if (threadIdx.x == 0) (void)xb_add(&bar[XB_XCNT(b.x)], 1u);
    return b;
}
__device__ __forceinline__ void xcd_barrier_complete(unsigned* bar, unsigned x, unsigned& nloc, unsigned& nx) {
    const unsigned G = gridDim.x * gridDim.y * gridDim.z;
    unsigned sum, cnt, mine, sp = 0u;
    for (;;) {
        sum = 0u; cnt = 0u; mine = 0u;
#pragma unroll
        for (unsigned j = 0; j < 16; ++j) { const unsigned c = xb_ld(&bar[XB_XCNT(j)]); sum += c; cnt += (c > 0u) ? 1u : 0u; mine = (j == x) ? c : mine; }
        if (sum == G) break;
        __builtin_amdgcn_s_sleep(1);
        if ((++sp & 255u) == 0u) { if (xb_ld(&bar[XB_TMO])) break; if (sp > XB_SPIN_CAP) { atomicAdd(&bar[XB_TMO], 1u); break; } }
    }
    nloc = mine > 0u ? mine : 1u; nx = cnt > 0u ? cnt : 1u;
}
__device__ __forceinline__ void xcd_barrier(const XcdBarrier& b) {
    asm volatile("s_waitcnt vmcnt(0)" ::: "memory");
    __syncthreads();
    if (threadIdx.x == 0) {
        unsigned* bar = b.bar;
        __builtin_amdgcn_s_waitcnt(0);
        unsigned nloc = b.st[0], nx = b.st[1];
        if (nloc == 0u) { xcd_barrier_complete(bar, b.x, nloc, nx); b.st[0] = nloc; b.st[1] = nx; }
        const unsigned old = xb_add(&bar[XB_XSUB(b.x)], 1u);
        const unsigned gen = old / nloc;
        if (old + 1u == (gen + 1u) * nloc) {
            __builtin_amdgcn_fence(__ATOMIC_RELEASE, "agent");
            asm volatile("s_waitcnt vmcnt(0)" ::: "memory");
            const unsigned og = xb_add(&bar[XB_TOP], 1u);
            const unsigned tg = og / nx;
            if (og + 1u == (tg + 1u) * nx) xb_add(&bar[XB_TOPGEN], 1u);
            else XB_SPIN(xb_ld(&bar[XB_TOPGEN]) == tg, bar);
            __builtin_amdgcn_fence(__ATOMIC_ACQUIRE, "agent");
            xb_add(&bar[XB_XGEN(b.x)], 1u);
            asm volatile("s_waitcnt vmcnt(0)" ::: "memory");
        } else {
            XB_SPIN(xb_ld(&bar[XB_XGEN(b.x)]) == gen, bar);
            __builtin_amdgcn_fence(__ATOMIC_ACQUIRE, "agent");
            asm volatile("s_waitcnt vmcnt(0)" ::: "memory");
        }
    }
    __syncthreads();
}

struct Frame {
    LAS unsigned char* lds;
    int G, blk;
    float* out; unsigned char* ws; unsigned char* ob;
};
enum { I_X = 0, I_C, I_WADA, I_BADA, I_GMIX, I_WIN, I_CONVW, I_ALOG, I_DTB, I_GNG, I_QNG, I_KNG, I_WUPG, I_WUPD, I_WOUT, I_GFFN, I_WR, I_RB, I_WEG, I_WEU, I_WED, I_WSG, I_WSU, I_WSD };
__device__ __forceinline__ const float* inp(int i) { return ((const float* const __attribute__((address_space(4)))*)__builtin_amdgcn_kernarg_segment_ptr())[i]; }

__device__ __forceinline__ void transpose_item(const float* W, int ldn, int n0s, int k0, bf16_t* WT, int dK, int drow0, LAS float* scr, int lane) {
#pragma unroll 8
    for (int i = 0; i < 32; ++i) { const int kk = 2 * i + (lane >> 5); scr[kk * 33 + (lane & 31)] = W[(size_t)(k0 + kk) * ldn + n0s + (lane & 31)]; }
    asm volatile("s_waitcnt lgkmcnt(0)" ::: "memory");
    const int c = lane & 7;
#pragma unroll
    for (int j = 0; j < 4; ++j) { const int n = (lane >> 3) + 8 * j; const LAS float* s = scr + (8 * c) * 33 + n;
        u32x4 o; o.x = pk2(s[0 * 33], s[1 * 33]); o.y = pk2(s[2 * 33], s[3 * 33]); o.z = pk2(s[4 * 33], s[5 * 33]); o.w = pk2(s[6 * 33], s[7 * 33]);
        *(GAS u32x4*)(WT + (size_t)(drow0 + n) * dK + k0 + 8 * c) = o; }
    asm volatile("s_waitcnt lgkmcnt(0)" ::: "memory");
}

__device__ __forceinline__ void p0_mod(Frame& F) {
    const int ftid = opaque_tid(), flane = ftid & 63, fwave = __builtin_amdgcn_readfirstlane(ftid >> 6);
    LAS float* cs = (LAS float*)(F.lds);
    LAS float* red = (LAS float*)(F.lds + 32768);
    for (int i = ftid; i < 8 * 1024; i += 512) cs[i] = siluf_(inp(I_C)[i]);
    __syncthreads();
    float* MOD = (float*)(F.ws + WS_MOD);
    for (int cb = F.blk; cb < 6144 / 24; cb += F.G) {
        const int col = ftid & 31, kg = ftid >> 5;
        float acc[8];
#pragma unroll
        for (int b = 0; b < 8; ++b) acc[b] = 0.f;
        if (col < 24) {
            const float* wp = inp(I_WADA) + (size_t)kg * 6144 + cb * 24 + col;
#pragma unroll
            for (int i0 = 0; i0 < 64; i0 += 16) {
                float w[16];
#pragma unroll
                for (int i = 0; i < 16; ++i) w[i] = __builtin_nontemporal_load(wp + (size_t)(16 * (i0 + i)) * 6144);
#pragma unroll
                for (int i = 0; i < 16; ++i) { const int k = kg + 16 * (i0 + i);
#pragma unroll
                    for (int b = 0; b < 8; ++b) acc[b] += cs[b * 1024 + k] * w[i]; }
            }
        }
#pragma unroll
        for (int b = 0; b < 8; ++b) red[(kg * 8 + b) * 32 + col] = acc[b];
        __syncthreads();
        if (ftid < 256) { const int b = ftid >> 5, cc = ftid & 31;
            if (cc < 24) { float s = inp(I_BADA)[cb * 24 + cc];
                for (int g = 0; g < 16; ++g) s += red[(g * 8 + b) * 32 + cc];
                MOD[b * 6144 + cb * 24 + cc] = s; } }
        __syncthreads();
    }
}
__device__ __forceinline__ void p0_weights(Frame& F) { (void)F; }
__device__ __forceinline__ void tr16_item(const float* src, int ldn, int n0, int k0, bf16_t* d0, bf16_t* d1, bf16_t* d2, bf16_t* d3, int lane) {
    f32x4 v[16];
#pragma unroll
    for (int i = 0; i < 16; ++i) v[i] = *(const f32x4*)(src + (size_t)(k0 + i) * ldn + n0 + 4 * lane);
    u32x4 a0, a1, b0, b1, c0, c1, e0, e1;
#pragma unroll
    for (int i = 0; i < 4; ++i) { a0[i] = pk2(v[2 * i].x, v[2 * i + 1].x); a1[i] = pk2(v[8 + 2 * i].x, v[9 + 2 * i].x); b0[i] = pk2(v[2 * i].y, v[2 * i + 1].y); b1[i] = pk2(v[8 + 2 * i].y, v[9 + 2 * i].y);
        c0[i] = pk2(v[2 * i].z, v[2 * i + 1].z); c1[i] = pk2(v[8 + 2 * i].z, v[9 + 2 * i].z); e0[i] = pk2(v[2 * i].w, v[2 * i + 1].w); e1[i] = pk2(v[8 + 2 * i].w, v[9 + 2 * i].w); }
    *(u32x4*)(d0 + k0) = a0; *(u32x4*)(d0 + k0 + 8) = a1; *(u32x4*)(d1 + k0) = b0; *(u32x4*)(d1 + k0 + 8) = b1;
    *(u32x4*)(d2 + k0) = c0; *(u32x4*)(d2 + k0 + 8) = c1; *(u32x4*)(d3 + k0) = e0; *(u32x4*)(d3 + k0 + 8) = e1;
}
__device__ __forceinline__ void tr16_item_fp8(const float* src, int ldn, int n0, int k0, unsigned char* d0, unsigned char* d1, unsigned char* d2, unsigned char* d3, int lane, float SC) {
    f32x4 v[16];
#pragma unroll
    for (int i = 0; i < 16; ++i) v[i] = __builtin_nontemporal_load((const f32x4*)(src + (size_t)(k0 + i) * ldn + n0 + 4 * lane)) * SC;
    u32x4 a, b, c, e;
#pragma unroll
    for (int j = 0; j < 4; ++j) { int w;
        w = 0; w = __builtin_amdgcn_cvt_pk_fp8_f32(v[4 * j].x, v[4 * j + 1].x, w, false); w = __builtin_amdgcn_cvt_pk_fp8_f32(v[4 * j + 2].x, v[4 * j + 3].x, w, true); a[j] = (unsigned)w;
        w = 0; w = __builtin_amdgcn_cvt_pk_fp8_f32(v[4 * j].y, v[4 * j + 1].y, w, false); w = __builtin_amdgcn_cvt_pk_fp8_f32(v[4 * j + 2].y, v[4 * j + 3].y, w, true); b[j] = (unsigned)w;
        w = 0; w = __builtin_amdgcn_cvt_pk_fp8_f32(v[4 * j].z, v[4 * j + 1].z, w, false); w = __builtin_amdgcn_cvt_pk_fp8_f32(v[4 * j + 2].z, v[4 * j + 3].z, w, true); c[j] = (unsigned)w;
        w = 0; w = __builtin_amdgcn_cvt_pk_fp8_f32(v[4 * j].w, v[4 * j + 1].w, w, false); w = __builtin_amdgcn_cvt_pk_fp8_f32(v[4 * j + 2].w, v[4 * j + 3].w, w, true); e[j] = (unsigned)w; }
    *(u32x4*)(d0 + k0) = a; *(u32x4*)(d1 + k0) = b; *(u32x4*)(d2 + k0) = c; *(u32x4*)(d3 + k0) = e;
}
constexpr float WOUT_SCALE = 32.0f, MG_SCALE = 8.0f;
constexpr float WUPG_SCALE = 32.0f, WUPD_SCALE = 16.0f, WG_SCALE = 32.0f, WIN_SCALE = 32.0f;
__device__ __forceinline__ void p0_wout8(Frame& F) {
    const int ftid = opaque_tid(), flane = ftid & 63, fwave = __builtin_amdgcn_readfirstlane(ftid >> 6);
    for (int it0 = F.blk * 8 + fwave; it0 < 64 * (NPROJ / 256); it0 += F.G * 8) {
        const int k0 = (it0 / (NPROJ / 256)) * 16, n0 = (it0 % (NPROJ / 256)) * 256; unsigned char* d = F.ws + WS_WIN + (size_t)(n0 + 4 * flane) * 1024;
        tr16_item_fp8(inp(I_WIN), IN_W, n0 + (n0 >= 4096 ? 16 : 0), k0, d, d + 1024, d + 2048, d + 3072, flane, WIN_SCALE); }
    for (int it0 = F.blk * 8 + fwave; it0 < 256 + 256 + 128 + 512; it0 += F.G * 8) { int it = it0;
        if (it < 256) { const int k0 = (it >> 2) * 16, n0 = (it & 3) * 256; unsigned char* d = F.ws + WS_WOUT + (size_t)(n0 + 4 * flane) * 1024;
            tr16_item_fp8(inp(I_WOUT), 1024, n0, k0, d, d + 1024, d + 2048, d + 3072, flane, WOUT_SCALE); continue; } it -= 256;
        if (it < 256) { const int k0 = (it >> 2) * 16, n0 = (it & 3) * 256; unsigned char* d = F.ws + WS_WUPG + (size_t)(n0 + 4 * flane) * 1024;
            tr16_item_fp8(inp(I_WUPG), 1024, n0, k0, d, d + 1024, d + 2048, d + 3072, flane, WUPG_SCALE); continue; } it -= 256;
        if (it < 128) { const int k0 = (it >> 2) * 16, n0 = (it & 3) * 256; unsigned char* d = F.ws + WS_WUPD + (size_t)(n0 + 4 * flane) * 512;
            tr16_item_fp8(inp(I_WUPD), 1024, n0, k0, d, d + 512, d + 1024, d + 1536, flane, WUPD_SCALE); continue; } it -= 128;
        { const int k0 = (it >> 3) * 16, hf = (it >> 2) & 1, pp = it & 3, p = 2 * pp + (flane >> 5), i = 4 * (flane & 31);
          unsigned char* d = F.ws + WS_WG + (size_t)(p * 256 + hf * 128 + i) * 1024;
          tr16_item_fp8(inp(I_WIN), IN_W, 8720 + hf * 1024 + pp * 256, k0, d, d + 1024, d + 2048, d + 3072, flane, WG_SCALE); }
    }
}
constexpr float WD_SCALE = 16.0f;
constexpr float WGU_SCALE = 32.0f;
__device__ __forceinline__ void convert_experts(Frame& F, int b0, int nb) {
    const int ftid = opaque_tid(), flane = ftid & 63, fwave = __builtin_amdgcn_readfirstlane(ftid >> 6);
    if (F.blk < b0 || F.blk >= b0 + nb) return;
    const int gw = (F.blk - b0) * 8 + fwave, NGW = nb * 8;
    unsigned char* WGU = F.ws + WS_WGU; unsigned char* WD = F.ws + WS_WD; unsigned char* WSGU = F.ws + WS_WSGU; unsigned char* WSD = F.ws + WS_WSD;
    constexpr int PER_E = 192, NIT = 65 * PER_E;
    LAS unsigned char* const lds = F.lds; (void)lds; TS_BEGIN();
    for (int it = gw; it < NIT; it += NGW) {
        const int e = it / PER_E; const int r = it % PER_E;
        unsigned char* dgu = e < 64 ? WGU + (size_t)e * 512 * 1024 : WSGU; unsigned char* dd = e < 64 ? WD + (size_t)e * 1024 * 256 : WSD;
        if (r < 128) { const int hf = r >> 6, k0 = (r & 63) * 16;
            const float* src = hf ? (e < 64 ? inp(I_WEU) + (size_t)e * 1024 * 256 : inp(I_WSU)) : (e < 64 ? inp(I_WEG) + (size_t)e * 1024 * 256 : inp(I_WSG));
            const int n = 4 * flane; unsigned char* d = dgu + (size_t)((n >> 7) * 256 + hf * 128 + (n & 127)) * 1024;
            tr16_item_fp8(src, 256, 0, k0, d, d + 1024, d + 2048, d + 3072, flane, WGU_SCALE); }
        else { const int q = r - 128, k0 = (q >> 2) * 16, n0 = (q & 3) * 256;
            const float* src = e < 64 ? inp(I_WED) + (size_t)e * 256 * 1024 : inp(I_WSD);
            unsigned char* d = dd + (size_t)(n0 + 4 * flane) * 256;
            tr16_item_fp8(src, 1024, n0, k0, d, d + 256, d + 512, d + 768, flane, WD_SCALE); }
    }
    TS_END(28);
}

__device__ __forceinline__ void p1_norm(Frame& F) {
    const int ftid = opaque_tid(), flane = ftid & 63, fwave = __builtin_amdgcn_readfirstlane(ftid >> 6);
    LAS float* WbT = (LAS float*)(F.lds);
    for (int it = 0; it < 8; ++it) { const int k = (ftid >> 2) + 128 * it, j4 = (ftid & 3) * 4;
        const f32x4 v = *(const f32x4*)(inp(I_WIN) + (size_t)k * IN_W + 4096 + j4);
        WbT[(j4 + 0) * 1024 + k] = v.x; WbT[(j4 + 1) * 1024 + k] = v.y; WbT[(j4 + 2) * 1024 + k] = v.z; WbT[(j4 + 3) * 1024 + k] = v.w; }
    __syncthreads();
    const float* MOD = (const float*)(F.ws + WS_MOD); bf16_t* H = (bf16_t*)(F.ws + WS_H); float* BA = (float*)(F.ws + WS_BA);
    const int gw = F.blk * 8 + fwave, NGW = F.G * 8;
    for (int rg = gw; rg < T / 8; rg += NGW) {
        const int row0 = rg * 8, b = row0 / SEQ;
        const float* sh = MOD + b * 6144; const float* sc = sh + 1024;
        f32x4 gm[4], s1[4], h1[4];
#pragma unroll
        for (int j = 0; j < 4; ++j) { const int k = 4 * flane + 256 * j; gm[j] = *(const f32x4*)(inp(I_GMIX) + k); s1[j] = *(const f32x4*)(sc + k) + 1.0f; h1[j] = *(const f32x4*)(sh + k); gm[j] = gm[j] * s1[j]; }
        f32x4 cur[4], nxt[4];
        { const f32x4* xr = (const f32x4*)(inp(I_X) + (size_t)row0 * DM) + flane;
#pragma unroll
          for (int j = 0; j < 4; ++j) cur[j] = __builtin_nontemporal_load(xr + 64 * j); }
#pragma unroll 1
        for (int r = 0; r < 8; ++r) {
            const int row = row0 + r;
            if (r < 7) { const f32x4* xr = (const f32x4*)(inp(I_X) + (size_t)(row + 1) * DM) + flane;
#pragma unroll
                for (int j = 0; j < 4; ++j) nxt[j] = __builtin_nontemporal_load(xr + 64 * j); }
            f32x4 v[4]; float ss = 0.f;
#pragma unroll
            for (int j = 0; j < 4; ++j) { v[j] = cur[j]; ss += (v[j].x * v[j].x + v[j].y * v[j].y) + (v[j].z * v[j].z + v[j].w * v[j].w); }
            const float rstd = rsqrtf(wave_sum(ss) * (1.f / DM) + EPS);
#pragma unroll
            for (int j = 0; j < 4; ++j) { const int k = 4 * flane + 256 * j;
                v[j] = (v[j] * rstd) * gm[j] + h1[j];
                { int w8 = 0; w8 = __builtin_amdgcn_cvt_pk_fp8_f32(v[j].x, v[j].y, w8, false); w8 = __builtin_amdgcn_cvt_pk_fp8_f32(v[j].z, v[j].w, w8, true); *(unsigned*)(F.ob + OUT_H8 + (size_t)row * DM + k) = (unsigned)w8; } }
            float a[16];
#pragma unroll
            for (int jj = 0; jj < 16; ++jj) { float s = 0.f;
#pragma unroll
                for (int j = 0; j < 4; ++j) { const f32x4 w = *(const LAS f32x4*)(WbT + jj * 1024 + 4 * flane + 256 * j); s += (v[j].x * w.x + v[j].y * w.y) + (v[j].z * w.z + v[j].w * w.w); }
                a[jj] = s; if ((jj & 3) == 3) asm volatile("" ::: "memory"); }
            float v8[8], v4[4], v2[2], v1;
            { const bool hi = (flane & 32) != 0;
#pragma unroll
              for (int i = 0; i < 8; ++i) { const float x = hi ? a[i] : a[8 + i]; const float rr = __shfl_xor(x, 32); v8[i] = (hi ? a[8 + i] : a[i]) + rr; } }
            { const bool hi = (flane & 16) != 0;
#pragma unroll
              for (int i = 0; i < 4; ++i) { const float x = hi ? v8[i] : v8[4 + i]; const float rr = __shfl_xor(x, 16); v4[i] = (hi ? v8[4 + i] : v8[i]) + rr; } }
            { const bool hi = (flane & 8) != 0;
#pragma unroll
              for (int i = 0; i < 2; ++i) { const float x = hi ? v4[i] : v4[2 + i]; const float rr = __shfl_xor(x, 8); v2[i] = (hi ? v4[2 + i] : v4[i]) + rr; } }
            { const bool hi = (flane & 4) != 0; const float x = hi ? v2[0] : v2[1]; const float rr = __shfl_xor(x, 4); v1 = (hi ? v2[1] : v2[0]) + rr; }
            v1 = red4(v1);
            if ((flane & 3) == 0) BA[(size_t)row * 16 + (flane >> 2)] = v1;
#pragma unroll
            for (int j = 0; j < 4; ++j) cur[j] = nxt[j];
        }
    }
}

using pg8::Unit; using pg8::cvt_pk_bf16;
struct EpiProj {
    static constexpr bool PERM = true;
    unsigned char* ws; bf16_t* gz;
    __device__ __forceinline__ void operator()(const f32x4 (&acc)[2][2][4][2], const Unit& u, const int ui) const {
        const int tid_ = opaque_tid(), lane_ = tid_ & 63, wid_ = tid_ >> 6, wr = wid_ >> 2, wc = wid_ & 3, fr = lane_ & 15, fq = lane_ >> 4;
        bf16_t* base; int ldc, colt;
        if (u.pn < 16) { const int t = u.pn >> 2; base = (bf16_t*)(ws + WS_GQ + (size_t)t * (32 * MiB)); if (t == 3) base = gz; ldc = 1024; colt = (u.pn & 3) * 256; }
        else { const int d = u.pn - 16, t = d / 6; base = (bf16_t*)(ws + WS_DQ + (size_t)t * (48 * MiB)); ldc = 1536; colt = (d % 6) * 256; }
        const int row0 = u.pm * 256 + wr * 64 + fr, col0 = colt + wc * 32 + 8 * fq;
        const __amdgpu_buffer_rsrc_t rs = wt_rsrc(base, (unsigned)T * (unsigned)ldc * 2u);
        if ((u.pn >> 2) == 3) {
#pragma unroll
            for (int ai = 0; ai < 2; ++ai)
#pragma unroll
                for (int m = 0; m < 4; ++m) { const unsigned ro = (unsigned)((row0 + ai * 128 + m * 16) * ldc + col0) * 2u;
#pragma unroll
                    for (int bj = 0; bj < 2; ++bj) { const f32x4 v0 = acc[ai][bj][m][0] * (1.0f / WIN_SCALE), v1 = acc[ai][bj][m][1] * (1.0f / WIN_SCALE);
                        u32x4 w; w.x = pk2(siluf_(v0[0]), siluf_(v0[1])); w.y = pk2(siluf_(v0[2]), siluf_(v0[3])); w.z = pk2(siluf_(v1[0]), siluf_(v1[1])); w.w = pk2(siluf_(v1[2]), siluf_(v1[3]));
                        st16_wt(rs, ro + bj * 256u, w); }
                    asm volatile("" ::: "memory"); }
            return; }
#pragma unroll
        for (int ai = 0; ai < 2; ++ai)
#pragma unroll
            for (int m = 0; m < 4; ++m) { const unsigned ro = (unsigned)((row0 + ai * 128 + m * 16) * ldc + col0) * 2u;
#pragma unroll
                for (int bj = 0; bj < 2; ++bj) { const f32x4 v0 = acc[ai][bj][m][0] * (1.0f / WIN_SCALE), v1 = acc[ai][bj][m][1] * (1.0f / WIN_SCALE);
                    u32x4 w; w.x = pk2(v0[0], v0[1]); w.y = pk2(v0[2], v0[3]); w.z = pk2(v1[0], v1[1]); w.w = pk2(v1[2], v1[3]);
                    st16_wt(rs, ro + bj * 256u, w); } }
    }
};
struct EpiStore {
    static constexpr bool PERM = true;
    bf16_t* O; int ldc; float sc = 1.0f;
    __device__ __forceinline__ void operator()(const f32x4 (&acc)[2][2][4][2], const Unit& u, const int ui) const {
        const int tid_ = opaque_tid(), lane_ = tid_ & 63, wid_ = tid_ >> 6, wr = wid_ >> 2, wc = wid_ & 3, fr = lane_ & 15, fq = lane_ >> 4;
        const int row0 = u.pm * 256 + wr * 64 + fr, col0 = u.pn * 256 + wc * 32 + 8 * fq;
#pragma unroll
        for (int ai = 0; ai < 2; ++ai)
#pragma unroll
            for (int m = 0; m < 4; ++m) { bf16_t* rowp = O + (size_t)(row0 + ai * 128 + m * 16) * ldc + col0;
#pragma unroll
                for (int bj = 0; bj < 2; ++bj) { const f32x4 v0 = acc[ai][bj][m][0] * sc, v1 = acc[ai][bj][m][1] * sc;
                    u32x4 w; w.x = pk2(v0[0], v0[1]); w.y = pk2(v0[2], v0[3]); w.z = pk2(v1[0], v1[1]); w.w = pk2(v1[2], v1[3]);
                    *(u32x4*)(rowp + bj * 128) = w; } }
    }
};
struct EpiGate {
    static constexpr bool PERM = true;
    const bf16_t* UA; const bf16_t* UB; unsigned char* MG;
    __device__ __forceinline__ void operator()(const f32x4 (&acc)[2][2][4][2], const Unit& u, const int ui) const {
        const int tid_ = opaque_tid(), lane_ = tid_ & 63, wid_ = tid_ >> 6, wr = wid_ >> 2, wc = wid_ & 3, fr = lane_ & 15, fq = lane_ >> 4;
        const int row0 = u.pm * 256 + wr * 64 + fr, col0 = u.pn * 128 + wc * 32 + 8 * fq;
#pragma unroll
        for (int ai = 0; ai < 2; ++ai) {
            u32x4 ua[4], ub[4];
#pragma unroll
            for (int m = 0; m < 4; ++m) { const size_t off = (size_t)(row0 + ai * 128 + m * 16) * 1024 + col0; ua[m] = *(const u32x4*)(UA + off); ub[m] = *(const u32x4*)(UB + off); }
#pragma unroll
            for (int m = 0; m < 4; ++m) { const size_t off = (size_t)(row0 + ai * 128 + m * 16) * 1024 + col0;
                float o[8];
#pragma unroll
                for (int n = 0; n < 2; ++n)
#pragma unroll
                    for (int j = 0; j < 4; ++j) { const int q = n * 4 + j; const unsigned wa = ua[m][q >> 1], wb = ub[m][q >> 1];
                        const float fa = (q & 1) ? bfhi(wa) : bflo(wa), fb = (q & 1) ? bfhi(wb) : bflo(wb);
                        o[q] = sigmoidf_(acc[ai][0][m][n][j] * (1.0f / WG_SCALE)) * fa + sigmoidf_(acc[ai][1][m][n][j] * (1.0f / WG_SCALE)) * fb; }
                int p0 = 0, p1 = 0;
                p0 = __builtin_amdgcn_cvt_pk_fp8_f32(o[0] * MG_SCALE, o[1] * MG_SCALE, p0, false); p0 = __builtin_amdgcn_cvt_pk_fp8_f32(o[2] * MG_SCALE, o[3] * MG_SCALE, p0, true);
                p1 = __builtin_amdgcn_cvt_pk_fp8_f32(o[4] * MG_SCALE, o[5] * MG_SCALE, p1, false); p1 = __builtin_amdgcn_cvt_pk_fp8_f32(o[6] * MG_SCALE, o[7] * MG_SCALE, p1, true);
                u32x2 w; w.x = (unsigned)p0; w.y = (unsigned)p1; *(u32x2*)(MG + off) = w; }
            asm volatile("" ::: "memory");
        }
    }
};
struct EpiX1 {
    static constexpr bool PERM = false;
    const float* x; const float* mod; float* out;
    __device__ __forceinline__ void operator()(const f32x4 (&acc)[2][2][4][2], const Unit& u, const int ui) const {
        const int tid_ = opaque_tid(), lane_ = tid_ & 63, wid_ = tid_ >> 6, wr = wid_ >> 2, wc = wid_ & 3, fr = lane_ & 15, fq = lane_ >> 4;
        const int row0 = u.pm * 256 + wr * 64 + fr, col0 = u.pn * 256 + wc * 32 + 4 * fq; const int b = u.pm >> 3;
        f32x4 gt[2][2];
#pragma unroll
        for (int bj = 0; bj < 2; ++bj)
#pragma unroll
            for (int n = 0; n < 2; ++n) gt[bj][n] = *(const f32x4*)(mod + b * 6144 + 2048 + col0 + bj * 128 + n * 16);
#pragma unroll
        for (int ai = 0; ai < 2; ++ai) {
            f32x4 xv[4][2][2];
#pragma unroll
            for (int m = 0; m < 4; ++m) { const size_t off = (size_t)(row0 + ai * 128 + m * 16) * 1024 + col0;
#pragma unroll
                for (int bj = 0; bj < 2; ++bj)
#pragma unroll
                    for (int n = 0; n < 2; ++n) xv[m][bj][n] = *(const f32x4*)(x + off + bj * 128 + n * 16); }
#pragma unroll
            for (int m = 0; m < 4; ++m) { const size_t off = (size_t)(row0 + ai * 128 + m * 16) * 1024 + col0;
#pragma unroll
                for (int bj = 0; bj < 2; ++bj)
#pragma unroll
                    for (int n = 0; n < 2; ++n) *(f32x4*)(out + off + bj * 128 + n * 16) = xv[m][bj][n] + gt[bj][n] * acc[ai][bj][m][n]; }
            asm volatile("" ::: "memory");
        }
    }
};
struct MoeTab { const LAS int* tp; const LAS int* cnt; const LAS unsigned short* te; };
struct EpiAct {
    static constexpr bool PERM = true;
    MoeTab tb; const LAS float* wkb; unsigned char* ACT; unsigned char* ACTS;
    __device__ __forceinline__ void operator()(const f32x4 (&acc)[2][2][4][2], const Unit& u, const int ui) const {
        const int tid_ = opaque_tid(), lane_ = tid_ & 63, wid_ = tid_ >> 6, wr = wid_ >> 2, wc = wid_ & 3, fr = lane_ & 15, fq = lane_ >> 4;
        const int e = u.e;
        unsigned char* base = e < 64 ? ACT + (size_t)u.pm * 256 * 256 : ACTS + (size_t)u.mt * 256 * 256;
        const int col0 = u.pn * 128 + wc * 32 + 8 * fq;
        float wk[2][4];
#pragma unroll
        for (int ai = 0; ai < 2; ++ai)
#pragma unroll
            for (int m = 0; m < 4; ++m) wk[ai][m] = wkb[ui * 256 + ai * 128 + wr * 64 + m * 16 + fr] * (1.0f / WGU_SCALE);
#pragma unroll
        for (int ai = 0; ai < 2; ++ai)
#pragma unroll
            for (int m = 0; m < 4; ++m) { const int r = ai * 128 + wr * 64 + m * 16 + fr;
                float o[8];
#pragma unroll
                for (int n = 0; n < 2; ++n)
#pragma unroll
                    for (int j = 0; j < 4; ++j) o[n * 4 + j] = siluf_(acc[ai][0][m][n][j] * (1.0f / WGU_SCALE)) * acc[ai][1][m][n][j] * wk[ai][m];
                int p0 = 0, p1 = 0;
                p0 = __builtin_amdgcn_cvt_pk_fp8_f32(o[0], o[1], p0, false); p0 = __builtin_amdgcn_cvt_pk_fp8_f32(o[2], o[3], p0, true);
                p1 = __builtin_amdgcn_cvt_pk_fp8_f32(o[4], o[5], p1, false); p1 = __builtin_amdgcn_cvt_pk_fp8_f32(o[6], o[7], p1, true);
                u32x2 w; w.x = (unsigned)p0; w.y = (unsigned)p1; *(u32x2*)(base + (size_t)r * 256 + col0) = w; }
    }
};
struct EpiSlot {
    static constexpr bool PERM = true;
    MoeTab tb; const LAS int* pairb; unsigned char* SLOT; bf16_t* SH;
    __device__ __forceinline__ void operator()(const f32x4 (&acc)[2][2][4][2], const Unit& u, const int ui) const {
        const int tid_ = opaque_tid(), lane_ = tid_ & 63, wid_ = tid_ >> 6, wr = wid_ >> 2, wc = wid_ & 3, fr = lane_ & 15, fq = lane_ >> 4;
        const int e = u.e; const int col0 = u.pn * 256 + wc * 32 + 8 * fq;
        if (e == 64) {
#pragma unroll
            for (int ai = 0; ai < 2; ++ai)
#pragma unroll
                for (int m = 0; m < 4; ++m) { bf16_t* rowp = SH + (size_t)(u.mt * 256 + ai * 128 + wr * 64 + m * 16 + fr) * 1024 + col0;
#pragma unroll
                    for (int bj = 0; bj < 2; ++bj) { const f32x4 v0 = acc[ai][bj][m][0], v1 = acc[ai][bj][m][1];
                        u32x4 w; w.x = pk2(v0[0], v0[1]); w.y = pk2(v0[2], v0[3]); w.z = pk2(v1[0], v1[1]); w.w = pk2(v1[2], v1[3]);
                        *(u32x4*)(rowp + bj * 128) = w; } }
            return;
        }
        int pair[2][4];
#pragma unroll
        for (int ai = 0; ai < 2; ++ai)
#pragma unroll
            for (int m = 0; m < 4; ++m) pair[ai][m] = pairb[ui * 256 + ai * 128 + wr * 64 + m * 16 + fr];
#pragma unroll
        for (int ai = 0; ai < 2; ++ai)
#pragma unroll
            for (int m = 0; m < 4; ++m) {
                if (pair[ai][m] >= 0) { unsigned char* rowp = SLOT + (size_t)pair[ai][m] * 1024 + col0;
#pragma unroll
                    for (int bj = 0; bj < 2; ++bj) { const f32x4 v0 = acc[ai][bj][m][0], v1 = acc[ai][bj][m][1];
                        int p0 = 0, p1 = 0;
                        p0 = __builtin_amdgcn_cvt_pk_fp8_f32(v0[0], v0[1], p0, false); p0 = __builtin_amdgcn_cvt_pk_fp8_f32(v0[2], v0[3], p0, true);
                        p1 = __builtin_amdgcn_cvt_pk_fp8_f32(v1[0], v1[1], p1, false); p1 = __builtin_amdgcn_cvt_pk_fp8_f32(v1[2], v1[3], p1, true);
                        u32x2 w; w.x = (unsigned)p0; w.y = (unsigned)p1; *(u32x2*)(rowp + bj * 128) = w; } } }
    }
};
struct G1Order {
    MoeTab tb; int G, c; const int* list; const char* H2; const char* WGU; const char* WSGU;
    __device__ __forceinline__ bool next(int i, Unit& u) const {
        const int NR = tb.tp[64]; const long L = (long)i * G + c; if (L >= (long)(NR + 64) * 2) return false;
        const int tile = (int)(L >> 1), j = (int)(L & 1);
        u.pn = j; u.Ap = H2;
        if (tile < NR) { const int e = tb.te[tile]; u.e = e; u.mt = tile - tb.tp[e]; u.pm = tile; u.Bp = WGU + ((size_t)e * 512 + j * 256) * 1024; }
        else { u.e = 64; u.mt = tile - NR; u.pm = 0; u.Bp = WSGU + (size_t)(j * 256) * 1024; }
        return true;
    }
    __device__ __forceinline__ int a_row(const Unit& u, int r) const {
        int tok;
        if (u.e == 64) tok = u.mt * 256 + r;
        else { const int pos = u.mt * 256 + r; tok = 0; if (pos < tb.cnt[u.e]) tok = list[(size_t)u.e * T + pos] >> 3; }
        return tok;
    }
    __device__ __forceinline__ unsigned a_off(const Unit& u, int r, int K) const { return (unsigned)(a_row(u, r) * K) * 2u; }
    __device__ __forceinline__ void preload(LAS int* tokb, LAS float* wkb, const float* listw) const {
        const int t = opaque_tid(); Unit u;
        for (int i = 0; i < 6 && next(i, u); ++i) if (t < 256) {
            int tok; float w = 1.0f;
            if (u.e == 64) tok = u.mt * 256 + t;
            else { const int pos = u.mt * 256 + t; tok = 0; w = 0.f; if (pos < tb.cnt[u.e]) { tok = list[(size_t)u.e * T + pos] >> 3; w = listw[(size_t)u.e * T + pos]; } }
            tokb[i * 256 + t] = tok; wkb[i * 256 + t] = w; }
        __syncthreads();
    }
};
struct G2Order {
    MoeTab tb; int G, c; const char* ACT; const char* WD; const char* ACTS; const char* WSD;
    __device__ __forceinline__ bool next(int i, Unit& u) const {
        const int NR = tb.tp[64]; const long L = (long)i * G + c; if (L >= (long)(NR + 64) * 4) return false;
        const int tile = (int)(L >> 2), pn = (int)(L & 3);
        u.pn = pn;
        if (tile < NR) { const int e = tb.te[tile];
            u.e = e; u.mt = tile - tb.tp[e]; u.pm = tile; u.Ap = ACT + (size_t)tile * 256 * 256 * 2; u.Bp = WD + ((size_t)e * 1024 + pn * 256) * 256 * 2; }
        else { u.e = 64; u.mt = tile - NR; u.pm = 0; u.Ap = ACTS + (size_t)u.mt * 256 * 256 * 2; u.Bp = WSD + (size_t)(pn * 256) * 256 * 2; }
        return true;
    }
    __device__ __forceinline__ unsigned a_off(const Unit&, int r, int K) const { return (unsigned)(r * K) * 2u; }
    __device__ __forceinline__ void preload(LAS int* pairb, const int* list) const {
        const int t = opaque_tid(); Unit u;
        for (int i = 0; i < 12 && next(i, u); ++i) if (t < 256) {
            int p = -1;
            if (u.e < 64) { const int pos = u.mt * 256 + t; if (pos < tb.cnt[u.e]) p = list[(size_t)u.e * T + pos]; }
            pairb[i * 256 + t] = p; }
        __syncthreads();
    }
};
__device__ __forceinline__ MoeTab build_moetab(Frame& F) {
    const int ftid = opaque_tid();
    LAS int* tp = (LAS int*)(F.lds + MISC_OFF + 1024); LAS int* cnt = (LAS int*)(F.lds + MISC_OFF + 2048); LAS unsigned short* te = (LAS unsigned short*)(F.lds + MISC_OFF + 2304);
    const gu32* gc = (const gu32*)(F.ws + WS_CTL) + CW_CNT;
    __syncthreads();
    if (ftid < 64) { int v = (int)__hip_atomic_load(gc + ftid, RLX_AGENT); if (v > T) v = T; if (v < 0) v = 0; cnt[ftid] = v; }
    __syncthreads();
    if (ftid == 0) { int s = 0; for (int e = 0; e < 64; ++e) { tp[e] = s; s += (cnt[e] + 255) >> 8; } tp[64] = s; }
    __syncthreads();
    if (ftid < 64) { const int t0 = tp[ftid], t1 = tp[ftid + 1]; for (int t = t0; t < t1 && t < 640; ++t) te[t] = (unsigned short)ftid; }
    __syncthreads();
    MoeTab t; t.tp = tp; t.cnt = cnt; t.te = te; return t;
}


typedef short v4i16_t __attribute__((ext_vector_type(4)));
constexpr size_t WS_OG01 = 302 * MiB;
constexpr size_t OUT_OG2 = 48 * MiB;
constexpr size_t WS_LSE = 3 * MiB + 512 * 1024;
__device__ __forceinline__ void p3_attn(Frame& F) {
    const int tid = opaque_tid(), lane = tid & 63, wave = __builtin_amdgcn_readfirstlane(tid >> 6), n = lane & 15, g = lane >> 4;
    const bf16_t* DQ = (const bf16_t*)(F.ws + WS_DQ); const bf16_t* DK = (const bf16_t*)(F.ws + WS_DK); const bf16_t* DV = (const bf16_t*)(F.ws + WS_DV);
    LAS unsigned char* Ks = F.lds; LAS unsigned char* Vs = F.lds + 65536; LAS float* rkS = (LAS float*)(F.lds + 131072); LAS float* gqkS = (LAS float*)(F.lds + 131072 + 1024);
    LAS unsigned char* const lds = F.lds; (void)lds;
    if (tid < 128) gqkS[tid] = inp(I_QNG)[tid] * inp(I_KNG)[tid] * (0.08838834764831845f * 1.4426950408889634f);
    u32x4 kreg[8], vreg[8], qreg[4];
#define ATT_DECODE(u_, b_, h_, dsh_, r_, qb_) const int b_ = (u_) / 192, rem_##b_ = (u_) % 192, h_ = rem_##b_ >> 4, rq_##b_ = rem_##b_ & 15, dsh_ = 2 * (h_ >> 2), r_ = rq_##b_ / (16 >> dsh_), qb_ = rq_##b_ % (16 >> dsh_)
#define ATT_LOADKV(u_) do { ATT_DECODE(u_, lb, lh, ldsh, lr, lqb); \
        _Pragma("unroll") for (int pass = 0; pass < 8; ++pass) { if (lqb == 0 && pass < 4) continue; \
            const int wi = pass * 32 + (tid >> 4), c = tid & 15, m = lqb * 128 - 128 + wi; \
            const size_t t = (size_t)lb * SEQ + (size_t)((m << ldsh) + lr); \
            kreg[pass] = *(const u32x4*)(DK + t * 1536 + lh * 128 + c * 8); vreg[pass] = *(const u32x4*)(DV + t * 1536 + lh * 128 + c * 8); } \
        { const size_t tq_ = (size_t)lb * SEQ + (size_t)(((lqb * 128 + 16 * wave + n) << ldsh) + lr); \
          _Pragma("unroll") for (int ks = 0; ks < 4; ++ks) qreg[ks] = *(const u32x4*)(DQ + tq_ * 1536 + lh * 128 + 32 * ks + 8 * g); } } while (0)
    if (F.blk < BATCH * 12 * 16) { ATT_LOADKV(F.blk); }
#pragma unroll 1
    for (int u = F.blk; u < BATCH * 12 * 16; u += F.G) {
        ATT_DECODE(u, b, h, dsh, r, qb); const int grp = h >> 2, s = h & 3, dil = 1 << dsh, m0 = qb * 128;
        const int rowb = b * SEQ;
        TS_BEGIN();
        __syncthreads();
        const int tid2 = opaque_tid();
#pragma unroll
        for (int pass = 0; pass < 8; ++pass) {
            if (qb == 0 && pass < 4) continue;
            const int wi = pass * 32 + (tid2 >> 4), c = tid2 & 15;
            const u32x4 kv = kreg[pass], vv = vreg[pass];
            float ss = 0.f;
#pragma unroll
            for (int i = 0; i < 4; ++i) { const float a0 = bflo(kv[i]), a1 = bfhi(kv[i]); ss += a0 * a0 + a1 * a1; }
            ss = red16(ss);
            if (c == 0) rkS[wi] = rsqrtf(ss * (1.f / 128.f) + EPS);
            *(LAS u32x4*)(Ks + wi * 256 + ((c ^ (wi & 15)) << 4)) = kv;
            *(LAS u32x4*)(Vs + wi * 256 + ((c ^ ((wi & 7) << 1)) << 4)) = vv;
        }
        TS_END(14);
        bf16x8 qf[4];
        {
            float ss = 0.f;
#pragma unroll
            for (int ks = 0; ks < 4; ++ks)
#pragma unroll
                for (int i = 0; i < 4; ++i) { const float a0 = bflo(qreg[ks][i]), a1 = bfhi(qreg[ks][i]); ss += a0 * a0 + a1 * a1; }
            ss += __shfl_xor(ss, 16); ss += __shfl_xor(ss, 32);
            const float rqs = rsqrtf(ss * (1.f / 128.f) + EPS);
#pragma unroll
            for (int ks = 0; ks < 4; ++ks) { const f32x4 g0 = *(const LAS f32x4*)(gqkS + 32 * ks + 8 * g), g1 = *(const LAS f32x4*)(gqkS + 32 * ks + 8 * g + 4); u32x4 o;
                o[0] = pk2(bflo(qreg[ks][0]) * rqs * g0.x, bfhi(qreg[ks][0]) * rqs * g0.y); o[1] = pk2(bflo(qreg[ks][1]) * rqs * g0.z, bfhi(qreg[ks][1]) * rqs * g0.w);
                o[2] = pk2(bflo(qreg[ks][2]) * rqs * g1.x, bfhi(qreg[ks][2]) * rqs * g1.y); o[3] = pk2(bflo(qreg[ks][3]) * rqs * g1.z, bfhi(qreg[ks][3]) * rqs * g1.w);
                qf[ks] = __builtin_bit_cast(bf16x8, o); }
        }
        TS_END(23);
        __syncthreads();
        if (u + F.G < BATCH * 12 * 16) { ATT_LOADKV(u + F.G); }
        TS_END(15);
        f32x4 st[9];
        float mx = -INFINITY;
#pragma unroll
        for (int j = 0; j < 9; ++j) {
            const int tau = wave + j;
            st[j] = (f32x4){-INFINITY, -INFINITY, -INFINITY, -INFINITY};
            if (qb > 0 || tau >= 8) {
                f32x4 a = {0.f, 0.f, 0.f, 0.f};
                const LAS unsigned char* kp = Ks + (16 * tau + n) * 256;
#pragma unroll
                for (int ks = 0; ks < 4; ++ks) { const bf16x8 kf = *(const LAS bf16x8*)(kp + (((4 * ks + g) ^ n) << 4));
                    a = __builtin_amdgcn_mfma_f32_16x16x32_bf16(kf, qf[ks], a, 0, 0, 0); }
                const f32x4 rk = *(const LAS f32x4*)(rkS + 16 * tau + 4 * g);
                a = a * rk;
                if (j == 0) {
#pragma unroll
                    for (int reg = 0; reg < 4; ++reg) if (4 * g + reg < n) a[reg] = -INFINITY; }
                if (j == 8) {
#pragma unroll
                    for (int reg = 0; reg < 4; ++reg) if (4 * g + reg > n) a[reg] = -INFINITY; }
                st[j] = a;
                mx = fmaxf(mx, fmaxf(fmaxf(a[0], a[1]), fmaxf(a[2], a[3])));
            }
        }
        TS_END(16);
        mx = fmaxf(mx, __shfl_xor(mx, 16)); mx = fmaxf(mx, __shfl_xor(mx, 32));
        float lsum = 0.f;
#pragma unroll
        for (int j = 0; j < 9; ++j)
#pragma unroll
            for (int reg = 0; reg < 4; ++reg) { const float p = __builtin_amdgcn_exp2f(st[j][reg] - mx); st[j][reg] = p; lsum += p; }
        lsum += __shfl_xor(lsum, 16); lsum += __shfl_xor(lsum, 32);
        TS_END(17);
        f32x4 o[8];
#pragma unroll
        for (int dt = 0; dt < 8; ++dt) o[dt] = (f32x4){0.f, 0.f, 0.f, 0.f};
        const int q4 = (lane & 15) >> 2, p4 = lane & 3;
#pragma unroll
        for (int a = 0; a < 5; ++a) {
            const int tA = wave + 2 * a, tB = a < 4 ? tA + 1 : tA;
            if (qb > 0 || tB >= 8) {
                u32x4 pw; pw[0] = pk2(st[2 * a][0], st[2 * a][1]); pw[1] = pk2(st[2 * a][2], st[2 * a][3]);
                if (a < 4) { pw[2] = pk2(st[2 * a + 1][0], st[2 * a + 1][1]); pw[3] = pk2(st[2 * a + 1][2], st[2 * a + 1][3]); } else { pw[2] = 0u; pw[3] = 0u; }
                const bf16x8 pf = __builtin_bit_cast(bf16x8, pw);
                const int tAe = (qb == 0 && tA < 8) ? tB : tA;
                const int row0 = 16 * tAe + 4 * g + q4, row1 = 16 * tB + 4 * g + q4;
#pragma unroll
                for (int dt = 0; dt < 8; ++dt) {
                    const int c = 2 * dt + (p4 >> 1);
                    const v4i16_t v0 = __builtin_amdgcn_ds_read_tr16_b64_v4i16((LAS v4i16_t*)(Vs + row0 * 256 + ((c ^ ((row0 & 7) << 1)) << 4) + 8 * (p4 & 1)));
                    const v4i16_t v1 = __builtin_amdgcn_ds_read_tr16_b64_v4i16((LAS v4i16_t*)(Vs + row1 * 256 + ((c ^ ((row1 & 7) << 1)) << 4) + 8 * (p4 & 1)));
                    const bf16x8 vf = (bf16x8){v0[0], v0[1], v0[2], v0[3], v1[0], v1[1], v1[2], v1[3]};
                    o[dt] = __builtin_amdgcn_mfma_f32_16x16x32_bf16(vf, pf, o[dt], 0, 0, 0);
                }
            }
        }
        TS_END(18);
        const float il = __builtin_amdgcn_rcpf(lsum);
        const int tq = rowb + (m0 + 16 * wave + n) * dil + r;
        unsigned char* OG = grp < 2 ? F.ws + WS_OG01 + (size_t)grp * T * 512 : F.ob + OUT_OG2;
#pragma unroll
        for (int dt = 0; dt < 8; ++dt) { int w8 = 0; w8 = __builtin_amdgcn_cvt_pk_fp8_f32(o[dt][0] * il, o[dt][1] * il, w8, false); w8 = __builtin_amdgcn_cvt_pk_fp8_f32(o[dt][2] * il, o[dt][3] * il, w8, true);
            *(unsigned*)(OG + (size_t)tq * 512 + s * 128 + 16 * dt + 4 * g) = (unsigned)w8; }
        if (g == 0) ((float*)(F.ws + WS_LSE))[((size_t)grp * T + (size_t)tq) * 4 + s] = (mx + __builtin_amdgcn_logf(lsum)) * 0.6931471805599453f;
        TS_END(19);
    }
}
#undef ATT_DECODE
#undef ATT_LOADKV
__device__ __forceinline__ void p3_merge(Frame& F, const int b0, const int nb) {
    const int tid = opaque_tid();
    if (F.blk < b0 || F.blk >= b0 + nb) return;
    const unsigned char* OG0 = F.ws + WS_OG01; const unsigned char* OG1 = OG0 + (size_t)T * 512; const unsigned char* OG2 = F.ob + OUT_OG2;
    const float* LSE = (const float*)(F.ws + WS_LSE); unsigned char* YB = F.ws + WS_YB;
    for (size_t it = (size_t)(F.blk - b0) * 512 + tid; it < (size_t)T * 64; it += (size_t)nb * 512) {
        const size_t t = it >> 6; const int ch = (int)(it & 63), s = ch >> 4;
        const float l0 = LSE[t * 4 + s], l1 = LSE[((size_t)T + t) * 4 + s], l2 = LSE[((size_t)2 * T + t) * 4 + s];
        const float m = fmaxf(l0, fmaxf(l1, l2)); const float e0 = __expf(l0 - m), e1 = __expf(l1 - m), e2 = __expf(l2 - m); const float inv = 1.f / (e0 + e1 + e2);
        const float w0 = e0 * inv, w1 = e1 * inv, w2 = e2 * inv;
        const u32x2 a = __builtin_nontemporal_load((const u32x2*)(OG0 + t * 512 + ch * 8)), bq = __builtin_nontemporal_load((const u32x2*)(OG1 + t * 512 + ch * 8)), cq = __builtin_nontemporal_load((const u32x2*)(OG2 + t * 512 + ch * 8));
        float o[8];
#pragma unroll
        for (int i = 0; i < 2; ++i) { const f32x2 a0 = __builtin_amdgcn_cvt_pk_f32_fp8((int)a[i], false), a1 = __builtin_amdgcn_cvt_pk_f32_fp8((int)a[i], true), b0 = __builtin_amdgcn_cvt_pk_f32_fp8((int)bq[i], false), b1 = __builtin_amdgcn_cvt_pk_f32_fp8((int)bq[i], true),
                c0 = __builtin_amdgcn_cvt_pk_f32_fp8((int)cq[i], false), c1 = __builtin_amdgcn_cvt_pk_f32_fp8((int)cq[i], true);
            o[4 * i] = w0 * a0.x + w1 * b0.x + w2 * c0.x; o[4 * i + 1] = w0 * a0.y + w1 * b0.y + w2 * c0.y; o[4 * i + 2] = w0 * a1.x + w1 * b1.x + w2 * c1.x; o[4 * i + 3] = w0 * a1.y + w1 * b1.y + w2 * c1.y; }
        int p0 = 0, p1 = 0;
        p0 = __builtin_amdgcn_cvt_pk_fp8_f32(o[0], o[1], p0, false); p0 = __builtin_amdgcn_cvt_pk_fp8_f32(o[2], o[3], p0, true);
        p1 = __builtin_amdgcn_cvt_pk_fp8_f32(o[4], o[5], p1, false); p1 = __builtin_amdgcn_cvt_pk_fp8_f32(o[6], o[7], p1, true);
        u32x2 w; w.x = (unsigned)p0; w.y = (unsigned)p1; *(u32x2*)(YB + t * 512 + ch * 8) = w;
    }
}

constexpr size_t WS_UT = 158 * MiB, WS_WM = 190 * MiB, WS_QD = 222 * MiB, WS_KDT = 254 * MiB, WS_QK = 286 * MiB;
constexpr size_t WS_GT = 1 * MiB + 512 * 1024;
__device__ __forceinline__ unsigned off_b(unsigned row, unsigned ch) { return 256u * row + 16u * (ch ^ (((row & 3) << 2) | ((row >> 2) & 3))); }
__device__ __forceinline__ unsigned rowfrag_b(unsigned lane, unsigned rb, unsigned s) { return off_b((lane & 15) + 16 * rb, 4 * s + (lane >> 4)); }
__device__ __forceinline__ unsigned trfrag_b(unsigned lane, unsigned c, unsigned ks, unsigned t) { const unsigned g = lane >> 4, q = (lane & 15) >> 2, p = lane & 3; return off_b(32 * ks + 8 * g + 4 * t + q, 2 * c + (p >> 1)) + 8 * (p & 1); }
__device__ __forceinline__ bf16x8 tr_pair(LAS unsigned char* a0, LAS unsigned char* a1) {
    const v4i16_t v0 = __builtin_amdgcn_ds_read_tr16_b64_v4i16((LAS v4i16_t*)a0), v1 = __builtin_amdgcn_ds_read_tr16_b64_v4i16((LAS v4i16_t*)a1);
    return (bf16x8){v0[0], v0[1], v0[2], v0[3], v1[0], v1[1], v1[2], v1[3]};
}
constexpr int MST = 144;
__device__ __forceinline__ f32x4 mm64_tile(LAS unsigned char* X, LAS unsigned char* Y, int ti, int tj, int lane) {
    const int n = lane & 15, g = lane >> 4, q = n >> 2, p = lane & 3;
    f32x4 acc = {0.f, 0.f, 0.f, 0.f};
#pragma unroll
    for (int ks = 0; ks < 2; ++ks) {
        const bf16x8 a = *(const LAS bf16x8*)(X + (16 * ti + n) * MST + 16 * (4 * ks + g));
        LAS unsigned char* yb = Y + (32 * ks + 8 * g + q) * MST + 32 * tj + 8 * p;
        const bf16x8 b = tr_pair(yb, yb + 4 * MST);
        acc = __builtin_amdgcn_mfma_f32_16x16x32_bf16(a, b, acc, 0, 0, 0);
    }
    return acc;
}
__device__ __forceinline__ void st_b16(LAS unsigned char* M, int row, int col, float v) { *(LAS unsigned short*)(M + row * MST + col * 2) = (unsigned short)pk2(v, 0.f); }

__device__ __forceinline__ void p3b_gdn_prep(Frame& F) {
    LAS unsigned char* Kn = F.lds; LAS unsigned char* Qn = F.lds + 16384; LAS unsigned char* Vn = F.lds + 32768;
    LAS unsigned char* R0 = F.lds + 49152; LAS unsigned char* R1 = R0 + 9216; LAS unsigned char* R2 = R1 + 9216; LAS unsigned char* R3 = R2 + 9216; LAS unsigned char* R4 = R3 + 9216;
    LAS float* Af = (LAS float*)(F.lds + 95232);
    LAS float* CW = (LAS float*)(F.lds + 111872);
    LAS float* betaS = (LAS float*)(F.lds + 118016); LAS float* gS = betaS + 64; LAS float* gcS = gS + 64;
    const bf16_t* GQ = (const bf16_t*)(F.ws + WS_GQ); const float* BA = (const float*)(F.ws + WS_BA);
    bf16_t* UT = (bf16_t*)(F.ws + WS_UT); bf16_t* WM = (bf16_t*)(F.ws + WS_WM); bf16_t* QD = (bf16_t*)(F.ws + WS_QD); bf16_t* KDT = (bf16_t*)(F.ws + WS_KDT); bf16_t* QK = (bf16_t*)(F.ws + WS_QK);
    float* GT = (float*)(F.ws + WS_GT);
    const float* convw = inp(I_CONVW);
    LAS unsigned char* RAW = F.lds + 49152;
    u32x4 own[3][2], halo; float cwr[3], bar0 = 0.f, bar1 = 0.f;
#define PREP_LOAD(u_) do { const int t_ = opaque_tid(), tr_ = t_ >> 3, cg_ = t_ & 7, h_ = ((u_) >> 5) & 7, nch_ = (u_) & 31; const size_t t0_ = (size_t)((u_) >> 8) * SEQ + 64 * nch_; \
        _Pragma("unroll") for (int tens = 0; tens < 3; ++tens) { const bf16_t* src = GQ + (size_t)tens * T * 1024 + (t0_ + tr_) * 1024 + h_ * 128 + 16 * cg_; own[tens][0] = *(const u32x4*)src; own[tens][1] = *(const u32x4*)(src + 8); } \
        halo = (u32x4){0u, 0u, 0u, 0u}; \
        if (t_ < 144 && nch_ > 0) { const int tens = t_ / 48, rem = t_ % 48; halo = *(const u32x4*)(GQ + (size_t)tens * T * 1024 + (t0_ - 3 + (rem >> 4)) * 1024 + h_ * 128 + (rem & 15) * 8); } \
        _Pragma("unroll") for (int i = 0; i < 3; ++i) { const int ii = t_ + 512 * i; cwr[i] = convw[((ii >> 7) & 3) * 3072 + (ii >> 9) * 1024 + h_ * 128 + (ii & 127)]; } \
        if (cg_ == 0) { bar0 = BA[(t0_ + tr_) * 16 + h_]; bar1 = BA[(t0_ + tr_) * 16 + 8 + h_]; } } while (0)
    LAS unsigned char* const lds = F.lds; (void)lds;
    if (F.blk < 2048) { PREP_LOAD(F.blk); }
#pragma unroll 1
    for (int u = F.blk; u < 2048; u += F.G) {
        const int tid = opaque_tid(), lane = tid & 63, wave = __builtin_amdgcn_readfirstlane(tid >> 6), n = lane & 15, g = lane >> 4;
        const int h = (u >> 5) & 7, nch = u & 31;
        const int tr = tid >> 3, cg = tid & 7;
        TS_BEGIN();
        __syncthreads();
#pragma unroll
        for (int i = 0; i < 3; ++i) CW[tid + 512 * i] = cwr[i];
#pragma unroll
        for (int tens = 0; tens < 3; ++tens) { LAS unsigned char* rp = RAW + (tens * 67 + 3 + tr) * 272 + 32 * cg; *(LAS u32x4*)rp = own[tens][0]; *(LAS u32x4*)(rp + 16) = own[tens][1]; }
        if (tid < 144) { const int tens = tid / 48, rem = tid % 48; *(LAS u32x4*)(RAW + (tens * 67 + (rem >> 4)) * 272 + (rem & 15) * 16) = halo; }
        __syncthreads();
        TS_END(0);
        float qv[16], kv[16];
        {
            float vv[16];
#pragma unroll
            for (int tens = 0; tens < 3; ++tens) {
                float acc[16];
#pragma unroll
                for (int c = 0; c < 16; ++c) acc[c] = 0.f;
#pragma unroll
                for (int j = 0; j < 4; ++j) { const LAS unsigned char* rp = RAW + (tens * 67 + tr + j) * 272 + 32 * cg; const u32x4 x0 = *(const LAS u32x4*)rp, x1 = *(const LAS u32x4*)(rp + 16);
                        const LAS float* w = CW + (tens * 4 + j) * 128 + 16 * cg;
#pragma unroll
                        for (int i = 0; i < 4; ++i) { acc[2 * i] += w[2 * i] * bflo(x0[i]); acc[2 * i + 1] += w[2 * i + 1] * bfhi(x0[i]); acc[8 + 2 * i] += w[8 + 2 * i] * bflo(x1[i]); acc[9 + 2 * i] += w[9 + 2 * i] * bfhi(x1[i]); } }
#pragma unroll
                for (int c = 0; c < 16; ++c) { const float y = siluf_(acc[c]); if (tens == 0) qv[c] = y; else if (tens == 1) kv[c] = y; else vv[c] = y; }
            }
            float sq = 0.f, sk = 0.f;
#pragma unroll
            for (int c = 0; c < 16; ++c) { sq += qv[c] * qv[c]; sk += kv[c] * kv[c]; }
            sq = red8(sq); sk = red8(sk);
            const float rq = rsqrtf(sq + EPS) * 0.08838834764831845f, rk = rsqrtf(sk + EPS);
#pragma unroll
            for (int c = 0; c < 16; ++c) { qv[c] *= rq; kv[c] *= rk; }
#pragma unroll
            for (int hf = 0; hf < 2; ++hf) { u32x4 a, bq, cq;
#pragma unroll
                for (int i = 0; i < 4; ++i) { a[i] = pk2(kv[8 * hf + 2 * i], kv[8 * hf + 2 * i + 1]); bq[i] = pk2(qv[8 * hf + 2 * i], qv[8 * hf + 2 * i + 1]); cq[i] = pk2(vv[8 * hf + 2 * i], vv[8 * hf + 2 * i + 1]); }
                const unsigned o = off_b(tr, 2 * cg + hf);
                *(LAS u32x4*)(Kn + o) = a; *(LAS u32x4*)(Qn + o) = bq; *(LAS u32x4*)(Vn + o) = cq; }
        }
        if (cg == 0) { const float bb = bar0, aa = bar1; const float sp = aa + inp(I_DTB)[h]; const float spl = sp > 20.f ? sp : log1pf(__expf(sp));
            betaS[tr] = sigmoidf_(bb); gS[tr] = -__expf(inp(I_ALOG)[h]) * spl; }
        __syncthreads();
        TS_END(1);
        if (wave == 0) { float v = gS[lane];
#pragma unroll
            for (int d = 1; d < 64; d <<= 1) { const float t = __shfl_up(v, d); if (lane >= d) v += t; }
            gcS[lane] = v; }
        __syncthreads();
        {
            const float eg = __expf(gcS[tr]);
            u32x4 a, bq;
#pragma unroll
            for (int i = 0; i < 4; ++i) { a[i] = pk2(qv[2 * i] * eg, qv[2 * i + 1] * eg); bq[i] = pk2(qv[8 + 2 * i] * eg, qv[9 + 2 * i] * eg); }
            bf16_t* d = QD + (size_t)u * 8192 + (size_t)(((tr >> 4) * 4 + (cg >> 1)) * 64 + (tr & 15)) * 8;
            { const int c = cg & 1; u32x2 p0, p1, p2, p3; p0.x = a[0]; p0.y = a[1]; p1.x = a[2]; p1.y = a[3]; p2.x = bq[0]; p2.y = bq[1]; p3.x = bq[2]; p3.y = bq[3];
              *(u32x2*)(d + (0 * 16) * 8 + 4 * c) = p0; *(u32x2*)(d + (1 * 16) * 8 + 4 * c) = p1; *(u32x2*)(d + (2 * 16) * 8 + 4 * c) = p2; *(u32x2*)(d + (3 * 16) * 8 + 4 * c) = p3; }
        }
        if (u + F.G < 2048) { PREP_LOAD(u + F.G); }
        const float gcl = gcS[63];
        if (tid == 0) GT[u] = __expf(gcl);
        TS_END(2);
#pragma unroll
        for (int rep = 0; rep < 2; ++rep) {
            const int idx = wave + 8 * rep, ti = idx >> 2, tj = idx & 3;
            f32x4 kk = {0.f, 0.f, 0.f, 0.f}, qk = {0.f, 0.f, 0.f, 0.f};
            if (ti >= tj) {
#pragma unroll
                for (int ks = 0; ks < 4; ++ks) { const bf16x8 a = *(const LAS bf16x8*)(Kn + rowfrag_b(lane, ti, ks)), bb = *(const LAS bf16x8*)(Kn + rowfrag_b(lane, tj, ks));
                    kk = __builtin_amdgcn_mfma_f32_16x16x32_bf16(a, bb, kk, 0, 0, 0); }
#pragma unroll
                for (int ks = 0; ks < 4; ++ks) { const bf16x8 a = *(const LAS bf16x8*)(Kn + rowfrag_b(lane, tj, ks)), bb = *(const LAS bf16x8*)(Qn + rowfrag_b(lane, ti, ks));
                    qk = __builtin_amdgcn_mfma_f32_16x16x32_bf16(a, bb, qk, 0, 0, 0); }
            }
            {
                const int j = 16 * tj + n; const float gj = gcS[j]; const f32x4 gi4 = *(const LAS f32x4*)(gcS + 16 * ti + 4 * g), bi4 = *(const LAS f32x4*)(betaS + 16 * ti + 4 * g);
#pragma unroll
                for (int reg = 0; reg < 4; ++reg) { const int i = 16 * ti + 4 * g + reg; float v = 0.f; if (j < i) v = kk[reg] * bi4[reg] * __expf(gi4[reg] - gj);
                    Af[i * 65 + j] = v; st_b16(R0, i, j, ti > tj ? v : 0.f); }
            }
            {
                const int i = 16 * ti + n; const float gi = gcS[i]; const f32x4 gj4 = *(const LAS f32x4*)(gcS + 16 * tj + 4 * g); float o[4];
#pragma unroll
                for (int reg = 0; reg < 4; ++reg) { const int j = 16 * tj + 4 * g + reg; o[reg] = (j <= i) ? qk[reg] * __expf(gi - gj4[reg]) : 0.f; }
                u32x2 w; w.x = pk2(o[0], o[1]); w.y = pk2(o[2], o[3]);
                *(u32x2*)(QK + (size_t)u * 4096 + (size_t)((ti * 2 + (tj >> 1)) * 64 + g * 16 + n) * 8 + 4 * (tj & 1)) = w;
            }
        }
        for (int i = tid; i < 9216 / 4; i += 512) ((LAS unsigned*)R1)[i] = 0u;
        __syncthreads();
        TS_END(3);
        if (tid < 64) { const int bI = tid >> 4, cc = tid & 15; float x[16];
#pragma unroll
            for (int i = 0; i < 16; ++i) { float s = (i == cc) ? 1.f : 0.f;
#pragma unroll
                for (int j = 0; j < 16; ++j) if (j < i) s -= Af[(16 * bI + i) * 65 + 16 * bI + j] * x[j];
                x[i] = s; }
#pragma unroll
            for (int i = 0; i < 16; ++i) st_b16(R1, 16 * bI + i, 16 * bI + cc, x[i]); }
        __syncthreads();
        TS_END(4);
#pragma unroll
        for (int rep = 0; rep < 2; ++rep) { const int idx = wave + 8 * rep, ti = idx >> 2, tj = idx & 3; const f32x4 m = mm64_tile(R1, R0, ti, tj, lane);
#pragma unroll
            for (int reg = 0; reg < 4; ++reg) { const int i = 16 * ti + 4 * g + reg, j = 16 * tj + n; st_b16(R2, i, j, m[reg]); st_b16(R3, i, j, (i == j ? 1.f : 0.f) - m[reg]); } }
        __syncthreads();
#pragma unroll
        for (int rep = 0; rep < 2; ++rep) { const int idx = wave + 8 * rep, ti = idx >> 2, tj = idx & 3; const f32x4 m = mm64_tile(R2, R2, ti, tj, lane);
#pragma unroll
            for (int reg = 0; reg < 4; ++reg) { const int i = 16 * ti + 4 * g + reg, j = 16 * tj + n; st_b16(R4, i, j, (i == j ? 1.f : 0.f) + m[reg]); } }
        __syncthreads();
#pragma unroll
        for (int rep = 0; rep < 2; ++rep) { const int idx = wave + 8 * rep, ti = idx >> 2, tj = idx & 3; const f32x4 m = mm64_tile(R4, R1, ti, tj, lane);
#pragma unroll
            for (int reg = 0; reg < 4; ++reg) { const int i = 16 * ti + 4 * g + reg, j = 16 * tj + n; st_b16(R0, i, j, m[reg]); } }
        __syncthreads();
#pragma unroll
        for (int rep = 0; rep < 2; ++rep) { const int idx = wave + 8 * rep, ti = idx >> 2, tj = idx & 3; const f32x4 m = mm64_tile(R3, R0, ti, tj, lane);
            const int j = 16 * tj + n; const float bj = betaS[j], bw = bj * __expf(gcS[j]);
#pragma unroll
            for (int reg = 0; reg < 4; ++reg) { const int i = 16 * ti + 4 * g + reg; st_b16(R2, i, j, m[reg] * bj); st_b16(R4, i, j, m[reg] * bw); } }
        __syncthreads();
        TS_END(5);
        {
            const int tt = wave >> 1, dvb = 4 * (wave & 1);
#pragma unroll
            for (int k = 0; k < 4; ++k) { const int dvt = dvb + k; f32x4 acc = {0.f, 0.f, 0.f, 0.f};
#pragma unroll
                for (int ks = 0; ks < 2; ++ks) { const bf16x8 a = *(const LAS bf16x8*)(R2 + (16 * tt + n) * MST + 16 * (4 * ks + g));
                    const bf16x8 bb = tr_pair(Vn + trfrag_b(lane, dvt, ks, 0), Vn + trfrag_b(lane, dvt, ks, 1));
                    acc = __builtin_amdgcn_mfma_f32_16x16x32_bf16(a, bb, acc, 0, 0, 0); }
                u32x2 w; w.x = pk2(acc[0], acc[1]); w.y = pk2(acc[2], acc[3]);
                *(u32x2*)(UT + (size_t)u * 8192 + (size_t)((tt * 8 + dvt) * 64 + lane) * 4) = w; }
            const int dkt = wave;
#pragma unroll
            for (int t4 = 0; t4 < 4; ++t4) { f32x4 acc = {0.f, 0.f, 0.f, 0.f};
#pragma unroll
                for (int ks = 0; ks < 2; ++ks) { const bf16x8 a = tr_pair(Kn + trfrag_b(lane, dkt, ks, 0), Kn + trfrag_b(lane, dkt, ks, 1));
                    if (t4 == 0) {
                        const f32x4 e0 = *(const LAS f32x4*)(gcS + 32 * ks + 8 * g), e1 = *(const LAS f32x4*)(gcS + 32 * ks + 8 * g + 4); u32x4 w;
                        w[0] = pk2(bf2f((unsigned short)a[0]) * __expf(gcl - e0.x), bf2f((unsigned short)a[1]) * __expf(gcl - e0.y)); w[1] = pk2(bf2f((unsigned short)a[2]) * __expf(gcl - e0.z), bf2f((unsigned short)a[3]) * __expf(gcl - e0.w));
                        w[2] = pk2(bf2f((unsigned short)a[4]) * __expf(gcl - e1.x), bf2f((unsigned short)a[5]) * __expf(gcl - e1.y)); w[3] = pk2(bf2f((unsigned short)a[6]) * __expf(gcl - e1.z), bf2f((unsigned short)a[7]) * __expf(gcl - e1.w));
                        { bf16_t* kd = KDT + (size_t)u * 8192 + (size_t)((dkt * 2 + ks) * 64) * 8 + 4 * (g >> 1); u32x2 lo, hi; lo.x = w[0]; lo.y = w[1]; hi.x = w[2]; hi.y = w[3];
                          *(u32x2*)(kd + (size_t)(((2 * g) & 3) * 16 + n) * 8) = lo; *(u32x2*)(kd + (size_t)(((2 * g + 1) & 3) * 16 + n) * 8) = hi; } }
                    const bf16x8 bb = *(const LAS bf16x8*)(R4 + (16 * t4 + n) * MST + 16 * (4 * ks + g));
                    acc = __builtin_amdgcn_mfma_f32_16x16x32_bf16(a, bb, acc, 0, 0, 0); }
                u32x2 w; w.x = pk2(acc[0], acc[1]); w.y = pk2(acc[2], acc[3]);
                *(u32x2*)(WM + (size_t)u * 8192 + (size_t)((t4 * 4 + (dkt >> 1)) * 64 + g * 16 + n) * 8 + 4 * (dkt & 1)) = w; }
        }
        TS_END(6);
    }
}

#undef PREP_LOAD
__device__ __forceinline__ void p4_gdn_scan(Frame& F) {
    if (F.blk >= 64) return;
    const int tid = opaque_tid(), lane = tid & 63, wave = __builtin_amdgcn_readfirstlane(tid >> 6), n = lane & 15, g = lane >> 4;
    const int b = F.blk >> 3, h = F.blk & 7; const size_t u0 = (size_t)F.blk * 32;
    LAS unsigned char* SbT0 = F.lds; LAS unsigned char* VNT = F.lds + 69632; LAS unsigned char* Os0 = F.lds + 88064; LAS float* ngS = (LAS float*)(F.lds + 122880);
    const bf16_t* UT = (const bf16_t*)(F.ws + WS_UT); const bf16_t* WM = (const bf16_t*)(F.ws + WS_WM); const bf16_t* QD = (const bf16_t*)(F.ws + WS_QD);
    const bf16_t* KDT = (const bf16_t*)(F.ws + WS_KDT); const bf16_t* QK = (const bf16_t*)(F.ws + WS_QK); const float* GT = (const float*)(F.ws + WS_GT);
    const bf16_t* GZ = (const bf16_t*)(F.ob + OUT_GZ); unsigned char* YA = F.ws + WS_YA;
    const int tt = wave >> 1, dvb = 4 * (wave & 1);
    const int tok = tid >> 3, seg = tid & 7;
    f32x4 S[8];
#pragma unroll
    for (int i = 0; i < 8; ++i) S[i] = (f32x4){0.f, 0.f, 0.f, 0.f};
    if (tid < 128) ngS[tid] = inp(I_GNG)[tid];
    bf16x8 wfA[4], wfB[4], qdf[4], qkf[2], kdf[2]; u32x2 ufA[4], ufB[4]; u32x4 zc[2], zp[2]; float gtA, gtB;
    const unsigned lo_w = (unsigned)((tt * 4) * 64 + lane) * 16u, lo_u = (unsigned)((tt * 8 + dvb) * 64 + lane) * 8u, lo_qk = (unsigned)((tt * 2) * 64 + lane) * 16u,
                   lo_kd = (unsigned)((wave * 2) * 64 + lane) * 16u, lo_z = (unsigned)(tok * 1024 + h * 128 + 16 * seg) * 2u;
    const char* const pWM = (const char*)(WM + u0 * 8192); const char* const pQD = (const char*)(QD + u0 * 8192); const char* const pUT = (const char*)(UT + u0 * 8192);
    const char* const pKD = (const char*)(KDT + u0 * 8192); const char* const pQK = (const char*)(QK + u0 * 4096); const char* const pGZ = (const char*)(GZ + (size_t)b * SEQ * 1024);
#define LD_SET(X, nn_) do { const unsigned c16_ = (unsigned)(nn_) * 16384u; \
        _Pragma("unroll") for (int ks = 0; ks < 4; ++ks) wf##X[ks] = *(const bf16x8*)(pWM + (c16_ + lo_w + 1024u * ks)); \
        _Pragma("unroll") for (int k = 0; k < 4; ++k) uf##X[k] = *(const u32x2*)(pUT + (c16_ + lo_u + 512u * k)); \
        gt##X = GT[u0 + (nn_)]; } while (0)
#define LD_Q(nn_) do { const unsigned c16_ = (unsigned)(nn_) * 16384u, c8_ = (unsigned)(nn_) * 8192u; \
        _Pragma("unroll") for (int ks = 0; ks < 4; ++ks) qdf[ks] = *(const bf16x8*)(pQD + (c16_ + lo_w + 1024u * ks)); \
        _Pragma("unroll") for (int ks = 0; ks < 2; ++ks) qkf[ks] = *(const bf16x8*)(pQK + (c8_ + lo_qk + 1024u * ks)); } while (0)
#define LD_K(nn_) do { const unsigned c16_ = (unsigned)(nn_) * 16384u, cz_ = (unsigned)(nn_) * 131072u; \
        _Pragma("unroll") for (int ks = 0; ks < 2; ++ks) kdf[ks] = *(const bf16x8*)(pKD + (c16_ + lo_kd + 1024u * ks)); \
        zc[0] = *(const u32x4*)(pGZ + (cz_ + lo_z)); zc[1] = *(const u32x4*)(pGZ + (cz_ + lo_z + 16u)); } while (0)
#define NORM_OUT(OsB, nc_, Z) do { const size_t t = (size_t)b * SEQ + 64 * (nc_) + tok; \
        const u32x4 o0 = *(const LAS u32x4*)((OsB) + tok * 272 + 32 * seg), o1 = *(const LAS u32x4*)((OsB) + tok * 272 + 32 * seg + 16); float o[16]; float ss = 0.f; \
        _Pragma("unroll") for (int i = 0; i < 4; ++i) { o[2 * i] = bflo(o0[i]); o[2 * i + 1] = bfhi(o0[i]); o[8 + 2 * i] = bflo(o1[i]); o[9 + 2 * i] = bfhi(o1[i]); } \
        _Pragma("unroll") for (int i = 0; i < 16; ++i) ss += o[i] * o[i]; \
        ss = red8(ss); \
        const float rstd = rsqrtf(ss * (1.f / 128.f) + EPS); \
        u32x4 y8; \
        _Pragma("unroll") for (int i = 0; i < 4; ++i) { int w8 = 0; \
            w8 = __builtin_amdgcn_cvt_pk_fp8_f32(o[4 * i] * rstd * ngS[16 * seg + 4 * i] * ((i & 1) ? bflo(Z[i >> 1][2]) : bflo(Z[i >> 1][0])), o[4 * i + 1] * rstd * ngS[16 * seg + 4 * i + 1] * ((i & 1) ? bfhi(Z[i >> 1][2]) : bfhi(Z[i >> 1][0])), w8, false); \
            w8 = __builtin_amdgcn_cvt_pk_fp8_f32(o[4 * i + 2] * rstd * ngS[16 * seg + 4 * i + 2] * ((i & 1) ? bflo(Z[i >> 1][3]) : bflo(Z[i >> 1][1])), o[4 * i + 3] * rstd * ngS[16 * seg + 4 * i + 3] * ((i & 1) ? bfhi(Z[i >> 1][3]) : bfhi(Z[i >> 1][1])), w8, true); y8[i] = (unsigned)w8; } \
        *(u32x4*)(YA + t * 1024 + h * 128 + 16 * seg) = y8; } while (0)
#define CHUNK(X, nc_, P) do { LAS unsigned char* const SbT = SbT0 + (P) * 34816; LAS unsigned char* const OsW = Os0 + (P) * 17408; \
          \
        _Pragma("unroll") for (int dvt = 0; dvt < 8; ++dvt) { u32x2 w; w.x = pk2(S[dvt][0], S[dvt][1]); w.y = pk2(S[dvt][2], S[dvt][3]); \
            *(LAS u32x2*)(SbT + (16 * dvt + n) * 272 + (16 * wave + 4 * g) * 2) = w; } \
        __syncthreads(); \
          \
        if ((nc_) > 0) { NORM_OUT(Os0 + (1 - (P)) * 17408, (nc_) - 1, zp); } \
          \
        { f32x4 acc[4]; \
          _Pragma("unroll") for (int k = 0; k < 4; ++k) acc[k] = (f32x4){0.f, 0.f, 0.f, 0.f}; \
          _Pragma("unroll") for (int ks = 0; ks < 4; ++ks) { bf16x8 bb[4]; \
            _Pragma("unroll") for (int k = 0; k < 4; ++k) bb[k] = *(const LAS bf16x8*)(SbT + (16 * (dvb + k) + n) * 272 + 16 * (4 * ks + g)); \
            _Pragma("unroll") for (int k = 0; k < 4; ++k) acc[k] = __builtin_amdgcn_mfma_f32_16x16x32_bf16(wf##X[ks], bb[k], acc[k], 0, 0, 0); } \
          _Pragma("unroll") for (int k = 0; k < 4; ++k) { u32x2 w; w.x = pk2(bflo(uf##X[k].x) - acc[k][0], bfhi(uf##X[k].x) - acc[k][1]); w.y = pk2(bflo(uf##X[k].y) - acc[k][2], bfhi(uf##X[k].y) - acc[k][3]); \
            *(LAS u32x2*)(VNT + (16 * (dvb + k) + n) * MST + (16 * tt + 4 * g) * 2) = w; } } \
        __syncthreads(); \
          \
        { f32x4 acc[4]; \
          _Pragma("unroll") for (int k = 0; k < 4; ++k) acc[k] = (f32x4){0.f, 0.f, 0.f, 0.f}; \
          _Pragma("unroll") for (int ks = 0; ks < 4; ++ks) { bf16x8 bb[4]; \
            _Pragma("unroll") for (int k = 0; k < 4; ++k) bb[k] = *(const LAS bf16x8*)(SbT + (16 * (dvb + k) + n) * 272 + 16 * (4 * ks + g)); \
            _Pragma("unroll") for (int k = 0; k < 4; ++k) acc[k] = __builtin_amdgcn_mfma_f32_16x16x32_bf16(qdf[ks], bb[k], acc[k], 0, 0, 0); } \
          _Pragma("unroll") for (int ks = 0; ks < 2; ++ks) { bf16x8 bb[4]; \
            _Pragma("unroll") for (int k = 0; k < 4; ++k) bb[k] = *(const LAS bf16x8*)(VNT + (16 * (dvb + k) + n) * MST + 16 * (4 * ks + g)); \
            _Pragma("unroll") for (int k = 0; k < 4; ++k) acc[k] = __builtin_amdgcn_mfma_f32_16x16x32_bf16(qkf[ks], bb[k], acc[k], 0, 0, 0); } \
          _Pragma("unroll") for (int k = 0; k < 4; ++k) _Pragma("unroll") for (int reg = 0; reg < 4; ++reg) \
              *(LAS unsigned short*)(OsW + (16 * tt + 4 * g + reg) * 272 + (16 * (dvb + k) + n) * 2) = (unsigned short)pk2(acc[k][reg], 0.f); } \
        if ((nc_) + 1 < 32) { LD_Q((nc_) + 1); }     \
          \
        _Pragma("unroll") for (int dvt = 0; dvt < 8; ++dvt) S[dvt] = S[dvt] * gt##X; \
        _Pragma("unroll") for (int ks = 0; ks < 2; ++ks) { bf16x8 bb[8]; \
            _Pragma("unroll") for (int dvt = 0; dvt < 8; ++dvt) bb[dvt] = *(const LAS bf16x8*)(VNT + (16 * dvt + n) * MST + 16 * (4 * ks + g)); \
            _Pragma("unroll") for (int dvt = 0; dvt < 8; ++dvt) S[dvt] = __builtin_amdgcn_mfma_f32_16x16x32_bf16(kdf[ks], bb[dvt], S[dvt], 0, 0, 0); } \
        zp[0] = zc[0]; zp[1] = zc[1]; \
        if ((nc_) + 1 < 32) { LD_K((nc_) + 1); } \
    } while (0)
    LAS unsigned char* const lds = F.lds; (void)lds;
    LD_SET(A, 0); LD_Q(0); LD_K(0);
#pragma unroll 1
    for (int nc = 0; nc < 32; nc += 2) {
        LD_SET(B, nc + 1);
        CHUNK(A, nc, 0);
        if (nc + 2 < 32) { LD_SET(A, nc + 2); }
        CHUNK(B, nc + 1, 1);
    }
    __syncthreads();
    NORM_OUT(Os0 + 17408, 31, zp);
#undef LD_SET
#undef LD_Q
#undef LD_K
#undef NORM_OUT
#undef CHUNK
}

__device__ __forceinline__ bf16x8 s2_frag(const LAS unsigned char* p) { return *(const LAS bf16x8*)p; }
__device__ __forceinline__ void p4_gdn_scan2(Frame& F) {
    if (F.blk >= 64) return;
    const int tid = opaque_tid(), lane = tid & 63, wave = __builtin_amdgcn_readfirstlane(tid >> 6), n = lane & 15, g = lane >> 4;
    const int b = F.blk >> 3, h = F.blk & 7; const size_t u0 = (size_t)F.blk * 32;
    LAS unsigned char* const AB = F.lds; LAS unsigned char* const Os = F.lds + 114688; LAS float* ngS = (LAS float*)(F.lds + 132096);
    const bf16_t* UT = (const bf16_t*)(F.ws + WS_UT); const bf16_t* WM = (const bf16_t*)(F.ws + WS_WM); const bf16_t* QD = (const bf16_t*)(F.ws + WS_QD);
    const bf16_t* KDT = (const bf16_t*)(F.ws + WS_KDT); const bf16_t* QK = (const bf16_t*)(F.ws + WS_QK); const float* GT = (const float*)(F.ws + WS_GT);
    const bf16_t* GZ = (const bf16_t*)(F.ob + OUT_GZ); unsigned char* YA = F.ws + WS_YA;
    const int tok = tid >> 3, seg = tid & 7;
    const char* const pWM = (const char*)(WM + u0 * 8192); const char* const pQD = (const char*)(QD + u0 * 8192); const char* const pUT = (const char*)(UT + u0 * 8192);
    const char* const pKD = (const char*)(KDT + u0 * 8192); const char* const pQK = (const char*)(QK + u0 * 4096); const char* const pGZ = (const char*)(GZ + (size_t)b * SEQ * 1024);
    const unsigned lo_u = (unsigned)(wave * 64 + lane) * 8u, lo_z = (unsigned)(tok * 1024 + h * 128 + 16 * seg) * 2u;
    const unsigned fo = (unsigned)lane * 16u;
    if (tid < 128) ngS[tid] = inp(I_GNG)[tid];
    f32x4 S[8];
#pragma unroll
    for (int i = 0; i < 8; ++i) S[i] = (f32x4){0.f, 0.f, 0.f, 0.f};
    u32x2 ufA[4], ufB[4]; u32x4 zA[2], zB[2]; float gtA, gtB;
    const char* sb_[7]; int so_[7], ss_[7];
#pragma unroll
    for (int j = 0; j < 7; ++j) { const int i = wave * 7 + j;
        if (i < 16) { sb_[j] = pWM + i * 1024; so_[j] = i * 1024; ss_[j] = 16384; }
        else if (i < 32) { sb_[j] = pQD + (i - 16) * 1024; so_[j] = 16384 + (i - 16) * 1024; ss_[j] = 16384; }
        else if (i < 48) { sb_[j] = pKD + (i - 32) * 1024; so_[j] = 32768 + (i - 32) * 1024; ss_[j] = 16384; }
        else { sb_[j] = pQK + (i - 48) * 1024; so_[j] = 49152 + (i - 48) * 1024; ss_[j] = 8192; } }
    u32x4 rg[7];
#define S2_GLOAD(nn_) do { _Pragma("unroll") for (int j_ = 0; j_ < 7; ++j_) rg[j_] = *(const u32x4*)(sb_[j_] + (size_t)(nn_) * ss_[j_] + lane * 16); } while (0)
#define S2_LWRITE(nn_) do { LAS unsigned char* db_ = AB + ((nn_) & 1) * 57344 + lane * 16; _Pragma("unroll") for (int j_ = 0; j_ < 7; ++j_) *(LAS u32x4*)(db_ + so_[j_]) = rg[j_]; } while (0)
#define S2_LDU(X, nn_) do { const unsigned c16_ = (unsigned)(nn_) * 16384u; \
        _Pragma("unroll") for (int tt = 0; tt < 4; ++tt) uf##X[tt] = *(const u32x2*)(pUT + (c16_ + lo_u + 4096u * tt)); \
        gt##X = GT[u0 + (nn_)]; } while (0)
#define S2_LDZ(X, nn_) do { const unsigned cz_ = (unsigned)(nn_) * 131072u; z##X[0] = *(const u32x4*)(pGZ + (cz_ + lo_z)); z##X[1] = *(const u32x4*)(pGZ + (cz_ + lo_z + 16u)); } while (0)
#define S2_FRAG(base_) s2_frag(base_)
#define S2_PACK(t0_, t1_) __builtin_bit_cast(bf16x8, (u32x4){pk2((t0_)[0], (t0_)[1]), pk2((t0_)[2], (t0_)[3]), pk2((t1_)[0], (t1_)[1]), pk2((t1_)[2], (t1_)[3])})
#define S2_NORM(nc_, Z) do { const size_t t = (size_t)b * SEQ + 64 * (nc_) + tok; \
        const u32x4 o0 = *(const LAS u32x4*)(Os + tok * 272 + 32 * seg), o1 = *(const LAS u32x4*)(Os + tok * 272 + 32 * seg + 16); float o[16]; float ss = 0.f; \
        _Pragma("unroll") for (int i = 0; i < 4; ++i) { o[2 * i] = bflo(o0[i]); o[2 * i + 1] = bfhi(o0[i]); o[8 + 2 * i] = bflo(o1[i]); o[9 + 2 * i] = bfhi(o1[i]); } \
        _Pragma("unroll") for (int i = 0; i < 16; ++i) ss += o[i] * o[i]; \
        ss = red8(ss); \
        const float rstd = rsqrtf(ss * (1.f / 128.f) + EPS); \
        u32x4 y8; \
        _Pragma("unroll") for (int i = 0; i < 4; ++i) { int w8 = 0; \
            w8 = __builtin_amdgcn_cvt_pk_fp8_f32(o[4 * i] * rstd * ngS[16 * seg + 4 * i] * ((i & 1) ? bflo(Z[i >> 1][2]) : bflo(Z[i >> 1][0])), o[4 * i + 1] * rstd * ngS[16 * seg + 4 * i + 1] * ((i & 1) ? bfhi(Z[i >> 1][2]) : bfhi(Z[i >> 1][0])), w8, false); \
            w8 = __builtin_amdgcn_cvt_pk_fp8_f32(o[4 * i + 2] * rstd * ngS[16 * seg + 4 * i + 2] * ((i & 1) ? bflo(Z[i >> 1][3]) : bflo(Z[i >> 1][1])), o[4 * i + 3] * rstd * ngS[16 * seg + 4 * i + 3] * ((i & 1) ? bfhi(Z[i >> 1][3]) : bfhi(Z[i >> 1][1])), w8, true); y8[i] = (unsigned)w8; } \
        *(u32x4*)(YA + t * 1024 + h * 128 + 16 * seg) = y8; } while (0)
#define S2_CHUNK(X, Y, nc_) do { \
        __syncthreads();                   \
        if ((nc_) + 1 < 32) { S2_LWRITE((nc_) + 1); } \
        if ((nc_) + 2 < 32) { S2_GLOAD((nc_) + 2); } \
        if ((nc_) + 1 < 32) { S2_LDU(Y, (nc_) + 1); } \
        if ((nc_) > 0) { S2_NORM((nc_) - 1, z##X); }     \
        S2_LDZ(Y, nc_);                    \
        __syncthreads();                   \
        { const LAS unsigned char* ab = AB + ((nc_) & 1) * 57344; \
          bf16x8 sb[4]; \
          _Pragma("unroll") for (int ks = 0; ks < 4; ++ks) sb[ks] = S2_PACK(S[2 * ks], S[2 * ks + 1]); \
          f32x4 vn[4]; \
          { f32x4 acc[4]; \
            _Pragma("unroll") for (int tt = 0; tt < 4; ++tt) acc[tt] = (f32x4){0.f, 0.f, 0.f, 0.f}; \
            _Pragma("unroll") for (int ks = 0; ks < 4; ++ks) { bf16x8 af_[4]; \
                _Pragma("unroll") for (int tt = 0; tt < 4; ++tt) af_[tt] = S2_FRAG(ab + (tt * 4 + ks) * 1024 + fo); \
                _Pragma("unroll") for (int tt = 0; tt < 4; ++tt) acc[tt] = __builtin_amdgcn_mfma_f32_16x16x32_bf16(af_[tt], sb[ks], acc[tt], 0, 0, 0); } \
            _Pragma("unroll") for (int tt = 0; tt < 4; ++tt) { vn[tt][0] = bflo(uf##X[tt].x) - acc[tt][0]; vn[tt][1] = bfhi(uf##X[tt].x) - acc[tt][1]; vn[tt][2] = bflo(uf##X[tt].y) - acc[tt][2]; vn[tt][3] = bfhi(uf##X[tt].y) - acc[tt][3]; } } \
          bf16x8 vb[2]; \
          _Pragma("unroll") for (int k2 = 0; k2 < 2; ++k2) vb[k2] = S2_PACK(vn[2 * k2], vn[2 * k2 + 1]); \
          { f32x4 acc[4]; \
            _Pragma("unroll") for (int tt = 0; tt < 4; ++tt) acc[tt] = (f32x4){0.f, 0.f, 0.f, 0.f}; \
            _Pragma("unroll") for (int ks = 0; ks < 4; ++ks) { bf16x8 af_[4]; \
                _Pragma("unroll") for (int tt = 0; tt < 4; ++tt) af_[tt] = S2_FRAG(ab + 16384 + (tt * 4 + ks) * 1024 + fo); \
                _Pragma("unroll") for (int tt = 0; tt < 4; ++tt) acc[tt] = __builtin_amdgcn_mfma_f32_16x16x32_bf16(af_[tt], sb[ks], acc[tt], 0, 0, 0); } \
            _Pragma("unroll") for (int k2 = 0; k2 < 2; ++k2) { bf16x8 af_[4]; \
                _Pragma("unroll") for (int tt = 0; tt < 4; ++tt) af_[tt] = S2_FRAG(ab + 49152 + (tt * 2 + k2) * 1024 + fo); \
                _Pragma("unroll") for (int tt = 0; tt < 4; ++tt) acc[tt] = __builtin_amdgcn_mfma_f32_16x16x32_bf16(af_[tt], vb[k2], acc[tt], 0, 0, 0); } \
            _Pragma("unroll") for (int tt = 0; tt < 4; ++tt) \
                _Pragma("unroll") for (int reg = 0; reg < 4; ++reg) *(LAS unsigned short*)(Os + (16 * tt + 4 * g + reg) * 272 + (16 * wave + n) * 2) = (unsigned short)pk2(acc[tt][reg], 0.f); } \
          _Pragma("unroll") for (int dkt = 0; dkt < 8; ++dkt) S[dkt] = S[dkt] * gt##X; \
          _Pragma("unroll") for (int k2 = 0; k2 < 2; ++k2) { \
              _Pragma("unroll") for (int hf = 0; hf < 2; ++hf) { bf16x8 af_[4]; \
                  _Pragma("unroll") for (int d = 0; d < 4; ++d) af_[d] = S2_FRAG(ab + 32768 + ((4 * hf + d) * 2 + k2) * 1024 + fo); \
                  _Pragma("unroll") for (int d = 0; d < 4; ++d) S[4 * hf + d] = __builtin_amdgcn_mfma_f32_16x16x32_bf16(af_[d], vb[k2], S[4 * hf + d], 0, 0, 0); } } } \
    } while (0)
    S2_GLOAD(0); S2_LWRITE(0); S2_GLOAD(1); S2_LDU(A, 0);
    zA[0] = zA[1] = zB[0] = zB[1] = (u32x4){0u, 0u, 0u, 0u};
#pragma unroll 1
    for (int nc = 0; nc < 32; nc += 2) {
        S2_CHUNK(A, B, nc);
        S2_CHUNK(B, A, nc + 1);
    }
    __syncthreads();
    S2_NORM(31, zA);
#undef S2_GLOAD
#undef S2_LWRITE
#undef S2_LDU
#undef S2_LDZ
#undef S2_FRAG
#undef S2_PACK
#undef S2_NORM
#undef S2_CHUNK
}

struct G2Unit { int e, mt, half; const unsigned char* Ap; const char* Bp; };
__device__ __forceinline__ G2Unit g2_unit(const Frame& F, const MoeTab& tb, int L, int NR) {
    G2Unit u; const int tile = L >> 1; u.half = L & 1;
    if (tile < NR) { u.e = tb.te[tile]; u.mt = tile - tb.tp[u.e]; u.Ap = F.ws + WS_ACT + (size_t)tile * 65536; u.Bp = (const char*)(F.ws + WS_WD) + ((size_t)u.e * 1024 + u.half * 512) * 256; }
    else { u.e = 64; u.mt = tile - NR; u.Ap = F.ws + WS_ACTS + (size_t)u.mt * 65536; u.Bp = (const char*)(F.ws + WS_WSD) + (size_t)(u.half * 512) * 256; }
    return u;
}
__device__ __forceinline__ void p8b_down(Frame& F, const MoeTab tb, const int xmode = 0) {
    if (xmode == 4) return;
    const int tid = opaque_tid(), lane = tid & 63, wave = __builtin_amdgcn_readfirstlane(tid >> 6), n = lane & 15, g = lane >> 4;
    LAS unsigned char* const Bs = F.lds;
    LAS int* const pairb = (LAS int*)(F.lds + INFO_OFF);
    const int* list = (const int*)(F.ws + WS_LIST);
    unsigned char* SLOT = F.ws + WS_SLOT; unsigned char* SH = F.ws + WS_SH;
    unsigned char* const dump = F.ws + WS_LSE + (size_t)F.blk * 1024 + lane * 16;
    const int NR = tb.tp[64], NU = (NR + 64) * 2;
    const int vblk = (F.G % 8 == 0) ? (F.blk % 8) * (F.G / 8) + F.blk / 8 : F.blk;
    int L = vblk; if (L >= NU) return;
    LAS unsigned char* const lds = F.lds; (void)lds; TS_DECL; TS_BEGIN();
    unsigned voff[2];
    { const int rho = 4 * wave + (lane >> 4), c = (lane & 15) ^ (rho & 15), ct = rho >> 4, gg = (rho >> 2) & 3, reg = rho & 3;
#pragma unroll
      for (int j = 0; j < 2; ++j) voff[j] = (unsigned)((16 * gg + 8 * j + 4 * ct + reg) * 256 + c * 16); }
#define G2_GLDS(src_, q_) __builtin_amdgcn_global_load_lds((const unsigned*)((src_) + (size_t)((q_) >> 1) * 16384 + voff[(q_) & 1]), (LAS unsigned*)(Bs + ((q_) & 7) * 8192 + wave * 1024), 16, 0, 0)
#define G2_PAIR_LD(u_, raw_) do { const int r_ = tid & 255; int idx_ = 0; if ((u_).e < 64) { const int pos_ = (u_).mt * 256 + r_; idx_ = pos_ < tb.cnt[(u_).e] ? (u_).e * T + pos_ : 0; } raw_ = list[idx_]; } while (0)
#define G2_PAIR_FIX(u_, raw_, dst_) do { const int r_ = tid & 255; if ((u_).e < 64) { const int pos_ = (u_).mt * 256 + r_; dst_ = pos_ < tb.cnt[(u_).e] ? raw_ : -1; } else dst_ = (u_).mt * 256 + r_; } while (0)
#define G2_ALOAD(u_, dst_) do { _Pragma("unroll") for (int rt = 0; rt < 2; ++rt) _Pragma("unroll") for (int kp = 0; kp < 4; ++kp) dst_[rt][kp] = *(const u32x4*)((u_).Ap + (size_t)(32 * wave + 16 * rt + n) * 256 + 64 * kp + 16 * g); } while (0)
    G2Unit cur = g2_unit(F, tb, L, NR);
    u32x4 af[2][4]; int pcur;
    { int raw; G2_PAIR_LD(cur, raw); G2_ALOAD(cur, af); G2_PAIR_FIX(cur, raw, pcur); }
    if (tid < 256) pairb[tid] = pcur;
#pragma unroll
    for (int t = 0; t < 6; ++t) G2_GLDS(cur.Bp, t);
#pragma unroll
    for (int rt = 0; rt < 2; ++rt)
#pragma unroll
        for (int kp = 0; kp < 4; ++kp) asm volatile("" : "+v"(af[rt][kp]));
    TS_END(50);
    while (true) {
        const int Ln = L + F.G; const bool hasn = Ln < NU;
        const G2Unit nxt = g2_unit(F, tb, hasn ? Ln : L, NR);
        u32x4 an[2][4]; int pn = -1, prow[2] = {-1, -1};
#pragma unroll
        for (int bp = 0; bp < 8; ++bp) {
            if (hasn && bp >= 5) asm volatile("s_waitcnt vmcnt(19)" ::: "memory"); else asm volatile("s_waitcnt vmcnt(10)" ::: "memory");
            __builtin_amdgcn_s_barrier();
            asm volatile("" ::: "memory");
#pragma unroll
            for (int j = 0; j < 2; ++j) { const int q = 2 * bp + 6 + j;
                if (q < 16) G2_GLDS(cur.Bp, q); else G2_GLDS(nxt.Bp, q - 16); }
            if (bp == 4 && hasn) { G2_ALOAD(nxt, an); G2_PAIR_LD(nxt, pn); }
            if (bp == 0) {
#pragma unroll
                for (int rt = 0; rt < 2; ++rt) prow[rt] = pairb[32 * wave + 16 * rt + n]; }
            f32x4 acc[2][2][2];
#pragma unroll
            for (int j = 0; j < 2; ++j) { const LAS unsigned char* bs = Bs + ((2 * bp + j) & 7) * 8192;
#pragma unroll
                for (int rt = 0; rt < 2; ++rt)
#pragma unroll
                    for (int ct = 0; ct < 2; ++ct) acc[j][rt][ct] = (f32x4){0.f, 0.f, 0.f, 0.f};
#pragma unroll
                for (int kk = 0; kk < 2; ++kk) {
                    const bf16x8 w00 = *(const LAS bf16x8*)(bs + n * 256 + (((8 * kk + g) ^ n) << 4)), w01 = *(const LAS bf16x8*)(bs + n * 256 + (((8 * kk + 4 + g) ^ n) << 4));
                    const bf16x8 w10 = *(const LAS bf16x8*)(bs + (16 + n) * 256 + (((8 * kk + g) ^ n) << 4)), w11 = *(const LAS bf16x8*)(bs + (16 + n) * 256 + (((8 * kk + 4 + g) ^ n) << 4));
#pragma unroll
                    for (int rt = 0; rt < 2; ++rt) { const bf16x8 a0 = __builtin_bit_cast(bf16x8, af[rt][2 * kk]), a1 = __builtin_bit_cast(bf16x8, af[rt][2 * kk + 1]);
                        acc[j][rt][0] = mfma_fp8_k128(w00, w01, a0, a1, acc[j][rt][0]); acc[j][rt][1] = mfma_fp8_k128(w10, w11, a0, a1, acc[j][rt][1]); }
                }
            }
            const int col = cur.half * 512 + 64 * bp + 16 * g; unsigned char* const obase = cur.e < 64 ? SLOT : SH;
#pragma unroll
            for (int rt = 0; rt < 2; ++rt) { const int p = prow[rt];
                constexpr float IS = 1.0f / WD_SCALE; u32x4 w;
#pragma unroll
                for (int j = 0; j < 2; ++j)
#pragma unroll
                    for (int ct = 0; ct < 2; ++ct) { int pk = 0; pk = __builtin_amdgcn_cvt_pk_fp8_f32(acc[j][rt][ct][0] * IS, acc[j][rt][ct][1] * IS, pk, false); pk = __builtin_amdgcn_cvt_pk_fp8_f32(acc[j][rt][ct][2] * IS, acc[j][rt][ct][3] * IS, pk, true); w[2 * j + ct] = (unsigned)pk; }
                *(u32x4*)(p >= 0 ? obase + (size_t)p * 1024 + col : dump) = w; }
        }
        TS_END(51);
        if (!hasn) break;
#pragma unroll
        for (int rt = 0; rt < 2; ++rt)
#pragma unroll
            for (int kp = 0; kp < 4; ++kp) af[rt][kp] = an[rt][kp];
        { int pf; G2_PAIR_FIX(nxt, pn, pf); if (tid < 256) pairb[tid] = pf; }
        cur = nxt; L = Ln;
        TS_END(50);
    }
#undef G2_GLDS
#undef G2_PAIR_LD
#undef G2_PAIR_FIX
#undef G2_ALOAD
}

constexpr size_t WS_WRH = 3 * MiB + 64 * 1024, WS_WRL = 3 * MiB + 192 * 1024;
__device__ __forceinline__ void p1_router_split(Frame& F) {
    const int gid = F.blk * 512 + opaque_tid();
    if (gid < 64 * 128) { const int e = gid >> 7, k0 = (gid & 127) * 8; const float* wr = inp(I_WR);
        u32x4 hi, lo;
#pragma unroll
        for (int i = 0; i < 4; ++i) { const float a = wr[(size_t)(k0 + 2 * i) * 64 + e], b = wr[(size_t)(k0 + 2 * i + 1) * 64 + e];
            const unsigned h = pk2(a, b); hi[i] = h; lo[i] = pk2(a - bflo(h), b - bfhi(h)); }
        *(u32x4*)((bf16_t*)(F.ws + WS_WRH) + (size_t)e * 1024 + k0) = hi; *(u32x4*)((bf16_t*)(F.ws + WS_WRL) + (size_t)e * 1024 + k0) = lo; }
}
__device__ __forceinline__ void p7_route(Frame& F, const bool emit) {
    const int ftid = opaque_tid(), flane = ftid & 63, fwave = __builtin_amdgcn_readfirstlane(ftid >> 6);
    constexpr int RS = 528, LS = 65;
    LAS unsigned char* Hhi = F.lds; LAS unsigned char* Hlo = F.lds + 64 * RS;
    LAS unsigned char* Whi = F.lds + 128 * RS; LAS unsigned char* Wlo = F.lds + 192 * RS;
    LAS float* Ls = (LAS float*)F.lds;
    LAS float* CandS = (LAS float*)(F.lds + 16896);
    LAS int* CandI = (LAS int*)(F.lds + 25088);
    LAS int* hist = (LAS int*)(F.lds + 33280);
    const float* MOD = (const float*)(F.ws + WS_MOD); const float* X = inp(I_X); const bf16_t* Y = (const bf16_t*)(F.ws + WS_Y); unsigned char* H2 = F.ws + WS_H;
    int* LIST = (int*)(F.ws + WS_LIST); float* LISTW = (float*)(F.ws + WS_LISTW); gu32* gcnt = (gu32*)(F.ws + WS_CTL) + CW_CNT;
    const bf16_t* WRH = (const bf16_t*)(F.ws + WS_WRH); const bf16_t* WRL = (const bf16_t*)(F.ws + WS_WRL);
    const int tid = ftid, lane = flane, wave = fwave, n = lane & 15, g = lane >> 4;
    LAS unsigned char* const lds = F.lds; (void)lds;
    for (int grp = F.blk; grp < T / 64; grp += F.G) {
        const int row0 = grp * 64, b = row0 / SEQ;
        TS_BEGIN();
        const float* sh2 = MOD + b * 6144 + 3 * 1024; const float* sc2 = sh2 + 1024;
        float rstd[8];
        f32x4 xx[8][4];
        {
#pragma unroll
          for (int rr = 0; rr < 8; ++rr) { const size_t ro = (size_t)(row0 + 8 * wave + rr) * DM + 4 * lane;
#pragma unroll
              for (int j = 0; j < 4; ++j) xx[rr][j] = __builtin_nontemporal_load((const f32x4*)(X + ro + 256 * j)); }
#pragma unroll
          for (int hb = 0; hb < 4; ++hb) { u32x2 yy[2][4];
#pragma unroll
            for (int rr = 0; rr < 2; ++rr) { const size_t ro = (size_t)(row0 + 8 * wave + 2 * hb + rr) * DM + 4 * lane;
#pragma unroll
                for (int j = 0; j < 4; ++j) yy[rr][j] = *(const u32x2*)(Y + ro + 256 * j); }
#pragma unroll
            for (int rr = 0; rr < 2; ++rr)
#pragma unroll
                for (int j = 0; j < 4; ++j) { const u32x2 y = yy[rr][j]; f32x4 v = xx[2 * hb + rr][j]; const f32x4 g1 = *(const f32x4*)(MOD + b * 6144 + 2048 + 256 * j + 4 * lane);
                    v.x += g1.x * bflo(y.x); v.y += g1.y * bfhi(y.x); v.z += g1.z * bflo(y.y); v.w += g1.w * bfhi(y.y); xx[2 * hb + rr][j] = v;
                    { u32x2 w; w.x = pk2(v.x, v.y); w.y = pk2(v.z, v.w); *(u32x2*)((bf16_t*)Y + (size_t)(row0 + 8 * wave + 2 * hb + rr) * DM + 4 * lane + 256 * j) = w; } }
            asm volatile("" ::: "memory"); } }
#pragma unroll
        for (int rr = 0; rr < 8; ++rr) { float ss = 0.f;
#pragma unroll
            for (int j = 0; j < 4; ++j) { const f32x4 v = xx[rr][j]; ss += (v.x * v.x + v.y * v.y) + (v.z * v.z + v.w * v.w); }
            rstd[rr] = rsqrtf(wave_sum(ss) * (1.f / DM) + EPS); }
        TS_END(10);
        f32x4 acc0 = {0.f, 0.f, 0.f, 0.f}, acc1 = {0.f, 0.f, 0.f, 0.f};
        const int rt = wave & 3, et = (wave >> 2) * 2;
        u32x4 wnh[4], wnl[4];
#define P7_LOADX(c_) do { \
        _Pragma("unroll") for (int i = 0; i < 4; ++i) { const int e = (tid >> 5) + 16 * i, kc = (tid & 31) * 8; wnh[i] = *(const u32x4*)(WRH + (size_t)e * 1024 + (c_) * 256 + kc); wnl[i] = *(const u32x4*)(WRL + (size_t)e * 1024 + (c_) * 256 + kc); } } while (0)
        P7_LOADX(0);
#pragma unroll
        for (int c = 0; c < 4; ++c) {
            const int tid = opaque_tid(), lane = tid & 63, n = lane & 15, g = lane >> 4;
            const int k = c * 256 + 4 * lane;
            const f32x4 g2 = *(const f32x4*)(inp(I_GFFN) + k), s2 = *(const f32x4*)(sc2 + k) + 1.0f, h2 = *(const f32x4*)(sh2 + k);
#pragma unroll
            for (int rr = 0; rr < 8; ++rr) { const size_t row = (size_t)(row0 + 8 * wave + rr);
                const f32x4 hv = (xx[rr][c] * rstd[rr]) * (g2 * s2) + h2;
                u32x2 hi, lo; hi.x = pk2(hv.x, hv.y); hi.y = pk2(hv.z, hv.w);
                lo.x = pk2(hv.x - bflo(hi.x), hv.y - bfhi(hi.x)); lo.y = pk2(hv.z - bflo(hi.y), hv.w - bfhi(hi.y));
                *(LAS u32x2*)(Hhi + (8 * wave + rr) * RS + 8 * lane) = hi; *(LAS u32x2*)(Hlo + (8 * wave + rr) * RS + 8 * lane) = lo;
                { int w8 = 0; w8 = __builtin_amdgcn_cvt_pk_fp8_f32(hv.x, hv.y, w8, false); w8 = __builtin_amdgcn_cvt_pk_fp8_f32(hv.z, hv.w, w8, true); *(unsigned*)(H2 + row * DM + k) = (unsigned)w8; } }
#pragma unroll
            for (int i = 0; i < 4; ++i) { const int e = (tid >> 5) + 16 * i, kc = (tid & 31) * 16; *(LAS u32x4*)(Whi + e * RS + kc) = wnh[i]; *(LAS u32x4*)(Wlo + e * RS + kc) = wnl[i]; }
            __syncthreads();
            if (c < 3) { P7_LOADX(c + 1); }
#pragma unroll
            for (int ks = 0; ks < 8; ++ks) {
                const bf16x8 ah = *(const LAS bf16x8*)(Hhi + (16 * rt + n) * RS + 64 * ks + 16 * g), al = *(const LAS bf16x8*)(Hlo + (16 * rt + n) * RS + 64 * ks + 16 * g);
                const bf16x8 b0h = *(const LAS bf16x8*)(Whi + (16 * et + n) * RS + 64 * ks + 16 * g), b0l = *(const LAS bf16x8*)(Wlo + (16 * et + n) * RS + 64 * ks + 16 * g);
                const bf16x8 b1h = *(const LAS bf16x8*)(Whi + (16 * et + 16 + n) * RS + 64 * ks + 16 * g), b1l = *(const LAS bf16x8*)(Wlo + (16 * et + 16 + n) * RS + 64 * ks + 16 * g);
                acc0 = __builtin_amdgcn_mfma_f32_16x16x32_bf16(al, b0h, acc0, 0, 0, 0); acc1 = __builtin_amdgcn_mfma_f32_16x16x32_bf16(al, b1h, acc1, 0, 0, 0);
                acc0 = __builtin_amdgcn_mfma_f32_16x16x32_bf16(ah, b0l, acc0, 0, 0, 0); acc1 = __builtin_amdgcn_mfma_f32_16x16x32_bf16(ah, b1l, acc1, 0, 0, 0);
                acc0 = __builtin_amdgcn_mfma_f32_16x16x32_bf16(ah, b0h, acc0, 0, 0, 0); acc1 = __builtin_amdgcn_mfma_f32_16x16x32_bf16(ah, b1h, acc1, 0, 0, 0);
                if (ks & 1) asm volatile("" ::: "memory");
            }
            __syncthreads();
        }
#undef P7_LOADX
#pragma unroll
        for (int reg = 0; reg < 4; ++reg) { const int r = rt * 16 + 4 * g + reg; Ls[r * LS + et * 16 + n] = acc0[reg]; Ls[r * LS + et * 16 + 16 + n] = acc1[reg]; }
        if (tid < 128) hist[tid] = 0;
        __syncthreads();
        TS_END(11);
        {
            const int tid = opaque_tid(), lane = tid & 63;
            const int r = tid >> 3, q = tid & 7;
            float s[8], sel[8];
#pragma unroll
            for (int i = 0; i < 8; ++i) { s[i] = sigmoidf_(Ls[r * LS + q * 8 + i]); sel[i] = s[i] + inp(I_RB)[q * 8 + i]; }
            float m1 = -INFINITY, m2 = -INFINITY;
#pragma unroll
            for (int i = 0; i < 8; ++i) { const float v = sel[i]; if (v > m1) { m2 = m1; m1 = v; } else if (v > m2) m2 = v; }
            const float gs = m1 + m2;
            int rank = 0;
#pragma unroll
            for (int j = 0; j < 8; ++j) { const float o = __shfl(gs, (lane & ~7) + j); rank += ((o > gs) || (o == gs && j < q)) ? 1 : 0; }
            const bool gsel = rank < 4;
            const unsigned long long bal = __ballot(gsel); const unsigned gm = (unsigned)(bal >> (lane & ~7)) & 0xffu;
            const int slot = __builtin_popcount(gm & ((1u << q) - 1u));
            if (gsel) {
#pragma unroll
                for (int i = 0; i < 8; ++i) { CandS[r * 32 + slot * 8 + i] = sel[i]; CandI[r * 32 + slot * 8 + i] = q * 8 + i; } }
            __syncthreads();
            int cn[8];
#pragma unroll
            for (int i = 0; i < 8; ++i) cn[i] = 0;
            for (int j = 0; j < 32; ++j) { const float o = CandS[r * 32 + j]; const int oi = CandI[r * 32 + j];
#pragma unroll
                for (int i = 0; i < 8; ++i) cn[i] += ((o > sel[i]) || (o == sel[i] && oi < q * 8 + i)) ? 1 : 0; }
            float part = 0.f;
#pragma unroll
            for (int i = 0; i < 8; ++i) if (gsel && cn[i] < 8) part += s[i];
            part = red8(part);
            const float inv = 2.5f / part;
            TS_END(12);
            int lp[8];
#pragma unroll
            for (int i = 0; i < 8; ++i) { lp[i] = -1; if (emit && gsel && cn[i] < 8) lp[i] = atomicAdd((int*)(hist + q * 8 + i), 1); }
            __syncthreads();
            if (emit && tid < 64) hist[64 + tid] = (int)__hip_atomic_fetch_add(gcnt + tid, (unsigned)hist[tid], RLX_AGENT);
            __syncthreads();
#pragma unroll
            for (int i = 0; i < 8; ++i) if (lp[i] >= 0) { const int e = q * 8 + i; const size_t li = (size_t)e * T + hist[64 + e] + lp[i]; LIST[li] = (row0 + r) * 8 + cn[i]; LISTW[li] = s[i] * inv; }
            __syncthreads();
            TS_END(13);
        }
    }
}

__device__ __forceinline__ void p9_combine(Frame& F) {
    const int tid = opaque_tid();
    const float* MOD = (const float*)(F.ws + WS_MOD); const unsigned char* SLOT = F.ws + WS_SLOT; const unsigned char* SH = F.ws + WS_SH; float* out = F.out; const bf16_t* Y = (const bf16_t*)(F.ws + WS_Y);
#ifdef PROBE_SEL
#ifndef PROBE_DIV
#define PROBE_DIV 100000.0f
#endif
#ifndef PROBE_Q
#define PROBE_Q 1000
#endif
    const float pscale_ = 1.0f + (float)((__hip_atomic_load(&g_ts[PROBE_SEL], __ATOMIC_RELAXED, __HIP_MEMORY_SCOPE_AGENT) + PROBE_Q / 2) / PROBE_Q * PROBE_Q) / PROBE_DIV;
#endif
    for (size_t it = (size_t)F.blk * 512 + tid; it < (size_t)T * 64; it += (size_t)F.G * 512) {
        const size_t t = it >> 6; const int c0 = (int)(it & 63) * 16; const int b = (int)(t / SEQ);
        u32x4 sl[8];
#pragma unroll
        for (int k = 0; k < 8; ++k) sl[k] = __builtin_nontemporal_load((const u32x4*)(SLOT + (t * 8 + k) * 1024 + c0));
        const u32x4 s8 = __builtin_nontemporal_load((const u32x4*)(SH + t * 1024 + c0));
        f32x4 xv[4], gv[4];
#pragma unroll
        for (int i = 0; i < 4; ++i) gv[i] = *(const f32x4*)(MOD + b * 6144 + 5 * 1024 + c0 + 4 * i);
        { const u32x4 y0 = __builtin_nontemporal_load((const u32x4*)(Y + t * 1024 + c0)), y1 = __builtin_nontemporal_load((const u32x4*)(Y + t * 1024 + c0 + 8));
#pragma unroll
          for (int i = 0; i < 4; ++i) { const unsigned w0 = i < 2 ? y0[2 * i] : y1[2 * i - 4], w1 = i < 2 ? y0[2 * i + 1] : y1[2 * i - 3];
            xv[i].x = bflo(w0); xv[i].y = bfhi(w0); xv[i].z = bflo(w1); xv[i].w = bfhi(w1); } }
        float acc[16];
#pragma unroll
        for (int i = 0; i < 4; ++i) { const f32x2 lo = __builtin_amdgcn_cvt_pk_f32_fp8((int)s8[i], false), hi = __builtin_amdgcn_cvt_pk_f32_fp8((int)s8[i], true); acc[4 * i] = lo.x; acc[4 * i + 1] = lo.y; acc[4 * i + 2] = hi.x; acc[4 * i + 3] = hi.y; }
#pragma unroll
        for (int k = 0; k < 8; ++k)
#pragma unroll
            for (int i = 0; i < 4; ++i) { const f32x2 lo = __builtin_amdgcn_cvt_pk_f32_fp8((int)sl[k][i], false), hi = __builtin_amdgcn_cvt_pk_f32_fp8((int)sl[k][i], true);
                acc[4 * i] += lo.x; acc[4 * i + 1] += lo.y; acc[4 * i + 2] += hi.x; acc[4 * i + 3] += hi.y; }
#pragma unroll
        for (int i = 0; i < 4; ++i) { f32x4 o; o.x = xv[i].x + gv[i].x * acc[4 * i]; o.y = xv[i].y + gv[i].y * acc[4 * i + 1]; o.z = xv[i].z + gv[i].z * acc[4 * i + 2]; o.w = xv[i].w + gv[i].w * acc[4 * i + 3];
#ifdef PROBE_SEL
            o = o * pscale_;
#endif
            *(f32x4*)(out + t * 1024 + c0 + 4 * i) = o; }
    }
}

struct Args { const float* in[24]; float* out; unsigned char* ws; };
__global__ void __launch_bounds__(512, 2) mega_fwd(Args args) {
    extern __shared__ __attribute__((aligned(16))) unsigned char lds_raw[];
    Frame F;
    F.lds = (LAS unsigned char*)lds_raw;
    F.G = gridDim.x; F.blk = blockIdx.x;
    F.out = args.out; F.ws = args.ws; F.ob = (unsigned char*)args.out;
    volatile LAS unsigned* MISC = (volatile LAS unsigned*)(F.lds + MISC_OFF);
    for (int u = threadIdx.x; u < 64; u += 512) MISC[u] = 0u;
    __syncthreads();
    XcdBarrier bar = xcd_barrier_post((unsigned*)(F.ws + WS_CTL) + CW_BAR, MISC + 8);
#ifdef PROBE_SEL
    int tsi_ = 0;
    volatile LAS unsigned long long* const tsl_ = (volatile LAS unsigned long long*)(F.lds + MISC_OFF + 72);
    if (blockIdx.x == PROBE_BLK && threadIdx.x == 0) { for (int k = 0; k < 64; ++k) g_ts[k] = 0; *tsl_ = __builtin_amdgcn_s_memrealtime(); }
#define GRID_BAR() do { xcd_barrier(bar); if (blockIdx.x == PROBE_BLK && threadIdx.x == 0) { const unsigned long long t_ = __builtin_amdgcn_s_memrealtime(); g_ts[32 + tsi_] += t_ - *tsl_; *tsl_ = t_; } ++tsi_; } while (0)
#else
#define GRID_BAR() xcd_barrier(bar)
#endif
    unsigned char* ws = F.ws;
    const float* MOD = (const float*)(ws + WS_MOD);

#ifndef DUPMASK
#define DUPMASK 0
#endif
#define REP(k) _Pragma("unroll 1") for (int rep_ = 0; rep_ < (((DUPMASK) >> (k)) & 1 ? 2 : 1); ++rep_)
    REP(0) { p0_mod(F); }
    GRID_BAR();
    REP(1) { p1_norm(F); }
    __syncthreads();
    p0_weights(F); p0_wout8(F);
    p1_router_split(F);
    GRID_BAR();
    REP(2) { pg8::DenseOrder S; S.init(T, NPROJ, 512, F.G, F.blk, F.ob + OUT_H8, ws + WS_WIN);
      EpiProj E{ws, (bf16_t*)(F.ob + OUT_GZ)};
      LAS int* tokb = (LAS int*)(F.lds + INFO_OFF); for (int i_ = opaque_tid(); i_ < 10 * 256; i_ += 512) tokb[i_] = i_ & 255; __syncthreads();
      pg8::gemm_phase<EpiProj, pg8::DenseOrder, true, true, true>(F.lds, 512, S, E, tokb); }
    GRID_BAR();
    REP(3) { p3_attn(F); }
    GRID_BAR();
    REP(4) { p3b_gdn_prep(F); }
    GRID_BAR();
    { LAS unsigned char* const lds = F.lds; (void)lds; TS_BEGIN(); }
    REP(6) { p4_gdn_scan2(F); }
    { LAS unsigned char* const lds = F.lds; (void)lds; if (F.blk < 64) { TS_END(24); } }
#ifndef CONVB
#define CONVB 112
#endif
    REP(5) { p3_merge(F, 64, CONVB); }
    REP(12) { convert_experts(F, 64, CONVB); }
    GRID_BAR();
    LAS int* tokb5 = (LAS int*)(F.lds + INFO_OFF); for (int i_ = opaque_tid(); i_ < 6 * 256; i_ += 512) tokb5[i_] = i_ & 255; __syncthreads();
    REP(7) {
    { pg8::DenseOrder S; S.init(T, 1024, 512, F.G, F.blk, ws + WS_YA, ws + WS_WUPG); EpiStore E{(bf16_t*)(ws + WS_UA), 1024, 1.0f / WUPG_SCALE};
      pg8::gemm_phase<EpiStore, pg8::DenseOrder, true, true, true>(F.lds, 512, S, E, tokb5); }
    { pg8::DenseOrder S; S.init(T, 1024, 256, F.G, F.blk, ws + WS_YB, ws + WS_WUPD); EpiStore E{(bf16_t*)(ws + WS_UB), 1024, 1.0f / WUPD_SCALE};
      pg8::gemm_phase<EpiStore, pg8::DenseOrder, true, true, true>(F.lds, 256, S, E, tokb5); }
    }
    REP(8) { pg8::LocalGateOrder S; S.init(T, 512, F.G, F.blk, F.ob + OUT_H8, ws + WS_WG); EpiGate E{(const bf16_t*)(ws + WS_UA), (const bf16_t*)(ws + WS_UB), ws + WS_MG};
      pg8::gemm_phase<EpiGate, pg8::LocalGateOrder, true, true, true>(F.lds, 512, S, E, tokb5); }
    GRID_BAR();
    REP(9) { pg8::DenseOrder S; S.init(T, 1024, 512, F.G, F.blk, ws + WS_MG, ws + WS_WOUT); EpiStore E{(bf16_t*)(ws + WS_Y), 1024, 1.0f / (WOUT_SCALE * MG_SCALE)};
      LAS int* tokb = (LAS int*)(F.lds + INFO_OFF); for (int i_ = opaque_tid(); i_ < 6 * 256; i_ += 512) tokb[i_] = i_ & 255; __syncthreads();
      pg8::gemm_phase<EpiStore, pg8::DenseOrder, true, true, true>(F.lds, 512, S, E, tokb); }
    GRID_BAR();
    if ((DUPMASK >> 13) & 1) p7_route(F, false);
    p7_route(F, true);
    GRID_BAR();
    REP(10) { MoeTab tb = build_moetab(F);
      G1Order S{tb, F.G, F.blk, (const int*)(ws + WS_LIST), (const char*)(ws + WS_H), (const char*)(ws + WS_WGU), (const char*)(ws + WS_WSGU)};
      LAS int* tokb = (LAS int*)(F.lds + INFO_OFF); LAS float* wkb = (LAS float*)(F.lds + INFO_OFF + 6144);
      S.preload(tokb, wkb, (const float*)(ws + WS_LISTW));
      EpiAct E{tb, wkb, ws + WS_ACT, ws + WS_ACTS};
      pg8::gemm_phase<EpiAct, G1Order, true, true, true>(F.lds, 512, S, E, tokb); }
    GRID_BAR();
#ifndef P8B_REPS
#define P8B_REPS 1
#endif
#ifndef P8B_XMODE
#define P8B_XMODE 0
#endif
    for (int r8_ = 0; r8_ < P8B_REPS; ++r8_) { REP(11) { MoeTab tb = build_moetab(F); p8b_down(F, tb, r8_ < P8B_REPS - 1 ? P8B_XMODE : 0); }
    GRID_BAR(); }
    if ((DUPMASK >> 14) & 1) { for (int r_ = 0; r_ < 13; ++r_) GRID_BAR(); }
#ifdef PROBE_SEL
    { __threadfence(); }
#endif
    p9_combine(F);
#undef REP
#undef GRID_BAR
}

extern "C" void kernel_launch(void* const* d_in, const int* in_sizes, int n_in, void* d_out, int out_size, void* d_ws, size_t ws_size, hipStream_t stream) {
    static int grid = 0;
    if (grid == 0) {
        if (n_in != 24 || out_size != T * DM || ws_size < WS_END) { fprintf(stderr, "kernel_launch: unexpected shapes / workspace (n_in %d out %d ws %zu, need %zu)\n", n_in, out_size, ws_size, (size_t)WS_END); grid = -1; return; }
        int dev = 0, cus = 0;
        if (hipGetDevice(&dev) != hipSuccess || hipDeviceGetAttribute(&cus, hipDeviceAttributeMultiprocessorCount, dev) != hipSuccess) { grid = -1; return; }
        if (hipFuncSetAttribute((const void*)mega_fwd, hipFuncAttributeMaxDynamicSharedMemorySize, LDS_BYTES) != hipSuccess) { fprintf(stderr, "kernel_launch: hipFuncSetAttribute failed\n"); grid = -1; return; }
        int per_cu = 0;
        if (hipOccupancyMaxActiveBlocksPerMultiprocessor(&per_cu, (const void*)mega_fwd, 512, LDS_BYTES) != hipSuccess || per_cu < 1) fprintf(stderr, "kernel_launch: occupancy query reports %d blocks per CU\n", per_cu);
        (void)hipGetLastError();
        if (cus < 64 + 112) { fprintf(stderr, "kernel_launch: %d CUs, the phase-4 work split needs at least 176\n", cus); grid = -1; return; }
        grid = cus;
    }
    if (grid < 0) return;
    if (hipMemsetAsync((char*)d_ws + WS_CTL, 0, CTL_ZERO_BYTES, stream) != hipSuccess) return;
    Args a{};
    for (int i = 0; i < 24; ++i) a.in[i] = (const float*)d_in[i];
    a.out = (float*)d_out; a.ws = (unsigned char*)d_ws;
    hipLaunchKernelGGL(mega_fwd, dim3(grid), dim3(512), LDS_BYTES, stream, a);
}
```
